# Optimizing an MI355X kernel written in HIP

```python
import math
import jax, jax.numpy as jnp
from jax import lax
import numpy as np

D_MODEL = 1024
BATCH = 8
SEQ = 4096
DEPTH = 2
DEC_BATCH = 128
DEC_SEQ = 1
PAST_LEN = 16384
PAGE_SIZE = 128

HEAD_DIM = 64
N_HEADS = 8
N_KV_HEADS = 2
GQA_GROUP = N_HEADS // N_KV_HEADS
ATTN_WIDTH = N_HEADS * HEAD_DIM
KV_WIDTH = N_KV_HEADS * HEAD_DIM
WINDOW = 128
BLOCK = WINDOW
POOL_SIZES = (2, 4, 8, 16)
POOL_GROUP_WIDTH = 128
POOL_WIDTH = len(POOL_SIZES) * POOL_GROUP_WIDTH
POOL_STATE = max(POOL_SIZES) - 1
MIX_WIDTH = ATTN_WIDTH + POOL_WIDTH
IN_WIDTH = ATTN_WIDTH + 2 * KV_WIDTH + POOL_WIDTH
D_FF = 2816
N_BUCKETS = 32
MAX_DISTANCE = 128
N_SUBLAYERS = 3
N_MOD = 3 * N_SUBLAYERS
EPS = 1e-6

kernel_name = "hybrid_swa_pool_macaron_adaln_step"


def rms_norm(x, g):
    xf = x.astype(jnp.float32)
    y = xf * lax.rsqrt(jnp.mean(xf * xf, axis=-1, keepdims=True) + EPS)
    return (y * g.astype(jnp.float32)).astype(x.dtype)


def swiglu(h, wg, wu, wd):
    return (jax.nn.silu(h @ wg) * (h @ wu)) @ wd


def t5_bucket(dist):
    n = jnp.maximum(dist, 0)
    max_exact = N_BUCKETS // 2
    nf = jnp.maximum(n, 1).astype(jnp.float32)
    large = max_exact + (jnp.log(nf / max_exact) / math.log(MAX_DISTANCE / max_exact)
                         * (N_BUCKETS - max_exact)).astype(jnp.int32)
    large = jnp.minimum(large, N_BUCKETS - 1)
    return jnp.where(n < max_exact, n, large)


def window_attention(q, k, v, key_valid, offset, sinks, rel_bias):
    B, N, Q = q.shape[:3]
    K = k.shape[2]
    qg = q.reshape(B, N, Q, N_KV_HEADS, GQA_GROUP, HEAD_DIM)
    s = jnp.einsum("bnqkgd,bnskd->bnkgqs", qg, k,
                   preferred_element_type=jnp.float32) * (HEAD_DIM ** -0.5)
    dist = jnp.arange(Q)[:, None] + offset - jnp.arange(K)[None, :]
    bias = rel_bias[t5_bucket(dist)].astype(jnp.float32)
    bias = bias.transpose(2, 0, 1).reshape(N_KV_HEADS, GQA_GROUP, Q, K)
    valid = ((dist >= 0) & (dist <= WINDOW))[None] & key_valid[:, None, :]
    s = jnp.where(valid[None, :, None, None], s + bias, -jnp.inf)
    sink = sinks.astype(jnp.float32).reshape(N_KV_HEADS, GQA_GROUP, 1, 1)
    m = jnp.maximum(jnp.max(s, axis=-1, keepdims=True), sink)
    p = jnp.exp(s - m)
    denom = jnp.sum(p, axis=-1, keepdims=True) + jnp.exp(sink - m)
    o = jnp.einsum("bnkgqs,bnskd->bnqkgd", (p / denom).astype(v.dtype), v)
    return o.reshape(B, N, Q, ATTN_WIDTH)


def prompt_attention(q, k, v, sinks, rel_bias):
    B, S = q.shape[:2]
    nb = S // BLOCK
    qb = q.reshape(B, nb, BLOCK, N_HEADS, HEAD_DIM)
    kb = k.reshape(B, nb, BLOCK, N_KV_HEADS, HEAD_DIM)
    vb = v.reshape(B, nb, BLOCK, N_KV_HEADS, HEAD_DIM)

    def with_prev(xb):
        prev = jnp.pad(xb, ((0, 0), (1, 0), (0, 0), (0, 0), (0, 0)))[:, :-1]
        return jnp.concatenate([prev, xb], axis=2)

    key_valid = jnp.concatenate(
        [jnp.broadcast_to(jnp.arange(nb)[:, None] > 0, (nb, BLOCK)),
         jnp.ones((nb, BLOCK), dtype=bool)], axis=1)
    o = window_attention(qb, with_prev(kb), with_prev(vb), key_valid, BLOCK, sinks, rel_bias)
    return o.reshape(B, S, ATTN_WIDTH)


def multiscale_pool(u_ext, pos0, n_prev, pool_w, pool_scale):
    L = u_ext.shape[1]
    uf = u_ext.astype(jnp.float32)
    cs = jnp.cumsum(uf, axis=1)
    pos = pos0 + jnp.arange(L)
    outs = []
    for g, w in enumerate(POOL_SIZES):
        lo, hi = g * POOL_GROUP_WIDTH, (g + 1) * POOL_GROUP_WIDTH
        cg = cs[..., lo:hi]
        lagged = jnp.pad(cg, ((0, 0), (w, 0), (0, 0)))[:, :L]
        count = jnp.minimum(pos + 1, w).astype(jnp.float32)[None, :, None]
        pooled = (cg - lagged) / count - uf[..., lo:hi]
        pooled = pooled[:, n_prev:].astype(u_ext.dtype)
        outs.append(pooled @ pool_w[g])
    return jnp.concatenate(outs, axis=-1) * pool_scale


def split_projection(z):
    return jnp.split(z, [ATTN_WIDTH, ATTN_WIDTH + KV_WIDTH, ATTN_WIDTH + 2 * KV_WIDTH], axis=-1)


def run_trunk(x, c, mixer, w_ada, b_ada, norm_gain, w_in, w_out,
              ffn1_wg, ffn1_wu, ffn1_wd, ffn2_wg, ffn2_wu, ffn2_wd, final_gain):
    states = []
    for l in range(DEPTH):
        mod = (jax.nn.silu(c) @ w_ada[l] + b_ada[l]).reshape(c.shape[0], 1, N_MOD, D_MODEL)

        def modulate(h, i):
            return rms_norm(h, norm_gain[l, i]) * (1 + mod[:, :, 3 * i + 1]) + mod[:, :, 3 * i]

        def gate(i):
            return mod[:, :, 3 * i + 2]

        x = x + 0.5 * gate(0) * swiglu(modulate(x, 0), ffn1_wg[l], ffn1_wu[l], ffn1_wd[l])
        z = modulate(x, 1) @ w_in[l]
        mixed, st = mixer(l, z)
        x = x + gate(1) * (mixed @ w_out[l])
        x = x + 0.5 * gate(2) * swiglu(modulate(x, 2), ffn2_wg[l], ffn2_wu[l], ffn2_wd[l])
        states.append(st)
    return rms_norm(x, final_gain), states


def setup_inputs(seed: int = 0) -> dict:
    key = jax.random.key(seed)
    ks = jax.random.split(key, 24)
    f32 = jnp.float32
    nrm = lambda k, shape, s: jax.random.normal(k, shape, f32) * s
    return {
        "x_prompt": nrm(ks[0], (BATCH, SEQ, D_MODEL), 1.0),
        "x_sample": nrm(ks[1], (DEC_BATCH, DEC_SEQ, D_MODEL), 1.0),
        "c_prompt": nrm(ks[2], (BATCH, D_MODEL), 1.0),
        "c_sample": nrm(ks[3], (DEC_BATCH, D_MODEL), 1.0),
        "cache_k": nrm(ks[4], (DEPTH, DEC_BATCH, WINDOW, N_KV_HEADS, HEAD_DIM), 1.0),
        "cache_v": nrm(ks[5], (DEPTH, DEC_BATCH, WINDOW, N_KV_HEADS, HEAD_DIM), 1.0),
        "state_pool": nrm(ks[6], (DEPTH, DEC_BATCH, POOL_STATE, POOL_WIDTH), 1.0),
        "w_ada": nrm(ks[7], (DEPTH, D_MODEL, N_MOD * D_MODEL), D_MODEL ** -0.5),
        "b_ada": nrm(ks[8], (DEPTH, N_MOD * D_MODEL), 0.02),
        "norm_gain": 1.0 + nrm(ks[9], (DEPTH, N_SUBLAYERS, D_MODEL), 0.02),
        "w_in": nrm(ks[10], (DEPTH, D_MODEL, IN_WIDTH), D_MODEL ** -0.5),
        "w_out": nrm(ks[11], (DEPTH, MIX_WIDTH, D_MODEL), MIX_WIDTH ** -0.5),
        "sinks": nrm(ks[12], (DEPTH, N_HEADS), 1.0),
        "rel_bias": nrm(ks[13], (N_BUCKETS, N_HEADS), 0.5),
        "pool_w": nrm(ks[14], (DEPTH, len(POOL_SIZES), POOL_GROUP_WIDTH, POOL_GROUP_WIDTH),
                      POOL_GROUP_WIDTH ** -0.5),
        "pool_scale": 1.0 + nrm(ks[15], (DEPTH, POOL_WIDTH), 0.1),
        "ffn1_wg": nrm(ks[16], (DEPTH, D_MODEL, D_FF), D_MODEL ** -0.5),
        "ffn1_wu": nrm(ks[17], (DEPTH, D_MODEL, D_FF), D_MODEL ** -0.5),
        "ffn1_wd": nrm(ks[18], (DEPTH, D_FF, D_MODEL), D_FF ** -0.5),
        "ffn2_wg": nrm(ks[19], (DEPTH, D_MODEL, D_FF), D_MODEL ** -0.5),
        "ffn2_wu": nrm(ks[20], (DEPTH, D_MODEL, D_FF), D_MODEL ** -0.5),
        "ffn2_wd": nrm(ks[21], (DEPTH, D_FF, D_MODEL), D_FF ** -0.5),
        "final_gain": 1.0 + nrm(ks[22], (D_MODEL,), 0.02),
    }


def reference(x_prompt, x_sample, c_prompt, c_sample, cache_k, cache_v, state_pool,
              w_ada, b_ada, norm_gain, w_in, w_out, sinks, rel_bias, pool_w, pool_scale,
              ffn1_wg, ffn1_wu, ffn1_wd, ffn2_wg, ffn2_wu, ffn2_wd, final_gain):

    def prompt_mixer(l, z):
        B, S = z.shape[:2]
        q, k, v, u = split_projection(z)
        k = k.reshape(B, S, N_KV_HEADS, HEAD_DIM)
        v = v.reshape(B, S, N_KV_HEADS, HEAD_DIM)
        attn = prompt_attention(q.reshape(B, S, N_HEADS, HEAD_DIM), k, v, sinks[l], rel_bias)
        pool = multiscale_pool(u, 0, 0, pool_w[l], pool_scale[l])
        return (jnp.concatenate([attn, pool], axis=-1),
                (k[:, -WINDOW:], v[:, -WINDOW:], u[:, -POOL_STATE:]))

    def sample_mixer(l, z):
        B, T = z.shape[:2]
        q, k, v, u = split_projection(z)
        k_all = jnp.concatenate([cache_k[l], k.reshape(B, T, N_KV_HEADS, HEAD_DIM)], axis=1)
        v_all = jnp.concatenate([cache_v[l], v.reshape(B, T, N_KV_HEADS, HEAD_DIM)], axis=1)
        key_valid = jnp.ones((1, WINDOW + T), dtype=bool)
        attn = window_attention(q.reshape(B, 1, T, N_HEADS, HEAD_DIM), k_all[:, None],
                                v_all[:, None], key_valid, WINDOW, sinks[l], rel_bias)[:, 0]
        u_ext = jnp.concatenate([state_pool[l], u], axis=1)
        pool = multiscale_pool(u_ext, PAST_LEN - POOL_STATE, POOL_STATE, pool_w[l], pool_scale[l])
        return (jnp.concatenate([attn, pool], axis=-1),
                (k_all[:, -WINDOW:], v_all[:, -WINDOW:], u_ext[:, -POOL_STATE:]))

    y_prompt, st_p = run_trunk(x_prompt, c_prompt, prompt_mixer, w_ada, b_ada, norm_gain, w_in,
                               w_out, ffn1_wg, ffn1_wu, ffn1_wd, ffn2_wg, ffn2_wu, ffn2_wd,
                               final_gain)
    y_sample, st_s = run_trunk(x_sample, c_sample, sample_mixer, w_ada, b_ada, norm_gain, w_in,
                               w_out, ffn1_wg, ffn1_wu, ffn1_wd, ffn2_wg, ffn2_wu, ffn2_wd,
                               final_gain)
    new_k_prompt = jnp.stack([s[0] for s in st_p])
    new_v_prompt = jnp.stack([s[1] for s in st_p])
    new_pool_prompt = jnp.stack([s[2] for s in st_p])
    new_k_sample = jnp.stack([s[0] for s in st_s])
    new_v_sample = jnp.stack([s[1] for s in st_s])
    new_pool_sample = jnp.stack([s[2] for s in st_s])
    return (y_prompt, y_sample, new_k_prompt, new_v_prompt, new_pool_prompt,
            new_k_sample, new_v_sample, new_pool_sample)
```

```cpp
#include <hip/hip_runtime.h>
#include <hip/hip_cooperative_groups.h>
#include <cstdio>
#include <cstdint>
namespace cg = cooperative_groups;
namespace pg8 {
#define PG8_LAS __attribute__((address_space(3)))
typedef unsigned short bf16_t;
typedef short bf16x8 __attribute__((ext_vector_type(8)));
typedef float f32x4 __attribute__((ext_vector_type(4)));
typedef unsigned u32x4 __attribute__((ext_vector_type(4)));
constexpr int BM = 256, BK = 64, HALF = 128, HTB = HALF * BK * 2  , STAGE_BYTES = 8 * HTB, NXCD = 8, WGM = 8;

__host__ __device__ __forceinline__ int lds_byte(int r, int c) { const int st = (r >> 4) * 2 + (c >> 5), rr = r & 15, cc = c & 31, ob = rr * 64 + cc * 2; return st * 1024 + (ob ^ (((ob >> 9) & 1) << 5)); }
__host__ __device__ __forceinline__ void stage_rc(int b, int& R, int& C) { const int st = b / 1024, sb = b % 1024, swz = sb ^ (((sb >> 9) & 1) << 5); R = (st >> 1) * 16 + swz / 64; C = (st & 1) * 32 + (swz % 64) / 2; }
__host__ __device__ __forceinline__ int perm32(int rho) { const int n = rho >> 4, i = rho & 15; return 8 * (i >> 2) + 4 * n + (i & 3); }

struct Unit { int pm, pn, k0; };
struct Gemm { const bf16_t* A; const bf16_t* Bt; int M, N, K; };

struct StaticOrder {
    static constexpr bool SPLIT = false;
    int nM, nN, nwg, G, c;
    __host__ __device__ void init(int M, int N, int G_, int c_, int K_ = 1024, int half_pm_ = -1) { nM = M / BM; nN = N / BM; nwg = nM * nN; G = G_; c = c_; (void)K_; (void)half_pm_; }
    __host__ __device__ bool next(int i, Unit& u) const {
        const long L = (long)i * G + c; if (L >= nwg) return false;
        int wgid = (int)L; { const int q = nwg / NXCD, r = nwg % NXCD, xcd = wgid % NXCD, off = wgid / NXCD; wgid = (xcd < r ? xcd * (q + 1) : r * (q + 1) + (xcd - r) * q) + off; }
        const int nig = WGM * nN, gid = wgid / nig, fm = gid * WGM, gsz = (nM - fm) < WGM ? (nM - fm) : WGM;
        u.pm = fm + ((wgid % nig) % gsz); u.pn = (wgid % nig) / gsz; u.k0 = 0; return true;
    }
    __device__ __forceinline__ void a_ready(const Unit&) const {}
    __device__ __forceinline__ void done(const Unit&) const {}
};

__device__ __forceinline__ unsigned cvt_pk_bf16(float lo, float hi) { unsigned r; asm volatile("v_cvt_pk_bf16_f32 %0, %1, %2" : "=v"(r) : "v"(lo), "v"(hi)); return r; }
typedef float f32x2 __attribute__((ext_vector_type(2)));
template <class Epi, class Sched, bool ALIGN_EPI = false, bool SP2 = false>
__device__ __forceinline__ void gemm_phase(PG8_LAS unsigned char* lds, const Gemm g, const Sched& S, const Epi& E, const int tid_in) {
    const int tid = tid_in, wid = __builtin_amdgcn_readfirstlane(tid >> 6), lane = tid & 63, wr = wid >> 2, wc = wid & 3, fr = lane & 15, fq = lane >> 4;
    const int K = g.K;
    unsigned voffA[2], voffB[2];
#pragma unroll
    for (int i = 0; i < 2; ++i) { int R, C; stage_rc(tid * 16 + i * 8192, R, C); const int Rb = Epi::PERM ? ((R & ~31) + perm32(R & 31)) : R;
        voffA[i] = (unsigned)(R * K + C) * 2u; voffB[i] = (unsigned)(Rb * K + C) * 2u; }
    const size_t kstep = (size_t)(BK * 2);
    const size_t hstep = (size_t)HALF * K * 2;
    const size_t tstep = 2 * hstep;
    const unsigned ldsw = (unsigned)wid * 1024u;
    const int aoff = lds_byte(wr * 64 + fr, fq * 8), boff = lds_byte(wc * 32 + fr, fq * 8);
#define PG8_SA(b, h) (((b) * 2 + (h)) * HTB)
#define PG8_SB(b, h) ((4 + (b) * 2 + (h)) * HTB)
#define PG8_STAGE(bufoff, gbase, voff) do { _Pragma("unroll") for (int _i = 0; _i < 2; ++_i) \
        __builtin_amdgcn_global_load_lds((const unsigned*)((const char*)(gbase) + (voff)[_i]), (PG8_LAS unsigned*)(lds + (bufoff) + ldsw + _i * 8192), 16, 0, 0); } while (0)
#define PG8_LDA(dst, b, h) do { _Pragma("unroll") for (int m = 0; m < 4; ++m) _Pragma("unroll") for (int k = 0; k < 2; ++k) dst[m][k] = *(const PG8_LAS bf16x8*)(lds + PG8_SA(b, h) + aoff + m * 2048 + k * 1024); } while (0)
#define PG8_LDB(dst, b, h) do { _Pragma("unroll") for (int n = 0; n < 2; ++n) _Pragma("unroll") for (int k = 0; k < 2; ++k) dst[n][k] = *(const PG8_LAS bf16x8*)(lds + PG8_SB(b, h) + boff + n * 2048 + k * 1024); } while (0)
#define PG8_MMA(ai, bj, At, Bt) do { __builtin_amdgcn_s_setprio(1); _Pragma("unroll") for (int m = 0; m < 4; ++m) _Pragma("unroll") for (int n = 0; n < 2; ++n) _Pragma("unroll") for (int k = 0; k < 2; ++k) \
        acc[ai][bj][m][n] = __builtin_amdgcn_mfma_f32_16x16x32_bf16(Bt[n][k], At[m][k], acc[ai][bj][m][n], 0, 0, 0); __builtin_amdgcn_s_setprio(0); } while (0)
#define PG8_WAIT_V(n) asm volatile("s_waitcnt vmcnt(" #n ")" ::: "memory")
#define PG8_WAIT_L(n) asm volatile("s_waitcnt lgkmcnt(" #n ")" ::: "memory")
#define PG8_BAR __builtin_amdgcn_s_barrier()
#define PG8_SCHED __builtin_amdgcn_sched_barrier(0)
    Unit cur, nxt; int ui = 0;
    if (!S.next(0, cur)) return;
    f32x4 acc[2][2][4][2];
#pragma unroll
    for (int a = 0; a < 2; ++a)
#pragma unroll
        for (int b = 0; b < 2; ++b)
#pragma unroll
            for (int m = 0; m < 4; ++m)
#pragma unroll
                for (int n = 0; n < 2; ++n) acc[a][b][m][n] = (f32x4){0.f, 0.f, 0.f, 0.f};
    bf16x8 At[4][2], B0[2][2], B1[2][2];
    const char* cA = (const char*)g.A + (size_t)cur.pm * tstep + (size_t)cur.k0 * kstep; const char* cB = (const char*)g.Bt + (size_t)cur.pn * tstep + (size_t)cur.k0 * kstep;
    S.a_ready(cur);
    if constexpr (SP2) {
        PG8_STAGE(PG8_SB(0, 0), cB, voffB); PG8_STAGE(PG8_SB(0, 1), cB + hstep, voffB); PG8_STAGE(PG8_SA(0, 0), cA, voffA); PG8_STAGE(PG8_SA(0, 1), cA + hstep, voffA);
        if (wr == 1) PG8_BAR;
        PG8_WAIT_V(2); PG8_BAR;
        PG8_STAGE(PG8_SB(1, 0), cB + kstep, voffB); PG8_STAGE(PG8_SA(1, 0), cA + kstep, voffA); PG8_STAGE(PG8_SB(1, 1), cB + hstep + kstep, voffB);
        PG8_WAIT_V(6); PG8_BAR;
    } else {
        PG8_STAGE(PG8_SB(0, 0), cB, voffB); PG8_STAGE(PG8_SA(0, 0), cA, voffA); PG8_STAGE(PG8_SB(0, 1), cB + hstep, voffB); PG8_STAGE(PG8_SA(0, 1), cA + hstep, voffA);
        if (wr == 1) PG8_BAR;
        PG8_WAIT_V(4); PG8_BAR;
        PG8_STAGE(PG8_SB(1, 0), cB + kstep, voffB); PG8_STAGE(PG8_SA(1, 0), cA + kstep, voffA); PG8_STAGE(PG8_SB(1, 1), cB + hstep + kstep, voffB);
        PG8_WAIT_V(6); PG8_BAR;
    }
    for (;;) {
        const bool has_next = S.next(ui + 1, nxt);
        const char* nA = has_next ? (const char*)g.A + (size_t)nxt.pm * tstep + (size_t)nxt.k0 * kstep : cA; const char* nB = has_next ? (const char*)g.Bt + (size_t)nxt.pn * tstep + (size_t)nxt.k0 * kstep : cB;
        const bool full = (cur.pm != 128); const int nt = (Sched::SPLIT && !full) ? 4 : K / BK;
        for (int t = 0; t < nt; t += 2) {
            const bool last = (t == nt - 2);
            const char* a1 = cA + (size_t)(t + 1) * kstep;
            const char* a2 = last ? nA : cA + (size_t)(t + 2) * kstep; const char* b2 = last ? nB : cB + (size_t)(t + 2) * kstep;
            const char* a3 = a2 + kstep; const char* b3 = b2 + kstep;
            if (last && has_next) S.a_ready(nxt);
            if constexpr (SP2) {
            PG8_LDB(B0, 0, 0); PG8_LDB(B1, 0, 1); PG8_SCHED; PG8_LDA(At, 0, 0); PG8_STAGE(PG8_SA(1, 1), a1 + hstep, voffA);
            PG8_WAIT_V(8); PG8_WAIT_L(0); PG8_BAR; PG8_MMA(0, 0, At, B0); PG8_MMA(0, 1, At, B1); PG8_BAR; PG8_SCHED;
            PG8_LDA(At, 0, 1); PG8_STAGE(PG8_SB(0, 0), b2, voffB); PG8_STAGE(PG8_SB(0, 1), b2 + hstep, voffB); PG8_STAGE(PG8_SA(0, 0), a2, voffA);
            PG8_WAIT_V(8); PG8_WAIT_L(0); PG8_BAR; if (full) { PG8_MMA(1, 0, At, B0); PG8_MMA(1, 1, At, B1); } PG8_BAR; PG8_SCHED;
            PG8_LDB(B0, 1, 0); PG8_LDB(B1, 1, 1); PG8_SCHED; PG8_LDA(At, 1, 0); PG8_STAGE(PG8_SA(0, 1), a2 + hstep, voffA);
            PG8_WAIT_V(8); PG8_WAIT_L(0); PG8_BAR; PG8_MMA(0, 0, At, B0); PG8_MMA(0, 1, At, B1); PG8_BAR; PG8_SCHED;
            PG8_LDA(At, 1, 1); PG8_STAGE(PG8_SB(1, 0), b3, voffB); PG8_STAGE(PG8_SB(1, 1), b3 + hstep, voffB); PG8_STAGE(PG8_SA(1, 0), a3, voffA);
            PG8_WAIT_V(8); PG8_WAIT_L(0); PG8_BAR; if (full) { PG8_MMA(1, 0, At, B0); PG8_MMA(1, 1, At, B1); } PG8_BAR; PG8_SCHED;
            } else {
            PG8_LDB(B0, 0, 0); PG8_SCHED; PG8_LDA(At, 0, 0); PG8_STAGE(PG8_SA(1, 1), a1 + hstep, voffA);
            PG8_WAIT_L(8); PG8_BAR; PG8_WAIT_L(0); PG8_MMA(0, 0, At, B0); PG8_BAR; PG8_SCHED;
            PG8_LDB(B1, 0, 1); PG8_STAGE(PG8_SB(0, 0), b2, voffB);
            PG8_BAR; PG8_WAIT_L(0); PG8_MMA(0, 1, At, B1); PG8_BAR;
            PG8_LDA(At, 0, 1); PG8_STAGE(PG8_SA(0, 0), a2, voffA);
            PG8_BAR; PG8_WAIT_L(0); PG8_MMA(1, 0, At, B0); PG8_BAR; PG8_SCHED;
            PG8_STAGE(PG8_SB(0, 1), b2 + hstep, voffB);
            PG8_WAIT_V(6); PG8_BAR; PG8_MMA(1, 1, At, B1); PG8_BAR;
            PG8_LDB(B0, 1, 0); PG8_SCHED; PG8_LDA(At, 1, 0); PG8_STAGE(PG8_SA(0, 1), a2 + hstep, voffA);
            PG8_WAIT_L(8); PG8_BAR; PG8_WAIT_L(0); PG8_MMA(0, 0, At, B0); PG8_BAR; PG8_SCHED;
            PG8_LDB(B1, 1, 1); PG8_STAGE(PG8_SB(1, 0), b3, voffB);
            PG8_BAR; PG8_WAIT_L(0); PG8_MMA(0, 1, At, B1); PG8_BAR;
            PG8_LDA(At, 1, 1); PG8_STAGE(PG8_SA(1, 0), a3, voffA);
            PG8_BAR; PG8_WAIT_L(0); PG8_MMA(1, 0, At, B0); PG8_BAR; PG8_SCHED;
            PG8_STAGE(PG8_SB(1, 1), b3 + hstep, voffB);
            PG8_WAIT_V(6); PG8_BAR; PG8_MMA(1, 1, At, B1); PG8_BAR;
            }
        }
        if constexpr (ALIGN_EPI) { if (wr == 0) PG8_BAR; }
        if constexpr (!Epi::AFTER_DRAIN) { E(acc, cur, wr, wc, fr, fq); S.done(cur); }
        if (!has_next) break;
#pragma unroll
        for (int a = 0; a < 2; ++a)
#pragma unroll
            for (int b = 0; b < 2; ++b)
#pragma unroll
                for (int m = 0; m < 4; ++m)
#pragma unroll
                    for (int n = 0; n < 2; ++n) acc[a][b][m][n] = (f32x4){0.f, 0.f, 0.f, 0.f};
        cur = nxt; cA = nA; cB = nB; ++ui;
        if constexpr (ALIGN_EPI) { if (wr == 1) PG8_BAR; }
    }
    PG8_WAIT_V(0);
    if constexpr (!ALIGN_EPI) { if (wr == 0) PG8_BAR; }
    PG8_BAR;
    if constexpr (Epi::AFTER_DRAIN) { E.fused(acc, cur, wr, wc, fr, fq, lds, wid, lane); S.done(cur); }
#undef PG8_SA
#undef PG8_SB
#undef PG8_STAGE
#undef PG8_LDA
#undef PG8_LDB
#undef PG8_MMA
#undef PG8_WAIT_V
#undef PG8_WAIT_L
#undef PG8_BAR
#undef PG8_SCHED
}
}
#ifndef PG8_SP2
#define PG8_SP2 true
#endif
#ifndef PG8_ALIGN
#define PG8_ALIGN true
#endif
#ifndef N_LAUNCH_PER_PHASE
#define N_LAUNCH_PER_PHASE 0
#endif

#define DI __device__ __forceinline__
#define LAS __attribute__((address_space(3)))
typedef unsigned short bf16_t;
typedef short bf16x8 __attribute__((ext_vector_type(8)));
typedef short s16x4 __attribute__((ext_vector_type(4)));
typedef float f32x4 __attribute__((ext_vector_type(4)));
typedef float f32x2 __attribute__((ext_vector_type(2)));
typedef float f32x16 __attribute__((ext_vector_type(16)));
typedef unsigned u32x4 __attribute__((ext_vector_type(4)));
typedef unsigned u32x2 __attribute__((ext_vector_type(2)));
typedef __bf16 bf16x2_t __attribute__((ext_vector_type(2)));

constexpr int TP = 32768, TS = 128, TT = TP + TS, MPAD = 33024;
constexpr int DM = 1024, FF = 2816, INW = 1280, NMOD = 9216, MODLD = 2 * NMOD;
constexpr int SEQ = 4096;
constexpr float EPS = 1e-6f, LOG2E = 1.4426950408889634f, C2 = 0.125f * 1.4426950408889634f;
constexpr int TBLD = 132;
constexpr size_t O_Y = 0, O_KP = 33685504, O_VP = 33947648, O_PP = 34209792, O_KS = 34332672, O_VS = 38526976, O_PS = 42721280, O_END = 44687360;
constexpr size_t MiB = 1u << 20;
constexpr size_t WS_BAR = 65536, WS_BAR_BYTES = 16384;
constexpr size_t WS_TB = 0, WS_CS = 1 * MiB, WS_MOD = 2 * MiB, WS_WADA = 12 * MiB, WS_L0 = 48 * MiB, LAYER_BYTES = 38 * MiB;
constexpr size_t LW_GU1 = 0, LW_D1 = 11 * MiB, LW_IN = 16 * MiB + MiB / 2, LW_OUT = 19 * MiB, LW_GU2 = 21 * MiB, LW_D2 = 32 * MiB, LW_POOL = 37 * MiB + MiB / 2;
constexpr size_t WS_X = 124 * MiB, WS_H = 253 * MiB, WS_ACT = 318 * MiB, WS_Z = WS_ACT, WS_MIX = WS_ACT + 96 * MiB, WS_END = 496 * MiB;
static_assert(WS_X + (size_t)MPAD * DM * 4 <= WS_H && WS_H + (size_t)MPAD * DM * 2 <= WS_ACT && WS_ACT + (size_t)MPAD * FF * 2 <= WS_END, "ws map");
static_assert(WS_Z + (size_t)MPAD * INW * 2 <= WS_MIX && WS_MIX + (size_t)MPAD * DM * 2 <= WS_END, "ws map 2");
static_assert(WS_MOD + (size_t)136 * MODLD * 4 <= WS_WADA && WS_WADA + (size_t)MODLD * DM * 2 <= WS_L0 && WS_L0 + 2 * LAYER_BYTES <= WS_X, "ws map 3");
constexpr int LDS_BYTES = 147456;
constexpr int NPH = 23;

struct Params { const float* in[23]; float* out; unsigned char* ws; int ph_lo, ph_hi; };

DI float bf2f(bf16_t b) { return __uint_as_float((unsigned)b << 16); }
DI unsigned pk2(float lo, float hi) { f32x2 v = {lo, hi}; bf16x2_t b = __builtin_convertvector(v, bf16x2_t); return __builtin_bit_cast(unsigned, b); }
DI float wave_sum(float v) {
#pragma unroll
    for (int o = 1; o < 64; o <<= 1) v += __shfl_xor(v, o);
    return v;
}
DI float wave_max(float v) {
#pragma unroll
    for (int o = 1; o < 64; o <<= 1) v = fmaxf(v, __shfl_xor(v, o));
    return v;
}
DI int crow(int r, int hi) { return (r & 3) + 8 * (r >> 2) + 4 * hi; }
DI f32x4 bf4_to_f4(const bf16_t* p) { const u32x2 v = *(const u32x2*)p; return (f32x4){__uint_as_float(v.x << 16), __uint_as_float(v.x & 0xffff0000u), __uint_as_float(v.y << 16), __uint_as_float(v.y & 0xffff0000u)}; }
#define MFMA32(a, b, c) __builtin_amdgcn_mfma_f32_32x32x16_bf16((a), (b), (c), 0, 0, 0)

struct EpiStoreBf16 {
    static constexpr bool PERM = true, AFTER_DRAIN = false;
    bf16_t* O; int ldc;
    DI void operator()(const pg8::f32x4 (&acc)[2][2][4][2], const pg8::Unit& u, int wr, int wc, int fr, int fq) const {
        const int row0 = u.pm * 256 + wr * 64 + fr, col0 = u.pn * 256 + wc * 32 + 8 * fq;
#pragma unroll
        for (int ai = 0; ai < 2; ++ai)
#pragma unroll
            for (int m = 0; m < 4; ++m) { bf16_t* rowp = O + (size_t)(row0 + ai * 128 + m * 16) * ldc + col0;
#pragma unroll
                for (int bj = 0; bj < 2; ++bj) { const f32x4 v0 = acc[ai][bj][m][0], v1 = acc[ai][bj][m][1];
                    u32x4 w; w.x = pk2(v0[0], v0[1]); w.y = pk2(v0[2], v0[3]); w.z = pk2(v1[0], v1[1]); w.w = pk2(v1[2], v1[3]);
                    *(u32x4*)(rowp + bj * 128) = w; } }
    }
};
DI float silu_mul(float g, float u) { return g * u * __builtin_amdgcn_rcpf(1.0f + __builtin_amdgcn_exp2f(-g * LOG2E)); }
struct EpiSwiGLU {
    static constexpr bool PERM = true, AFTER_DRAIN = false;
    bf16_t* O;
    DI void operator()(const pg8::f32x4 (&acc)[2][2][4][2], const pg8::Unit& u, int wr, int wc, int fr, int fq) const {
        const int row0 = u.pm * 256 + wr * 64 + fr, col0 = u.pn * 128 + wc * 32 + 8 * fq;
#pragma unroll
        for (int ai = 0; ai < 2; ++ai)
#pragma unroll
            for (int m = 0; m < 4; ++m) { bf16_t* rowp = O + (size_t)(row0 + ai * 128 + m * 16) * FF + col0;
                const f32x4 g0 = acc[ai][0][m][0], g1 = acc[ai][0][m][1], u0 = acc[ai][1][m][0], u1 = acc[ai][1][m][1];
                u32x4 w; w.x = pk2(silu_mul(g0[0], u0[0]), silu_mul(g0[1], u0[1])); w.y = pk2(silu_mul(g0[2], u0[2]), silu_mul(g0[3], u0[3]));
                w.z = pk2(silu_mul(g1[0], u1[0]), silu_mul(g1[1], u1[1])); w.w = pk2(silu_mul(g1[2], u1[2]), silu_mul(g1[3], u1[3]));
                *(u32x4*)rowp = w; }
    }
};
struct SplitOrder {
    static constexpr bool SPLIT = true;
    pg8::StaticOrder base; int nmain, nN, nchunk, G, c;
    DI void init(int N, int K, int G_, int c_) { base.init(TP, N, G_, c_, K, -1); nN = N / 256; nmain = (TP / 256) * nN; nchunk = K / 256; G = G_; c = c_; }
    DI bool next(int i, pg8::Unit& u) const {
        const int L = i * G + c;
        if (L < nmain) return base.next(i, u);
        const int s = L - nmain; if (s >= nN * nchunk) return false;
        u.pm = TP / 256; u.pn = s % nN; u.k0 = (s / nN) * 4; return true;
    }
    DI void a_ready(const pg8::Unit&) const {}
    DI void done(const pg8::Unit&) const {}
};
struct EpiResid {
    static constexpr bool PERM = true, AFTER_DRAIN = false;
    const float* xin_p; const float* xin_s; float* X; const float* gate; float coef;
    DI void operator()(const pg8::f32x4 (&acc)[2][2][4][2], const pg8::Unit& u, int wr, int wc, int fr, int fq) const {
        const int row0 = u.pm * 256 + wr * 64 + fr, col0 = u.pn * 256 + wc * 32 + 8 * fq;
        if (u.pm == TP / 256) {
#pragma unroll
            for (int m = 0; m < 4; ++m) { const int row = row0 + m * 16; const float* gp = gate + (size_t)(8 + row - TP) * MODLD; float* dst = X + (size_t)row * DM;
#pragma unroll
                for (int bj = 0; bj < 2; ++bj)
#pragma unroll
                    for (int n = 0; n < 2; ++n) { const int col = col0 + bj * 128 + n * 4; const f32x4 gv = *(const f32x4*)(gp + col); const f32x4 v = (gv * coef) * acc[0][bj][m][n];
                        unsafeAtomicAdd(dst + col + 0, v[0]); unsafeAtomicAdd(dst + col + 1, v[1]); unsafeAtomicAdd(dst + col + 2, v[2]); unsafeAtomicAdd(dst + col + 3, v[3]); } }
            return;
        }
        const float* gp = gate + (size_t)(u.pm >> 4) * MODLD;
        f32x4 gv[2][2];
#pragma unroll
        for (int bj = 0; bj < 2; ++bj)
#pragma unroll
            for (int n = 0; n < 2; ++n) gv[bj][n] = *(const f32x4*)(gp + col0 + bj * 128 + n * 4) * coef;
#pragma unroll
        for (int am = 0; am < 4; ++am) {
            f32x4 xv[2][2][2];
#pragma unroll
            for (int mm = 0; mm < 2; ++mm) { const int ai = am >> 1, m = (am & 1) * 2 + mm; const float* src = xin_p + (size_t)(row0 + ai * 128 + m * 16) * DM + col0;
#pragma unroll
                for (int bj = 0; bj < 2; ++bj) { xv[mm][bj][0] = *(const f32x4*)(src + bj * 128); xv[mm][bj][1] = *(const f32x4*)(src + bj * 128 + 4); } }
            asm volatile("" ::: "memory");
#pragma unroll
            for (int mm = 0; mm < 2; ++mm) { const int ai = am >> 1, m = (am & 1) * 2 + mm; float* dst = X + (size_t)(row0 + ai * 128 + m * 16) * DM + col0;
#pragma unroll
                for (int bj = 0; bj < 2; ++bj) { *(f32x4*)(dst + bj * 128) = xv[mm][bj][0] + gv[bj][0] * acc[ai][bj][m][0]; *(f32x4*)(dst + bj * 128 + 4) = xv[mm][bj][1] + gv[bj][1] * acc[ai][bj][m][1]; } }
            asm volatile("" ::: "memory");
        }
    }
};
struct EpiMod {
    static constexpr bool PERM = false, AFTER_DRAIN = false;
    float* mod; const float* bias;
    DI void operator()(const pg8::f32x4 (&acc)[2][2][4][2], const pg8::Unit& u, int wr, int wc, int fr, int fq) const {
        const int row0 = u.pm * 256 + wr * 64 + fr, col0 = u.pn * 256 + wc * 32 + 4 * fq;
#pragma unroll
        for (int ai = 0; ai < 2; ++ai)
#pragma unroll
            for (int m = 0; m < 4; ++m) { const int row = row0 + ai * 128 + m * 16;
                if (row < 136) {
#pragma unroll
                    for (int bj = 0; bj < 2; ++bj)
#pragma unroll
                        for (int n = 0; n < 2; ++n) { const int col = col0 + bj * 128 + n * 16;
                            *(f32x4*)(mod + (size_t)row * MODLD + col) = acc[ai][bj][m][n] + *(const f32x4*)(bias + col); } } }
    }
};
typedef const __attribute__((address_space(4))) Params* KP;
DI void transpose_item(const float* W, int K, int N, bf16_t* WT, int mode, LAS float* scr, int item, int lane) {
    const int nblk = N / 32, kb = item / nblk, nb = item % nblk, k0 = 64 * kb, n0 = 32 * nb;
#pragma unroll 8
    for (int i = 0; i < 32; ++i) { const int kk = 2 * i + (lane >> 5); scr[kk * 33 + (lane & 31)] = W[(size_t)(k0 + kk) * N + n0 + (lane & 31)]; }
    asm volatile("s_waitcnt lgkmcnt(0)" ::: "memory");
    int rbase = n0;
    if (mode == 1) rbase = (n0 >> 7) * 256 + (n0 & 127);
    if (mode == 2) rbase = (n0 >> 7) * 256 + 128 + (n0 & 127);
    const int c = lane & 7;
#pragma unroll
    for (int j = 0; j < 4; ++j) { const int n = (lane >> 3) + 8 * j; const LAS float* s = scr + (8 * c) * 33 + n;
        u32x4 o; o.x = pk2(s[0 * 33], s[1 * 33]); o.y = pk2(s[2 * 33], s[3 * 33]); o.z = pk2(s[4 * 33], s[5 * 33]); o.w = pk2(s[6 * 33], s[7 * 33]);
        *(u32x4*)(WT + (size_t)(rbase + n) * K + k0 + 8 * c) = o; }
    asm volatile("s_waitcnt lgkmcnt(0)" ::: "memory");
}
constexpr int I_ADA = (DM / 64) * (NMOD / 32), I_FU = (DM / 64) * (FF / 32), I_FD = (FF / 64) * (DM / 32), I_IN = (DM / 64) * (INW / 32), I_OUT = (DM / 64) * (DM / 32), I_POOL = 4 * 8;
constexpr int IPL = I_ADA + 4 * I_FU + 2 * I_FD + I_IN + I_OUT + I_POOL;
DI int t5_bucket(int n) {
    if (n < 16) return n;
    int b = 16;
    b += (n >= 19); b += (n >= 21); b += (n >= 24); b += (n >= 27); b += (n >= 31); b += (n >= 35); b += (n >= 40); b += (n >= 46);
    b += (n >= 52); b += (n >= 59); b += (n >= 67); b += (n >= 77); b += (n >= 87); b += (n >= 99); b += (n >= 113);
    return b;
}
DI void prologue(KP P, LAS unsigned char* lds, int gw, int NGW, int gtid, int GT, int wid, int lane) {
    LAS float* scr = (LAS float*)(lds + wid * 8448);
    for (int it = gw; it < 2 * IPL; it += NGW) {
        const int l = it / IPL; int r = it - l * IPL;
        unsigned char* wl = P->ws + WS_L0 + (size_t)l * LAYER_BYTES;
        const float* src; bf16_t* dst; int K, N, mode = 0;
        if (r < I_ADA) { src = P->in[7] + (size_t)l * DM * NMOD; K = DM; N = NMOD; dst = (bf16_t*)(P->ws + WS_WADA) + (size_t)l * NMOD * DM; }
        else if ((r -= I_ADA) < I_FU) { src = P->in[16] + (size_t)l * DM * FF; K = DM; N = FF; dst = (bf16_t*)(wl + LW_GU1); mode = 1; }
        else if ((r -= I_FU) < I_FU) { src = P->in[17] + (size_t)l * DM * FF; K = DM; N = FF; dst = (bf16_t*)(wl + LW_GU1); mode = 2; }
        else if ((r -= I_FU) < I_FD) { src = P->in[18] + (size_t)l * FF * DM; K = FF; N = DM; dst = (bf16_t*)(wl + LW_D1); }
        else if ((r -= I_FD) < I_IN) { src = P->in[10] + (size_t)l * DM * INW; K = DM; N = INW; dst = (bf16_t*)(wl + LW_IN); }
        else if ((r -= I_IN) < I_OUT) { src = P->in[11] + (size_t)l * DM * DM; K = DM; N = DM; dst = (bf16_t*)(wl + LW_OUT); }
        else if ((r -= I_OUT) < I_FU) { src = P->in[19] + (size_t)l * DM * FF; K = DM; N = FF; dst = (bf16_t*)(wl + LW_GU2); mode = 1; }
        else if ((r -= I_FU) < I_FU) { src = P->in[20] + (size_t)l * DM * FF; K = DM; N = FF; dst = (bf16_t*)(wl + LW_GU2); mode = 2; }
        else if ((r -= I_FU) < I_FD) { src = P->in[21] + (size_t)l * FF * DM; K = FF; N = DM; dst = (bf16_t*)(wl + LW_D2); }
        else { r -= I_FD; const int g = r >> 3; r &= 7; src = P->in[14] + (size_t)(l * 4 + g) * 16384; K = 128; N = 128; dst = (bf16_t*)(wl + LW_POOL) + (size_t)g * 16384; }
        transpose_item(src, K, N, dst, mode, scr, r, lane);
    }
    bf16_t* CS = (bf16_t*)(P->ws + WS_CS);
    for (int idx = gtid; idx < 256 * DM; idx += GT) {
        const int row = idx >> 10; float v = 0.f;
        if (row < 8) v = P->in[2][idx]; else if (row < 136) v = P->in[3][idx - 8 * DM];
        const float s = v / (1.0f + __expf(-v));
        CS[idx] = (bf16_t)(pk2(row < 136 ? s : 0.f, 0.f) & 0xffffu);
    }
    float* TB = (float*)(P->ws + WS_TB);
    for (int idx = gtid; idx < 8 * TBLD; idx += GT) { const int h = idx / TBLD, d = idx % TBLD; const int dd = d < 128 ? d : 128;
        TB[idx] = P->in[13][t5_bucket(dd) * 8 + h] * LOG2E; }
}

template <bool FINAL>
DI void norm_phase(const float* xp, const float* xs, const float* gain, const float* modsh, bf16_t* H, float* Y, int gw, int NGW, int lane, float* xcopy = nullptr) {
    for (int blk = gw; blk < TT / 16; blk += NGW) {
        const int row0 = blk * 16; const bool prompt = row0 < TP;
        f32x4 Gv[4], Sv[4];
        if (FINAL) {
#pragma unroll
            for (int j = 0; j < 4; ++j) { Gv[j] = ((const f32x4*)gain)[lane + 64 * j]; Sv[j] = (f32x4){0.f, 0.f, 0.f, 0.f}; }
        } else if (prompt) {
            const float* mp = modsh + (size_t)(row0 >> 12) * MODLD;
#pragma unroll
            for (int j = 0; j < 4; ++j) { Gv[j] = ((const f32x4*)gain)[lane + 64 * j] * (((const f32x4*)(mp + DM))[lane + 64 * j] + 1.0f); Sv[j] = ((const f32x4*)mp)[lane + 64 * j]; }
        }
        for (int r = 0; r < 16; ++r) {
            const int row = row0 + r;
            if (!FINAL && !prompt) {
                const float* mp = modsh + (size_t)(8 + row - TP) * MODLD;
#pragma unroll
                for (int j = 0; j < 4; ++j) { Gv[j] = ((const f32x4*)gain)[lane + 64 * j] * (((const f32x4*)(mp + DM))[lane + 64 * j] + 1.0f); Sv[j] = ((const f32x4*)mp)[lane + 64 * j]; }
            }
            const float* xr = row < TP ? xp + (size_t)row * DM : xs + (size_t)(row - TP) * DM;
            f32x4 v[4]; float ss = 0.f;
#pragma unroll
            for (int j = 0; j < 4; ++j) { v[j] = ((const f32x4*)xr)[lane + 64 * j]; ss += (v[j].x * v[j].x + v[j].y * v[j].y) + (v[j].z * v[j].z + v[j].w * v[j].w); }
            ss = wave_sum(ss);
            if (!FINAL && !prompt && xcopy) {
#pragma unroll
                for (int j = 0; j < 4; ++j) ((f32x4*)(xcopy + (size_t)row * DM))[lane + 64 * j] = v[j];
            }
            const float rstd = 1.0f / sqrtf(ss * (1.0f / DM) + EPS);
            if (FINAL) {
#pragma unroll
                for (int j = 0; j < 4; ++j) ((f32x4*)(Y + (size_t)row * DM))[lane + 64 * j] = v[j] * rstd * Gv[j];
            } else {
#pragma unroll
                for (int j = 0; j < 4; ++j) { const f32x4 h = v[j] * rstd * Gv[j] + Sv[j]; u32x2 w; w.x = pk2(h.x, h.y); w.y = pk2(h.z, h.w);
                    ((u32x2*)(H + (size_t)row * DM))[lane + 64 * j] = w; }
            }
        }
    }
}

constexpr int KS_LD = 72, VT_LD = 264;
constexpr int ATT_KS = 0, ATT_VT = 256 * KS_LD * 2, ATT_TB = ATT_VT + 64 * VT_LD * 2;
DI void attn_unit(LAS unsigned char* lds, const bf16_t* Z, bf16_t* MIX, const float* TB, const float* sinks_l, int b, int n, int kvh, int tid) {
    const int lane = tid & 63, wid = tid >> 6, r = lane & 31, hh = lane >> 5;
    LAS bf16_t* Ks = (LAS bf16_t*)(lds + ATT_KS); LAS bf16_t* Vt = (LAS bf16_t*)(lds + ATT_VT); LAS float* tb = (LAS float*)(lds + ATT_TB);
    const int base = b * SEQ + n * 128;
#pragma unroll
    for (int i = 0; i < 4; ++i) {
        const int c = tid + 512 * i, key = c >> 3, part = c & 7;
        u32x4 kv = {0u, 0u, 0u, 0u}, vv = {0u, 0u, 0u, 0u};
        if (n > 0 || key >= 128) { const bf16_t* zr = Z + (size_t)(base - 128 + key) * INW + kvh * 64 + part * 8; kv = *(const u32x4*)(zr + 512); vv = *(const u32x4*)(zr + 640); }
        *(LAS u32x4*)(Ks + key * KS_LD + part * 8) = kv;
        LAS bf16_t* vd = Vt + (part * 8) * VT_LD + key;
        vd[0 * VT_LD] = (bf16_t)(vv.x & 0xffffu); vd[1 * VT_LD] = (bf16_t)(vv.x >> 16); vd[2 * VT_LD] = (bf16_t)(vv.y & 0xffffu); vd[3 * VT_LD] = (bf16_t)(vv.y >> 16);
        vd[4 * VT_LD] = (bf16_t)(vv.z & 0xffffu); vd[5 * VT_LD] = (bf16_t)(vv.z >> 16); vd[6 * VT_LD] = (bf16_t)(vv.w & 0xffffu); vd[7 * VT_LD] = (bf16_t)(vv.w >> 16);
    }
    for (int i = tid; i < 4 * TBLD; i += 512) tb[i] = TB[kvh * 4 * TBLD + i];
    const int hl = wid >> 1, h = kvh * 4 + hl;
    const float sink2 = sinks_l[h] * LOG2E;
    LAS const float* tbh = tb + hl * TBLD;
    bf16x8 qf[4];
    {   const bf16_t* qrow = Z + (size_t)(base + (wid & 1) * 64 + r) * INW + h * 64 + 8 * hh;
#pragma unroll
        for (int c = 0; c < 4; ++c) qf[c] = *(const bf16x8*)(qrow + 16 * c); }
    __syncthreads();
#pragma unroll 1
    for (int sub = 0; sub < 2; ++sub) {
        const int qoff = (wid & 1) * 64 + sub * 32, kt0 = qoff >> 5, q = qoff + r;
        f32x16 sc[5];
#pragma unroll
        for (int t = 0; t < 5; ++t) {
#pragma unroll
            for (int i = 0; i < 16; ++i) sc[t][i] = 0.f;
#pragma unroll
            for (int c = 0; c < 4; ++c) { const bf16x8 a = *(LAS const bf16x8*)(Ks + (32 * (kt0 + t) + r) * KS_LD + 16 * c + 8 * hh); sc[t] = MFMA32(a, qf[c], sc[t]); }
        }
        if (sub == 0) {
            const bf16_t* qrow = Z + (size_t)(base + q + 32) * INW + h * 64 + 8 * hh;
#pragma unroll
            for (int c = 0; c < 4; ++c) qf[c] = *(const bf16x8*)(qrow + 16 * c);
        }
        float m = -INFINITY;
        const int rel = r - 4 * hh;
#pragma unroll
        for (int t = 0; t < 5; ++t) {
            const bool dead = (n == 0) && (kt0 + t < 4);
#pragma unroll
            for (int i = 0; i < 16; ++i) {
                const int cc = (i & 3) + 8 * (i >> 2);
                const int dist = 128 - 32 * t + rel - cc;
                bool valid = !dead;
                if (t == 0) valid = valid && (dist <= 128);
                if (t == 4) valid = valid && (dist >= 0);
                const float bias = tbh[(t == 0 || t == 4) ? (valid ? dist : 0) : dist];
                const float val = valid ? sc[t][i] * C2 + bias : -INFINITY;
                sc[t][i] = val; m = fmaxf(m, val);
            }
        }
        m = fmaxf(m, __shfl_xor(m, 32)); m = fmaxf(m, sink2);
        float sum = 0.f;
#pragma unroll
        for (int t = 0; t < 5; ++t)
#pragma unroll
            for (int i = 0; i < 16; ++i) { const float p = __builtin_amdgcn_exp2f(sc[t][i] - m); sc[t][i] = p; sum += p; }
        sum += __shfl_xor(sum, 32); sum += __builtin_amdgcn_exp2f(sink2 - m);
        const float inv = 1.0f / sum;
        f32x16 o[2];
#pragma unroll
        for (int i = 0; i < 16; ++i) { o[0][i] = 0.f; o[1][i] = 0.f; }
#pragma unroll
        for (int t = 0; t < 5; ++t)
#pragma unroll
            for (int s = 0; s < 2; ++s) {
                u32x4 pw; pw.x = pk2(sc[t][8 * s + 0], sc[t][8 * s + 1]); pw.y = pk2(sc[t][8 * s + 2], sc[t][8 * s + 3]); pw.z = pk2(sc[t][8 * s + 4], sc[t][8 * s + 5]); pw.w = pk2(sc[t][8 * s + 6], sc[t][8 * s + 7]);
                const bf16x8 pb = __builtin_bit_cast(bf16x8, pw);
#pragma unroll
                for (int dt = 0; dt < 2; ++dt) {
                    LAS const bf16_t* vr = Vt + (32 * dt + r) * VT_LD + 32 * (kt0 + t) + 16 * s + 4 * hh;
                    const s16x4 lo = *(LAS const s16x4*)vr, hi = *(LAS const s16x4*)(vr + 8);
                    const bf16x8 a = __builtin_shufflevector(lo, hi, 0, 1, 2, 3, 4, 5, 6, 7);
                    o[dt] = MFMA32(a, pb, o[dt]);
                }
            }
        bf16_t* orow = MIX + (size_t)(base + q) * DM + h * 64 + 4 * hh;
#pragma unroll
        for (int dt = 0; dt < 2; ++dt)
#pragma unroll
            for (int g4 = 0; g4 < 4; ++g4) { u32x2 w; w.x = pk2(o[dt][4 * g4 + 0] * inv, o[dt][4 * g4 + 1] * inv); w.y = pk2(o[dt][4 * g4 + 2] * inv, o[dt][4 * g4 + 3] * inv);
                *(u32x2*)(orow + 32 * dt + 8 * g4) = w; }
    }
    __syncthreads();
}

DI void sattn_task(LAS float* wl, const bf16_t* Z, const float* ck, const float* cv, bf16_t* MIX, const float* TB, const float* sinks_l, int s, int kvh, int lane) {
    const bf16_t* zrow = Z + (size_t)(TP + s) * INW;
#pragma unroll
    for (int hl = 0; hl < 4; ++hl) wl[hl * 64 + lane] = bf2f(zrow[(kvh * 4 + hl) * 64 + lane]) * C2;
    const float kn = bf2f(zrow[512 + kvh * 64 + lane]);
    asm volatile("s_waitcnt lgkmcnt(0)" ::: "memory");
    float sc[4][2];
#pragma unroll
    for (int kk = 0; kk < 2; ++kk) {
        const int j = lane + 64 * kk;
        const float* krow = ck + ((size_t)(s * 128 + j) * 2 + kvh) * 64;
        float a[4] = {0.f, 0.f, 0.f, 0.f};
#pragma unroll 8
        for (int d4 = 0; d4 < 16; ++d4) { const f32x4 kv = *(const f32x4*)(krow + 4 * d4);
#pragma unroll
            for (int hl = 0; hl < 4; ++hl) { const f32x4 qv = *(LAS const f32x4*)(wl + hl * 64 + 4 * d4); a[hl] += (kv.x * qv.x + kv.y * qv.y) + (kv.z * qv.z + kv.w * qv.w); } }
#pragma unroll
        for (int hl = 0; hl < 4; ++hl) sc[hl][kk] = a[hl] + TB[(kvh * 4 + hl) * TBLD + (128 - j)];
    }
    float pn[4];
#pragma unroll
    for (int hl = 0; hl < 4; ++hl) {
        const float sink2 = sinks_l[kvh * 4 + hl] * LOG2E;
        const float snew = wave_sum(kn * wl[hl * 64 + lane]) + TB[(kvh * 4 + hl) * TBLD + 0];
        float m = wave_max(fmaxf(sc[hl][0], sc[hl][1])); m = fmaxf(m, fmaxf(snew, sink2));
        const float p0 = __builtin_amdgcn_exp2f(sc[hl][0] - m), p1 = __builtin_amdgcn_exp2f(sc[hl][1] - m), pnw = __builtin_amdgcn_exp2f(snew - m);
        const float sum = wave_sum(p0 + p1) + pnw + __builtin_amdgcn_exp2f(sink2 - m);
        const float inv = 1.0f / sum;
        wl[256 + hl * TBLD + lane] = p0 * inv; wl[256 + hl * TBLD + 64 + lane] = p1 * inv; pn[hl] = pnw * inv;
    }
    asm volatile("s_waitcnt lgkmcnt(0)" ::: "memory");
    const int jg = lane >> 4, d4 = lane & 15;
    f32x4 o[4];
#pragma unroll
    for (int hl = 0; hl < 4; ++hl) o[hl] = (f32x4){0.f, 0.f, 0.f, 0.f};
    const float* vb = cv + ((size_t)(s * 128 + jg) * 2 + kvh) * 64 + 4 * d4;
#pragma unroll 8
    for (int i = 0; i < 32; ++i) { const f32x4 vv = *(const f32x4*)(vb + (size_t)i * 512);
#pragma unroll
        for (int hl = 0; hl < 4; ++hl) o[hl] += vv * wl[256 + hl * TBLD + 4 * i + jg]; }
    const f32x4 vn4 = bf4_to_f4(zrow + 640 + kvh * 64 + 4 * d4);
#pragma unroll
    for (int hl = 0; hl < 4; ++hl) {
#pragma unroll
        for (int e = 0; e < 4; ++e) { float v = o[hl][e]; v += __shfl_xor(v, 16); v += __shfl_xor(v, 32); o[hl][e] = v + pn[hl] * vn4[e]; }
        if (jg == 0) { u32x2 w; w.x = pk2(o[hl][0], o[hl][1]); w.y = pk2(o[hl][2], o[hl][3]); *(u32x2*)(MIX + (size_t)(TP + s) * DM + (kvh * 4 + hl) * 64 + 4 * d4) = w; }
    }
    asm volatile("s_waitcnt lgkmcnt(0)" ::: "memory");
}

constexpr int PU_LD = 136;
constexpr int POOL_U = 0, POOL_P = 144 * PU_LD * 2;
DI void pool_unit(LAS unsigned char* lds, const bf16_t* Z, const float* sp_l, const bf16_t* PWT, const float* pscale_l, bf16_t* MIX, int ub, int tid) {
    const int lane = tid & 63, wid = tid >> 6, r = lane & 31, hh = lane >> 5;
    LAS bf16_t* Ug = (LAS bf16_t*)(lds + POOL_U); LAS bf16_t* Pg = (LAS bf16_t*)(lds + POOL_P);
    const bool prompt = ub < 256; const int b = ub >> 5, n = ub & 31;
    const int s0 = ((ub - 256) & 3) * 32;
    const int rowbase = prompt ? b * SEQ + n * 128 : TP + s0;
    const int g_lo = prompt ? 0 : (ub - 256) >> 2, g_hi = prompt ? 4 : g_lo + 1, mtiles = prompt ? 4 : 1;
#pragma unroll 1
    for (int g = g_lo; g < g_hi; ++g) {
        const int w = 2 << g;
        const int mt = wid >> 1, nt0 = (wid & 1) * 2;
        bf16x8 bfr[8][2];
#pragma unroll
        for (int ks = 0; ks < 8; ++ks)
#pragma unroll
            for (int qq = 0; qq < 2; ++qq) bfr[ks][qq] = *(const bf16x8*)(PWT + (size_t)g * 16384 + (32 * (nt0 + qq) + r) * 128 + 16 * ks + 8 * hh);
        if (prompt) {
            for (int c = tid; c < 143 * 16; c += 512) { const int row = c >> 4, part = c & 15, pos = n * 128 - 15 + row;
                u32x4 v = {0u, 0u, 0u, 0u};
                if (pos >= 0) v = *(const u32x4*)(Z + (size_t)(b * SEQ + pos) * INW + 768 + g * 128 + part * 8);
                *(LAS u32x4*)(Ug + row * PU_LD + part * 8) = v; }
            __syncthreads();
            const int c2 = tid & 63, t0 = wid * 16;
            float s0 = 0.f, s1 = 0.f;
            for (int s = 0; s < w; ++s) { const unsigned uv = *(LAS const unsigned*)(Ug + (t0 + 15 - s) * PU_LD + 2 * c2); s0 += __uint_as_float(uv << 16); s1 += __uint_as_float(uv & 0xffff0000u); }
            for (int t = t0; t < t0 + 16; ++t) {
                const unsigned uv = *(LAS const unsigned*)(Ug + (t + 15) * PU_LD + 2 * c2);
                const float u0 = __uint_as_float(uv << 16), u1 = __uint_as_float(uv & 0xffff0000u);
                const int pos1 = n * 128 + t + 1; const float ic = 1.0f / (float)(pos1 < w ? pos1 : w);
                *(LAS unsigned*)(Pg + t * PU_LD + 2 * c2) = pk2(s0 * ic - u0, s1 * ic - u1);
                if (t + 1 < t0 + 16) {
                    const unsigned ua = *(LAS const unsigned*)(Ug + (t + 16) * PU_LD + 2 * c2), ud = *(LAS const unsigned*)(Ug + (t + 16 - w) * PU_LD + 2 * c2);
                    s0 += __uint_as_float(ua << 16) - __uint_as_float(ud << 16); s1 += __uint_as_float(ua & 0xffff0000u) - __uint_as_float(ud & 0xffff0000u);
                }
            }
        } else {
            for (int idx = tid; idx < 32 * 64; idx += 512) { const int sl = idx >> 6, c2 = idx & 63, s = s0 + sl;
                const unsigned uv = *(const unsigned*)(Z + (size_t)(TP + s) * INW + 768 + g * 128 + 2 * c2);
                const float u0 = __uint_as_float(uv << 16), u1 = __uint_as_float(uv & 0xffff0000u);
                float a0 = u0, a1 = u1;
#pragma unroll
                for (int i = 0; i < 15; ++i) { if (i >= 16 - w) { const f32x2 sv = *(const f32x2*)(sp_l + ((size_t)s * 15 + i) * 512 + g * 128 + 2 * c2); a0 += sv.x; a1 += sv.y; } }
                const float ic = 1.0f / (float)w;
                *(LAS unsigned*)(Pg + sl * PU_LD + 2 * c2) = pk2(a0 * ic - u0, a1 * ic - u1); }
        }
        __syncthreads();
        f32x16 acc[2];
#pragma unroll
        for (int i = 0; i < 16; ++i) { acc[0][i] = 0.f; acc[1][i] = 0.f; }
        if (mt < mtiles) {
#pragma unroll
        for (int ks = 0; ks < 8; ++ks) {
            const bf16x8 a = *(LAS const bf16x8*)(Pg + (32 * mt + r) * PU_LD + 16 * ks + 8 * hh);
#pragma unroll
            for (int qq = 0; qq < 2; ++qq) acc[qq] = MFMA32(a, bfr[ks][qq], acc[qq]);
        }
#pragma unroll
        for (int qq = 0; qq < 2; ++qq) { const int col = g * 128 + 32 * (nt0 + qq) + r; const float ps = pscale_l[col];
#pragma unroll
            for (int i = 0; i < 16; ++i) { const int row = 32 * mt + crow(i, hh);
                MIX[(size_t)(rowbase + row) * DM + 512 + col] = (bf16_t)(pk2(acc[qq][i] * ps, 0.f) & 0xffffu); } }
        }
        __syncthreads();
    }
}

DI void states_copy(KP P, const bf16_t* Z, int l, int gtid, int GT) {
    float* out = P->out;
    for (int idx = gtid; idx < 8 * 128 * 32; idx += GT) { const int c4 = idx & 31, j = (idx >> 5) & 127, b = idx >> 12;
        const bf16_t* zr = Z + (size_t)(b * SEQ + SEQ - 128 + j) * INW + c4 * 4;
        *(f32x4*)(out + O_KP + ((size_t)(l * 8 + b) * 128 + j) * 128 + c4 * 4) = bf4_to_f4(zr + 512);
        *(f32x4*)(out + O_VP + ((size_t)(l * 8 + b) * 128 + j) * 128 + c4 * 4) = bf4_to_f4(zr + 640); }
    for (int idx = gtid; idx < 8 * 15 * 128; idx += GT) { const int c4 = idx & 127, bi = idx >> 7, i = bi % 15, b = bi / 15;
        *(f32x4*)(out + O_PP + ((size_t)(l * 8 + b) * 15 + i) * 512 + c4 * 4) = bf4_to_f4(Z + (size_t)(b * SEQ + SEQ - 15 + i) * INW + 768 + c4 * 4); }
    const float* ck = P->in[4] + (size_t)l * 128 * 128 * 128; const float* cv = P->in[5] + (size_t)l * 128 * 128 * 128; const float* sp = P->in[6] + (size_t)l * 128 * 15 * 512;
    for (int idx = gtid; idx < 128 * 128 * 32; idx += GT) { const int c4 = idx & 31, j = (idx >> 5) & 127, s = idx >> 12;
        const bf16_t* zr = Z + (size_t)(TP + s) * INW + c4 * 4;
        f32x4 kv, vv;
        if (j < 127) { kv = *(const f32x4*)(ck + ((size_t)s * 128 + j + 1) * 128 + c4 * 4); vv = *(const f32x4*)(cv + ((size_t)s * 128 + j + 1) * 128 + c4 * 4); }
        else { kv = bf4_to_f4(zr + 512); vv = bf4_to_f4(zr + 640); }
        *(f32x4*)(out + O_KS + ((size_t)(l * 128 + s) * 128 + j) * 128 + c4 * 4) = kv;
        *(f32x4*)(out + O_VS + ((size_t)(l * 128 + s) * 128 + j) * 128 + c4 * 4) = vv; }
    for (int idx = gtid; idx < 128 * 15 * 128; idx += GT) { const int c4 = idx & 127, si = idx >> 7, i = si % 15, s = si / 15;
        f32x4 v;
        if (i < 14) v = *(const f32x4*)(sp + ((size_t)s * 15 + i + 1) * 512 + c4 * 4); else v = bf4_to_f4(Z + (size_t)(TP + s) * INW + 768 + c4 * 4);
        *(f32x4*)(out + O_PS + ((size_t)(l * 128 + s) * 15 + i) * 512 + c4 * 4) = v; }
}

#define XB_TMO      128
#define XB_XCNT(j)  (256  + 64 * (j))
#define XB_XSUB(j)  (1280 + 64 * (j))
#define XB_XGEN(j)  (2304 + 64 * (j))
#define XB_TOP      3328
#define XB_TOPGEN   3392
#define XCD_BAR_WORDS 3456
#define XB_SPIN_CAP (1u << 18)

__device__ __forceinline__ unsigned xb_ld(unsigned* p)              { return __hip_atomic_load(p, __ATOMIC_RELAXED, __HIP_MEMORY_SCOPE_AGENT); }
__device__ __forceinline__ unsigned xb_add(unsigned* p, unsigned v) { return __hip_atomic_fetch_add(p, v, __ATOMIC_RELAXED, __HIP_MEMORY_SCOPE_AGENT); }
__device__ __forceinline__ unsigned xb_xcc_id() { return (unsigned)__builtin_amdgcn_s_getreg((3 << 11) | 20) & 0xFu; }
#define XB_SPIN(cond, bar) do { unsigned _sp = 0; while (cond) { __builtin_amdgcn_s_sleep(1); \
    if ((++_sp & 255u) == 0u) { if (xb_ld(&(bar)[XB_TMO])) break; if (_sp > XB_SPIN_CAP) { atomicAdd(&(bar)[XB_TMO], 1u); break; } } } } while (0)

struct XcdBarrier {
    unsigned* bar; unsigned x;
    volatile LAS unsigned* st;
};

__device__ __forceinline__ XcdBarrier xcd_barrier_post(unsigned* bar, volatile LAS unsigned* st) {
    XcdBarrier b; b.bar = bar; b.x = xb_xcc_id(); b.st = st;
    if (threadIdx.x == 0) (void)xb_add(&bar[XB_XCNT(b.x)], 1u);
    return b;
}
__device__ __forceinline__ void xcd_barrier_complete(unsigned* bar, unsigned x, unsigned& nloc, unsigned& nx) {
    const unsigned G = gridDim.x * gridDim.y * gridDim.z;
    unsigned sum, cnt, mine, sp = 0u;
    for (;;) {
        sum = 0u; cnt = 0u; mine = 0u;
#pragma unroll
        for (unsigned j = 0; j < 16; ++j) { const unsigned c = xb_ld(&bar[XB_XCNT(j)]); sum += c; cnt += (c > 0u) ? 1u : 0u; mine = (j == x) ? c : mine; }
        if (sum == G) break;
        __builtin_amdgcn_s_sleep(1);
        if ((++sp & 255u) == 0u) { if (xb_ld(&bar[XB_TMO])) break; if (sp > XB_SPIN_CAP) { atomicAdd(&bar[XB_TMO], 1u); break; } }
    }
    nloc = mine > 0u ? mine : 1u; nx = cnt > 0u ? cnt : 1u;
}

__device__ __forceinline__ void xcd_barrier(const XcdBarrier& b) {
    asm volatile("s_waitcnt vmcnt(0)" ::: "memory");
    __syncthreads();
    if (threadIdx.x == 0) {
        unsigned* bar = b.bar;
        __builtin_amdgcn_s_waitcnt(0);
        unsigned nloc = b.st[0], nx = b.st[1];
        if (nloc == 0u) { xcd_barrier_complete(bar, b.x, nloc, nx); b.st[0] = nloc; b.st[1] = nx; }
        const unsigned old = xb_add(&bar[XB_XSUB(b.x)], 1u);
        const unsigned gen = old / nloc;
        if (old + 1u == (gen + 1u) * nloc) {
            __builtin_amdgcn_fence(__ATOMIC_RELEASE, "agent");
            asm volatile("s_waitcnt vmcnt(0)" ::: "memory");
            const unsigned og = xb_add(&bar[XB_TOP], 1u);
            const unsigned tg = og / nx;
            if (og + 1u == (tg + 1u) * nx) xb_add(&bar[XB_TOPGEN], 1u);
            else XB_SPIN(xb_ld(&bar[XB_TOPGEN]) == tg, bar);
            __builtin_amdgcn_fence(__ATOMIC_ACQUIRE, "agent");
            xb_add(&bar[XB_XGEN(b.x)], 1u);
            asm volatile("s_waitcnt vmcnt(0)" ::: "memory");
        } else {
            XB_SPIN(xb_ld(&bar[XB_XGEN(b.x)]) == gen, bar);
            __builtin_amdgcn_fence(__ATOMIC_ACQUIRE, "agent");
            asm volatile("s_waitcnt vmcnt(0)" ::: "memory");
        }
    }
    __syncthreads();
}
DI KP kargs() { unsigned long long v = (unsigned long long)__builtin_amdgcn_kernarg_segment_ptr(); asm volatile("" : "+s"(v)); return (KP)v; }
#define PH_VARS KP Pk = kargs(); int tid = threadIdx.x; asm volatile("" : "+v"(tid)); const int lane = tid & 63, wid = __builtin_amdgcn_readfirstlane(tid >> 6); \
    const int G = gridDim.x, bx = blockIdx.x; const int gw = bx * 8 + wid, NGW = G * 8, gtid = bx * 512 + tid, GT = G * 512; unsigned char* ws = Pk->ws; (void)lane; (void)gw; (void)NGW; (void)gtid; (void)GT; (void)ws;
__global__ void __launch_bounds__(512, 2) fwd(Params Pdummy) {
    extern __shared__ __attribute__((aligned(16))) unsigned char lds_g[];
    LAS unsigned char* lds = (LAS unsigned char*)lds_g;
    cg::grid_group grid = cg::this_grid();
    int lo, hi; unsigned* barw; { KP Pk = kargs(); lo = Pk->ph_lo; hi = Pk->ph_hi; barw = (unsigned*)(Pk->ws + WS_BAR); }
    if (hi > 1000) grid.sync();
    if (threadIdx.x < 2) ((volatile LAS unsigned*)(lds + 131072))[threadIdx.x] = 0u;
    __syncthreads();
    XcdBarrier xb; xb.bar = barw; xb.x = 0; xb.st = nullptr;
    if (hi - lo > 1) xb = xcd_barrier_post(barw, (volatile LAS unsigned*)(lds + 131072));
#ifndef PROBE_REP
#define PROBE_REP -1
#endif
#ifndef PROBE_N
#define PROBE_N 0
#endif
#ifndef PROBE_MIX
#define PROBE_MIX 0
#endif
#ifndef PROBE_SYNC
#define PROBE_SYNC 0
#endif
#define REPS(k) for (int rep_ = 0; rep_ < ((k) == PROBE_REP ? 1 + PROBE_N : 1); ++rep_)
#define IN(k) (lo <= (k) && (k) < hi)
#define SEAM(k) do { if (IN(k) && IN((k) + 1)) xcd_barrier(xb); } while (0)
    if (IN(0)) REPS(0) { PH_VARS prologue(Pk, lds, gw, NGW, gtid, GT, wid, lane); }
    SEAM(0);
    for (int i_ = 0; i_ < PROBE_SYNC; ++i_) xcd_barrier(xb);
    if (IN(1)) REPS(1) { PH_VARS
        pg8::Gemm g{(const bf16_t*)(ws + WS_CS), (const bf16_t*)(ws + WS_WADA), 256, MODLD, DM}; pg8::StaticOrder S; S.init(256, MODLD, G, bx);
        EpiMod E{(float*)(ws + WS_MOD), Pk->in[8]};
        pg8::gemm_phase<EpiMod, pg8::StaticOrder, PG8_ALIGN, PG8_SP2>(lds, g, S, E, tid);
    }
    SEAM(1);
#pragma unroll 1
    for (int l = 0; l < 2; ++l) {
        const int pb = 2 + 10 * l;
#define LAYER_VARS unsigned char* wl = ws + WS_L0 + (size_t)l * LAYER_BYTES; float* X = (float*)(ws + WS_X); bf16_t* H = (bf16_t*)(ws + WS_H); bf16_t* ACT = (bf16_t*)(ws + WS_ACT); bf16_t* Z = (bf16_t*)(ws + WS_Z); bf16_t* MIX = (bf16_t*)(ws + WS_MIX); \
        const float* modl = (const float*)(ws + WS_MOD) + (size_t)l * NMOD; const float* gain_l = Pk->in[9] + (size_t)l * 3 * DM; \
        (void)wl; (void)X; (void)H; (void)ACT; (void)Z; (void)MIX; (void)modl; (void)gain_l;
        if (IN(pb + 0)) REPS(pb + 0) { PH_VARS LAYER_VARS
            const float* xin_p = l == 0 ? Pk->in[0] : X; const float* xin_s = l == 0 ? Pk->in[1] : X + (size_t)TP * DM;
            norm_phase<false>(xin_p, xin_s, gain_l, modl, H, nullptr, gw, NGW, lane, l == 0 ? X : nullptr); }
        SEAM(pb + 0);
        if (IN(pb + 1)) REPS(pb + 1) { PH_VARS LAYER_VARS
            pg8::Gemm g{H, (const bf16_t*)(wl + LW_GU1), MPAD, 2 * FF, DM}; pg8::StaticOrder S; S.init(MPAD, 2 * FF, G, bx, DM, TP / 256);
            EpiSwiGLU E{ACT};
            pg8::gemm_phase<EpiSwiGLU, pg8::StaticOrder, PG8_ALIGN, PG8_SP2>(lds, g, S, E, tid);
        }
        SEAM(pb + 1);
        if (IN(pb + 2)) REPS(pb + 2) { PH_VARS LAYER_VARS
            const float* xin_p = l == 0 ? Pk->in[0] : X; const float* xin_s = l == 0 ? Pk->in[1] : X + (size_t)TP * DM;
            pg8::Gemm g{ACT, (const bf16_t*)(wl + LW_D1), MPAD, DM, FF}; SplitOrder S; S.init(DM, FF, G, bx);
            EpiResid E{xin_p, xin_s, X, modl + 2 * DM, 0.5f};
            pg8::gemm_phase<EpiResid, SplitOrder, PG8_ALIGN, PG8_SP2>(lds, g, S, E, tid);
        }
        SEAM(pb + 2);
        if (IN(pb + 3)) REPS(pb + 3) { PH_VARS LAYER_VARS norm_phase<false>(X, X + (size_t)TP * DM, gain_l + DM, modl + 3 * DM, H, nullptr, gw, NGW, lane); }
        SEAM(pb + 3);
        if (IN(pb + 4)) REPS(pb + 4) { PH_VARS LAYER_VARS
            pg8::Gemm g{H, (const bf16_t*)(wl + LW_IN), MPAD, INW, DM}; pg8::StaticOrder S; S.init(MPAD, INW, G, bx, DM, TP / 256);
            EpiStoreBf16 E{Z, INW};
            pg8::gemm_phase<EpiStoreBf16, pg8::StaticOrder, PG8_ALIGN, PG8_SP2>(lds, g, S, E, tid);
        }
        SEAM(pb + 4);
        if (IN(pb + 5)) REPS(pb + 5) { PH_VARS LAYER_VARS
            const float* TB = (const float*)(ws + WS_TB);
            const float* sinks_l = Pk->in[12] + l * 8;
            const float* ck = Pk->in[4] + (size_t)l * 128 * 128 * 128; const float* cv = Pk->in[5] + (size_t)l * 128 * 128 * 128; const float* sp = Pk->in[6] + (size_t)l * 128 * 15 * 512;
            for (int id = bx; id < 816; id += G) {
                if (id < 512) { for (int rp = 0; rp < (PROBE_MIX == 1 ? 2 : 1); ++rp) { const int kvh = id & 1, bn = id >> 1; attn_unit(lds, Z, MIX, TB, sinks_l, bn >> 5, bn & 31, kvh, tid); } }
                else if (id < 784) { for (int rp = 0; rp < (PROBE_MIX == 2 ? 2 : 1); ++rp) pool_unit(lds, Z, sp, (const bf16_t*)(wl + LW_POOL), Pk->in[15] + l * 512, MIX, id - 512, tid); }
                else { for (int rp = 0; rp < (PROBE_MIX == 3 ? 2 : 1); ++rp) { const int task = (id - 784) * 8 + wid; sattn_task((LAS float*)(lds + wid * 4096), Z, ck, cv, MIX, TB, sinks_l, task >> 1, task & 1, lane); __syncthreads(); } }
            }
            for (int rp = 0; rp < (PROBE_MIX == 4 ? 2 : 1); ++rp) states_copy(Pk, Z, l, gtid, GT);
        }
        SEAM(pb + 5);
        if (IN(pb + 6)) REPS(pb + 6) { PH_VARS LAYER_VARS
            pg8::Gemm g{MIX, (const bf16_t*)(wl + LW_OUT), MPAD, DM, DM}; SplitOrder S; S.init(DM, DM, G, bx);
            EpiResid E{X, X + (size_t)TP * DM, X, modl + 5 * DM, 1.0f};
            pg8::gemm_phase<EpiResid, SplitOrder, PG8_ALIGN, PG8_SP2>(lds, g, S, E, tid);
        }
        SEAM(pb + 6);
        if (IN(pb + 7)) REPS(pb + 7) { PH_VARS LAYER_VARS norm_phase<false>(X, X + (size_t)TP * DM, gain_l + 2 * DM, modl + 6 * DM, H, nullptr, gw, NGW, lane); }
        SEAM(pb + 7);
        if (IN(pb + 8)) REPS(pb + 8) { PH_VARS LAYER_VARS
            pg8::Gemm g{H, (const bf16_t*)(wl + LW_GU2), MPAD, 2 * FF, DM}; pg8::StaticOrder S; S.init(MPAD, 2 * FF, G, bx, DM, TP / 256);
            EpiSwiGLU E{ACT};
            pg8::gemm_phase<EpiSwiGLU, pg8::StaticOrder, PG8_ALIGN, PG8_SP2>(lds, g, S, E, tid);
        }
        SEAM(pb + 8);
        if (IN(pb + 9)) REPS(pb + 9) { PH_VARS LAYER_VARS
            pg8::Gemm g{ACT, (const bf16_t*)(wl + LW_D2), MPAD, DM, FF}; SplitOrder S; S.init(DM, FF, G, bx);
            EpiResid E{X, X + (size_t)TP * DM, X, modl + 8 * DM, 0.5f};
            pg8::gemm_phase<EpiResid, SplitOrder, PG8_ALIGN, PG8_SP2>(lds, g, S, E, tid);
        }
        SEAM(pb + 9);
    }
    if (IN(22)) REPS(22) { PH_VARS float* X = (float*)(ws + WS_X); norm_phase<true>(X, X + (size_t)TP * DM, Pk->in[22], nullptr, nullptr, Pk->out, gw, NGW, lane); }
#undef IN
#undef SEAM
}

extern "C" void kernel_launch(void* const* d_in, const int* in_sizes, int n_in, void* d_out, int out_size, void* d_ws, size_t ws_size, hipStream_t stream) {
    static int grid = 0;
    if (grid == 0) {
        if (n_in != 23 || (size_t)out_size != O_END || ws_size < WS_END) { fprintf(stderr, "kernel_launch: unexpected sizes n_in %d out %d ws %zu\n", n_in, out_size, ws_size); grid = -1; return; }
        int dev = 0, cus = 0, per_cu = 0;
        (void)hipGetDevice(&dev); (void)hipDeviceGetAttribute(&cus, hipDeviceAttributeMultiprocessorCount, dev);
        if (hipFuncSetAttribute((const void*)fwd, hipFuncAttributeMaxDynamicSharedMemorySize, LDS_BYTES) != hipSuccess) { fprintf(stderr, "kernel_launch: hipFuncSetAttribute failed\n"); grid = -1; return; }
        if (hipOccupancyMaxActiveBlocksPerMultiprocessor(&per_cu, (const void*)fwd, 512, LDS_BYTES) != hipSuccess || per_cu < 1) { fprintf(stderr, "kernel_launch: occupancy query says %d\n", per_cu); per_cu = 1; }
        (void)hipGetLastError();
        grid = cus * per_cu;
    }
    if (grid < 0) return;
    Params p{};
    for (int i = 0; i < 23; ++i) p.in[i] = (const float*)d_in[i];
    p.out = (float*)d_out; p.ws = (unsigned char*)d_ws;
#if N_LAUNCH_PER_PHASE
    for (int ph = 0; ph < NPH; ++ph) { p.ph_lo = ph; p.ph_hi = ph + 1; hipLaunchKernelGGL(fwd, dim3(grid), dim3(512), LDS_BYTES, stream, p); }
#else
    p.ph_lo = 0; p.ph_hi = NPH;
    if (hipMemsetAsync((char*)d_ws + WS_BAR, 0, WS_BAR_BYTES, stream) != hipSuccess) { fprintf(stderr, "kernel_launch: memset failed\n"); return; }
    void* args[] = {&p};
    hipError_t e = hipLaunchCooperativeKernel((const void*)fwd, dim3(grid), dim3(512), args, LDS_BYTES, stream);
    if (e != hipSuccess) fprintf(stderr, "kernel_launch: cooperative launch failed: %s (grid %d)\n", hipGetErrorString(e), grid);
#endif
}
```

```cpp
#include <hip/hip_runtime.h>
#include <hip/hip_cooperative_groups.h>
#include <cstdio>
#include <cstdint>
namespace cg = cooperative_groups;
namespace pg8 {
#define PG8_LAS __attribute__((address_space(3)))
typedef unsigned short bf16_t;
typedef short bf16x8 __attribute__((ext_vector_type(8)));
typedef float f32x4 __attribute__((ext_vector_type(4)));
typedef unsigned u32x4 __attribute__((ext_vector_type(4)));
constexpr int BM = 256, BK = 64, HALF = 128, HTB = HALF * BK * 2  , STAGE_BYTES = 8 * HTB, NXCD = 8, WGM = 8;

__host__ __device__ __forceinline__ int lds_byte(int r, int c) { const int st = (r >> 4) * 2 + (c >> 5), rr = r & 15, cc = c & 31, ob = rr * 64 + cc * 2; return st * 1024 + (ob ^ (((ob >> 9) & 1) << 5)); }
__host__ __device__ __forceinline__ void stage_rc(int b, int& R, int& C) { const int st = b / 1024, sb = b % 1024, swz = sb ^ (((sb >> 9) & 1) << 5); R = (st >> 1) * 16 + swz / 64; C = (st & 1) * 32 + (swz % 64) / 2; }
__host__ __device__ __forceinline__ int perm32(int rho) { const int n = rho >> 4, i = rho & 15; return 8 * (i >> 2) + 4 * n + (i & 3); }

struct Unit { int pm, pn, k0; };
struct Gemm { const bf16_t* A; const bf16_t* Bt; int M, N, K; };

struct StaticOrder {
    static constexpr bool SPLIT = false;
    int nM, nN, nwg, G, c;
    __host__ __device__ void init(int M, int N, int G_, int c_, int K_ = 1024, int half_pm_ = -1) { nM = M / BM; nN = N / BM; nwg = nM * nN; G = G_; c = c_; (void)K_; (void)half_pm_; }
    __host__ __device__ bool next(int i, Unit& u) const {
        const long L = (long)i * G + c; if (L >= nwg) return false;
        int wgid = (int)L; { const int q = nwg / NXCD, r = nwg % NXCD, xcd = wgid % NXCD, off = wgid / NXCD; wgid = (xcd < r ? xcd * (q + 1) : r * (q + 1) + (xcd - r) * q) + off; }
        const int nig = WGM * nN, gid = wgid / nig, fm = gid * WGM, gsz = (nM - fm) < WGM ? (nM - fm) : WGM;
        u.pm = fm + ((wgid % nig) % gsz); u.pn = (wgid % nig) / gsz; u.k0 = 0; return true;
    }
    __device__ __forceinline__ void a_ready(const Unit&) const {}
    __device__ __forceinline__ void done(const Unit&) const {}
};

__device__ __forceinline__ unsigned cvt_pk_bf16(float lo, float hi) { unsigned r; asm volatile("v_cvt_pk_bf16_f32 %0, %1, %2" : "=v"(r) : "v"(lo), "v"(hi)); return r; }
typedef float f32x2 __attribute__((ext_vector_type(2)));
template <class Epi, class Sched, bool ALIGN_EPI = false, bool SP2 = false>
__device__ __forceinline__ void gemm_phase(PG8_LAS unsigned char* lds, const Gemm g, const Sched& S, const Epi& E, const int tid_in) {
    const int tid = tid_in, wid = __builtin_amdgcn_readfirstlane(tid >> 6), lane = tid & 63, wr = wid >> 2, wc = wid & 3, fr = lane & 15, fq = lane >> 4;
    const int K = g.K;
    unsigned voffA[2], voffB[2];
#pragma unroll
    for (int i = 0; i < 2; ++i) { int R, C; stage_rc(tid * 16 + i * 8192, R, C); const int Rb = Epi::PERM ? ((R & ~31) + perm32(R & 31)) : R;
        voffA[i] = (unsigned)(R * K + C) * 2u; voffB[i] = (unsigned)(Rb * K + C) * 2u; }
    const size_t kstep = (size_t)(BK * 2);
    const size_t hstep = (size_t)HALF * K * 2;
    const size_t tstep = 2 * hstep;
    const unsigned ldsw = (unsigned)wid * 1024u;
    const int aoff = lds_byte(wr * 64 + fr, fq * 8), boff = lds_byte(wc * 32 + fr, fq * 8);
#define PG8_SA(b, h) (((b) * 2 + (h)) * HTB)
#define PG8_SB(b, h) ((4 + (b) * 2 + (h)) * HTB)
#define PG8_STAGE(bufoff, gbase, voff) do { _Pragma("unroll") for (int _i = 0; _i < 2; ++_i) \
        __builtin_amdgcn_global_load_lds((const unsigned*)((const char*)(gbase) + (voff)[_i]), (PG8_LAS unsigned*)(lds + (bufoff) + ldsw + _i * 8192), 16, 0, 0); } while (0)
#define PG8_LDA(dst, b, h) do { _Pragma("unroll") for (int m = 0; m < 4; ++m) _Pragma("unroll") for (int k = 0; k < 2; ++k) dst[m][k] = *(const PG8_LAS bf16x8*)(lds + PG8_SA(b, h) + aoff + m * 2048 + k * 1024); } while (0)
#define PG8_LDB(dst, b, h) do { _Pragma("unroll") for (int n = 0; n < 2; ++n) _Pragma("unroll") for (int k = 0; k < 2; ++k) dst[n][k] = *(const PG8_LAS bf16x8*)(lds + PG8_SB(b, h) + boff + n * 2048 + k * 1024); } while (0)
#define PG8_MMA(ai, bj, At, Bt) do { __builtin_amdgcn_s_setprio(1); _Pragma("unroll") for (int m = 0; m < 4; ++m) _Pragma("unroll") for (int n = 0; n < 2; ++n) _Pragma("unroll") for (int k = 0; k < 2; ++k) \
        acc[ai][bj][m][n] = __builtin_amdgcn_mfma_f32_16x16x32_bf16(Bt[n][k], At[m][k], acc[ai][bj][m][n], 0, 0, 0); __builtin_amdgcn_s_setprio(0); } while (0)
#define PG8_WAIT_V(n) asm volatile("s_waitcnt vmcnt(" #n ")" ::: "memory")
#define PG8_WAIT_L(n) asm volatile("s_waitcnt lgkmcnt(" #n ")" ::: "memory")
#define PG8_BAR __builtin_amdgcn_s_barrier()
#define PG8_SCHED __builtin_amdgcn_sched_barrier(0)
    Unit cur, nxt; int ui = 0;
    if (!S.next(0, cur)) return;
    f32x4 acc[2][2][4][2];
#pragma unroll
    for (int a = 0; a < 2; ++a)
#pragma unroll
        for (int b = 0; b < 2; ++b)
#pragma unroll
            for (int m = 0; m < 4; ++m)
#pragma unroll
                for (int n = 0; n < 2; ++n) acc[a][b][m][n] = (f32x4){0.f, 0.f, 0.f, 0.f};
    bf16x8 At[4][2], B0[2][2], B1[2][2];
    const char* cA = (const char*)g.A + (size_t)cur.pm * tstep + (size_t)cur.k0 * kstep; const char* cB = (const char*)g.Bt + (size_t)cur.pn * tstep + (size_t)cur.k0 * kstep;
    S.a_ready(cur);
    if constexpr (SP2) {
        PG8_STAGE(PG8_SB(0, 0), cB, voffB); PG8_STAGE(PG8_SB(0, 1), cB + hstep, voffB); PG8_STAGE(PG8_SA(0, 0), cA, voffA); PG8_STAGE(PG8_SA(0, 1), cA + hstep, voffA);
        if (wr == 1) PG8_BAR;
        PG8_WAIT_V(2); PG8_BAR;
        PG8_STAGE(PG8_SB(1, 0), cB + kstep, voffB); PG8_STAGE(PG8_SA(1, 0), cA + kstep, voffA); PG8_STAGE(PG8_SB(1, 1), cB + hstep + kstep, voffB);
        PG8_WAIT_V(6); PG8_BAR;
    } else {
        PG8_STAGE(PG8_SB(0, 0), cB, voffB); PG8_STAGE(PG8_SA(0, 0), cA, voffA); PG8_STAGE(PG8_SB(0, 1), cB + hstep, voffB); PG8_STAGE(PG8_SA(0, 1), cA + hstep, voffA);
        if (wr == 1) PG8_BAR;
        PG8_WAIT_V(4); PG8_BAR;
        PG8_STAGE(PG8_SB(1, 0), cB + kstep, voffB); PG8_STAGE(PG8_SA(1, 0), cA + kstep, voffA); PG8_STAGE(PG8_SB(1, 1), cB + hstep + kstep, voffB);
        PG8_WAIT_V(6); PG8_BAR;
    }
    for (;;) {
        const bool has_next = S.next(ui + 1, nxt);
        const char* nA = has_next ? (const char*)g.A + (size_t)nxt.pm * tstep + (size_t)nxt.k0 * kstep : cA; const char* nB = has_next ? (const char*)g.Bt + (size_t)nxt.pn * tstep + (size_t)nxt.k0 * kstep : cB;
        const bool full = (cur.pm != 128); const int nt = (Sched::SPLIT && !full) ? 4 : K / BK;
        for (int t = 0; t < nt; t += 2) {
            const bool last = (t == nt - 2);
            const char* a1 = cA + (size_t)(t + 1) * kstep;
            const char* a2 = last ? nA : cA + (size_t)(t + 2) * kstep; const char* b2 = last ? nB : cB + (size_t)(t + 2) * kstep;
            const char* a3 = a2 + kstep; const char* b3 = b2 + kstep;
            if (last && has_next) S.a_ready(nxt);
            if constexpr (SP2) {
            PG8_LDB(B0, 0, 0); PG8_LDB(B1, 0, 1); PG8_SCHED; PG8_LDA(At, 0, 0); PG8_STAGE(PG8_SA(1, 1), a1 + hstep, voffA);
            PG8_WAIT_V(8); PG8_WAIT_L(0); PG8_BAR; PG8_MMA(0, 0, At, B0); PG8_MMA(0, 1, At, B1); PG8_BAR; PG8_SCHED;
            PG8_LDA(At, 0, 1); PG8_STAGE(PG8_SB(0, 0), b2, voffB); PG8_STAGE(PG8_SB(0, 1), b2 + hstep, voffB); PG8_STAGE(PG8_SA(0, 0), a2, voffA);
            PG8_WAIT_V(8); PG8_WAIT_L(0); PG8_BAR; if (full) { PG8_MMA(1, 0, At, B0); PG8_MMA(1, 1, At, B1); } PG8_BAR; PG8_SCHED;
            PG8_LDB(B0, 1, 0); PG8_LDB(B1, 1, 1); PG8_SCHED; PG8_LDA(At, 1, 0); PG8_STAGE(PG8_SA(0, 1), a2 + hstep, voffA);
            PG8_WAIT_V(8); PG8_WAIT_L(0); PG8_BAR; PG8_MMA(0, 0, At, B0); PG8_MMA(0, 1, At, B1); PG8_BAR; PG8_SCHED;
            PG8_LDA(At, 1, 1); PG8_STAGE(PG8_SB(1, 0), b3, voffB); PG8_STAGE(PG8_SB(1, 1), b3 + hstep, voffB); PG8_STAGE(PG8_SA(1, 0), a3, voffA);
            PG8_WAIT_V(8); PG8_WAIT_L(0); PG8_BAR; if (full) { PG8_MMA(1, 0, At, B0); PG8_MMA(1, 1, At, B1); } PG8_BAR; PG8_SCHED;
            } else {
            PG8_LDB(B0, 0, 0); PG8_SCHED; PG8_LDA(At, 0, 0); PG8_STAGE(PG8_SA(1, 1), a1 + hstep, voffA);
            PG8_WAIT_L(8); PG8_BAR; PG8_WAIT_L(0); PG8_MMA(0, 0, At, B0); PG8_BAR; PG8_SCHED;
            PG8_LDB(B1, 0, 1); PG8_STAGE(PG8_SB(0, 0), b2, voffB);
            PG8_BAR; PG8_WAIT_L(0); PG8_MMA(0, 1, At, B1); PG8_BAR;
            PG8_LDA(At, 0, 1); PG8_STAGE(PG8_SA(0, 0), a2, voffA);
            PG8_BAR; PG8_WAIT_L(0); PG8_MMA(1, 0, At, B0); PG8_BAR; PG8_SCHED;
            PG8_STAGE(PG8_SB(0, 1), b2 + hstep, voffB);
            PG8_WAIT_V(6); PG8_BAR; PG8_MMA(1, 1, At, B1); PG8_BAR;
            PG8_LDB(B0, 1, 0); PG8_SCHED; PG8_LDA(At, 1, 0); PG8_STAGE(PG8_SA(0, 1), a2 + hstep, voffA);
            PG8_WAIT_L(8); PG8_BAR; PG8_WAIT_L(0); PG8_MMA(0, 0, At, B0); PG8_BAR; PG8_SCHED;
            PG8_LDB(B1, 1, 1); PG8_STAGE(PG8_SB(1, 0), b3, voffB);
            PG8_BAR; PG8_WAIT_L(0); PG8_MMA(0, 1, At, B1); PG8_BAR;
            PG8_LDA(At, 1, 1); PG8_STAGE(PG8_SA(1, 0), a3, voffA);
            PG8_BAR; PG8_WAIT_L(0); PG8_MMA(1, 0, At, B0); PG8_BAR; PG8_SCHED;
            PG8_STAGE(PG8_SB(1, 1), b3 + hstep, voffB);
            PG8_WAIT_V(6); PG8_BAR; PG8_MMA(1, 1, At, B1); PG8_BAR;
            }
        }
        if constexpr (ALIGN_EPI) { if (wr == 0) PG8_BAR; }
        if constexpr (!Epi::AFTER_DRAIN) { E(acc, cur, wr, wc, fr, fq); S.done(cur); }
        if (!has_next) break;
#pragma unroll
        for (int a = 0; a < 2; ++a)
#pragma unroll
            for (int b = 0; b < 2; ++b)
#pragma unroll
                for (int m = 0; m < 4; ++m)
#pragma unroll
                    for (int n = 0; n < 2; ++n) acc[a][b][m][n] = (f32x4){0.f, 0.f, 0.f, 0.f};
        cur = nxt; cA = nA; cB = nB; ++ui;
        if constexpr (ALIGN_EPI) { if (wr == 1) PG8_BAR; }
    }
    PG8_WAIT_V(0);
    if constexpr (!ALIGN_EPI) { if (wr == 0) PG8_BAR; }
    PG8_BAR;
    if constexpr (Epi::AFTER_DRAIN) { E.fused(acc, cur, wr, wc, fr, fq, lds, wid, lane); S.done(cur); }
#undef PG8_SA
#undef PG8_SB
#undef PG8_STAGE
#undef PG8_LDA
#undef PG8_LDB
#undef PG8_MMA
#undef PG8_WAIT_V
#undef PG8_WAIT_L
#undef PG8_BAR
#undef PG8_SCHED
}
}
#ifndef PG8_SP2
#define PG8_SP2 true
#endif
#ifndef PG8_ALIGN
#define PG8_ALIGN true
#endif
#ifndef N_LAUNCH_PER_PHASE
#define N_LAUNCH_PER_PHASE 0
#endif

#define DI __device__ __forceinline__
#define LAS __attribute__((address_space(3)))
typedef unsigned short bf16_t;
typedef short bf16x8 __attribute__((ext_vector_type(8)));
typedef short s16x4 __attribute__((ext_vector_type(4)));
typedef float f32x4 __attribute__((ext_vector_type(4)));
typedef float f32x2 __attribute__((ext_vector_type(2)));
typedef float f32x16 __attribute__((ext_vector_type(16)));
typedef unsigned u32x4 __attribute__((ext_vector_type(4)));
typedef unsigned u32x2 __attribute__((ext_vector_type(2)));
typedef __bf16 bf16x2_t __attribute__((ext_vector_type(2)));

constexpr int TP = 32768, TS = 128, TT = TP + TS, MPAD = 33024;
constexpr int DM = 1024, FF = 2816, INW = 1280, NMOD = 9216, MODLD = 2 * NMOD;
constexpr int SEQ = 4096;
constexpr float EPS = 1e-6f, LOG2E = 1.4426950408889634f, C2 = 0.125f * 1.4426950408889634f;
constexpr int TBLD = 132;
constexpr size_t O_Y = 0, O_KP = 33685504, O_VP = 33947648, O_PP = 34209792, O_KS = 34332672, O_VS = 38526976, O_PS = 42721280, O_END = 44687360;
constexpr size_t MiB = 1u << 20;
constexpr size_t WS_BAR = 65536, WS_BAR_BYTES = 16384;
constexpr size_t WS_TB = 0, WS_CS = 1 * MiB, WS_MOD = 2 * MiB, WS_WADA = 12 * MiB, WS_L0 = 48 * MiB, LAYER_BYTES = 38 * MiB;
constexpr size_t LW_GU1 = 0, LW_D1 = 11 * MiB, LW_IN = 16 * MiB + MiB / 2, LW_OUT = 19 * MiB, LW_GU2 = 21 * MiB, LW_D2 = 32 * MiB, LW_POOL = 37 * MiB + MiB / 2;
constexpr size_t WS_X = 124 * MiB, WS_H = 253 * MiB, WS_ACT = 318 * MiB, WS_Z = WS_ACT, WS_MIX = WS_ACT + 96 * MiB, WS_END = 496 * MiB;
static_assert(WS_X + (size_t)MPAD * DM * 4 <= WS_H && WS_H + (size_t)MPAD * DM * 2 <= WS_ACT && WS_ACT + (size_t)MPAD * FF * 2 <= WS_END, "ws map");
static_assert(WS_Z + (size_t)MPAD * INW * 2 <= WS_MIX && WS_MIX + (size_t)MPAD * DM * 2 <= WS_END, "ws map 2");
static_assert(WS_MOD + (size_t)136 * MODLD * 4 <= WS_WADA && WS_WADA + (size_t)MODLD * DM * 2 <= WS_L0 && WS_L0 + 2 * LAYER_BYTES <= WS_X, "ws map 3");
constexpr int LDS_BYTES = 147456;
constexpr int NPH = 23;

struct Params { const float* in[23]; float* out; unsigned char* ws; int ph_lo, ph_hi; };

DI float bf2f(bf16_t b) { return __uint_as_float((unsigned)b << 16); }
DI unsigned pk2(float lo, float hi) { f32x2 v = {lo, hi}; bf16x2_t b = __builtin_convertvector(v, bf16x2_t); return __builtin_bit_cast(unsigned, b); }
DI float wave_sum(float v) {
#pragma unroll
    for (int o = 1; o < 64; o <<= 1) v += __shfl_xor(v, o);
    return v;
}
DI float wave_max(float v) {
#pragma unroll
    for (int o = 1; o < 64; o <<= 1) v = fmaxf(v, __shfl_xor(v, o));
    return v;
}
DI int crow(int r, int hi) { return (r & 3) + 8 * (r >> 2) + 4 * hi; }
DI f32x4 bf4_to_f4(const bf16_t* p) { const u32x2 v = *(const u32x2*)p; return (f32x4){__uint_as_float(v.x << 16), __uint_as_float(v.x & 0xffff0000u), __uint_as_float(v.y << 16), __uint_as_float(v.y & 0xffff0000u)}; }
#define MFMA32(a, b, c) __builtin_amdgcn_mfma_f32_32x32x16_bf16((a), (b), (c), 0, 0, 0)

struct EpiStoreBf16 {
    static constexpr bool PERM = true, AFTER_DRAIN = false;
    bf16_t* O; int ldc;
    DI void operator()(const pg8::f32x4 (&acc)[2][2][4][2], const pg8::Unit& u, int wr, int wc, int fr, int fq) const {
        const int row0 = u.pm * 256 + wr * 64 + fr, col0 = u.pn * 256 + wc * 32 + 8 * fq;
#pragma unroll
        for (int ai = 0; ai < 2; ++ai)
#pragma unroll
            for (int m = 0; m < 4; ++m) { bf16_t* rowp = O + (size_t)(row0 + ai * 128 + m * 16) * ldc + col0;
#pragma unroll
                for (int bj = 0; bj < 2; ++bj) { const f32x4 v0 = acc[ai][bj][m][0], v1 = acc[ai][bj][m][1];
                    u32x4 w; w.x = pk2(v0[0], v0[1]); w.y = pk2(v0[2], v0[3]); w.z = pk2(v1[0], v1[1]); w.w = pk2(v1[2], v1[3]);
                    *(u32x4*)(rowp + bj * 128) = w; } }
    }
};
DI float silu_mul(float g, float u) { return g * u * __builtin_amdgcn_rcpf(1.0f + __builtin_amdgcn_exp2f(-g * LOG2E)); }
struct EpiSwiGLU {
    static constexpr bool PERM = true, AFTER_DRAIN = false;
    bf16_t* O;
    DI void operator()(const pg8::f32x4 (&acc)[2][2][4][2], const pg8::Unit& u, int wr, int wc, int fr, int fq) const {
        const int row0 = u.pm * 256 + wr * 64 + fr, col0 = u.pn * 128 + wc * 32 + 8 * fq;
#pragma unroll
        for (int ai = 0; ai < 2; ++ai)
#pragma unroll
            for (int m = 0; m < 4; ++m) { bf16_t* rowp = O + (size_t)(row0 + ai * 128 + m * 16) * FF + col0;
                const f32x4 g0 = acc[ai][0][m][0], g1 = acc[ai][0][m][1], u0 = acc[ai][1][m][0], u1 = acc[ai][1][m][1];
                u32x4 w; w.x = pk2(silu_mul(g0[0], u0[0]), silu_mul(g0[1], u0[1])); w.y = pk2(silu_mul(g0[2], u0[2]), silu_mul(g0[3], u0[3]));
                w.z = pk2(silu_mul(g1[0], u1[0]), silu_mul(g1[1], u1[1])); w.w = pk2(silu_mul(g1[2], u1[2]), silu_mul(g1[3], u1[3]));
                *(u32x4*)rowp = w; }
    }
};
struct SplitOrder {
    static constexpr bool SPLIT = true;
    pg8::StaticOrder base; int nmain, nN, nchunk, G, c;
    DI void init(int N, int K, int G_, int c_) { base.init(TP, N, G_, c_, K, -1); nN = N / 256; nmain = (TP / 256) * nN; nchunk = K / 256; G = G_; c = c_; }
    DI bool next(int i, pg8::Unit& u) const {
        const int L = i * G + c;
        if (L < nmain) return base.next(i, u);
        const int s = L - nmain; if (s >= nN * nchunk) return false;
        u.pm = TP / 256; u.pn = s % nN; u.k0 = (s / nN) * 4; return true;
    }
    DI void a_ready(const pg8::Unit&) const {}
    DI void done(const pg8::Unit&) const {}
};
struct EpiResid {
    static constexpr bool PERM = false, AFTER_DRAIN = false;
    const float* xin_p; const float* xin_s; float* X; const float* gate; float coef;
    DI void operator()(const pg8::f32x4 (&acc)[2][2][4][2], const pg8::Unit& u, int wr, int wc, int fr, int fq) const {
        const int row0 = u.pm * 256 + wr * 64 + fr, col0 = u.pn * 256 + wc * 32 + 4 * fq;
        if (u.pm == TP / 256) {
#pragma unroll
            for (int m = 0; m < 4; ++m) { const int row = row0 + m * 16; const float* gp = gate + (size_t)(8 + row - TP) * MODLD; float* dst = X + (size_t)row * DM;
#pragma unroll
                for (int bj = 0; bj < 2; ++bj)
#pragma unroll
                    for (int n = 0; n < 2; ++n) { const int col = col0 + bj * 128 + n * 16; const f32x4 gv = *(const f32x4*)(gp + col); const f32x4 v = (gv * coef) * acc[0][bj][m][n];
                        unsafeAtomicAdd(dst + col + 0, v[0]); unsafeAtomicAdd(dst + col + 1, v[1]); unsafeAtomicAdd(dst + col + 2, v[2]); unsafeAtomicAdd(dst + col + 3, v[3]); } }
            return;
        }
#pragma unroll
        for (int ai = 0; ai < 2; ++ai)
#pragma unroll
            for (int m = 0; m < 4; ++m) { const int row = row0 + ai * 128 + m * 16; const int rr = row < TT ? row : TT - 1;
                const float* src = rr < TP ? xin_p + (size_t)rr * DM : xin_s + (size_t)(rr - TP) * DM;
                const int gb = rr < TP ? (rr >> 12) : 8 + rr - TP;
                const float* gp = gate + (size_t)gb * MODLD; float* dst = X + (size_t)row * DM;
#pragma unroll
                for (int bj = 0; bj < 2; ++bj)
#pragma unroll
                    for (int n = 0; n < 2; ++n) { const int col = col0 + bj * 128 + n * 16;
                        const f32x4 xv = *(const f32x4*)(src + col), gv = *(const f32x4*)(gp + col);
                        *(f32x4*)(dst + col) = xv + (gv * coef) * acc[ai][bj][m][n]; } }
    }
};
struct EpiMod {
    static constexpr bool PERM = false, AFTER_DRAIN = false;
    float* mod; const float* bias;
    DI void operator()(const pg8::f32x4 (&acc)[2][2][4][2], const pg8::Unit& u, int wr, int wc, int fr, int fq) const {
        const int row0 = u.pm * 256 + wr * 64 + fr, col0 = u.pn * 256 + wc * 32 + 4 * fq;
#pragma unroll
        for (int ai = 0; ai < 2; ++ai)
#pragma unroll
            for (int m = 0; m < 4; ++m) { const int row = row0 + ai * 128 + m * 16;
                if (row < 136) {
#pragma unroll
                    for (int bj = 0; bj < 2; ++bj)
#pragma unroll
                        for (int n = 0; n < 2; ++n) { const int col = col0 + bj * 128 + n * 16;
                            *(f32x4*)(mod + (size_t)row * MODLD + col) = acc[ai][bj][m][n] + *(const f32x4*)(bias + col); } } }
    }
};
typedef const __attribute__((address_space(4))) Params* KP;
DI void transpose_item(const float* W, int K, int N, bf16_t* WT, int mode, LAS float* scr, int item, int lane) {
    const int nblk = N / 32, kb = item / nblk, nb = item % nblk, k0 = 64 * kb, n0 = 32 * nb;
#pragma unroll 8
    for (int i = 0; i < 32; ++i) { const int kk = 2 * i + (lane >> 5); scr[kk * 33 + (lane & 31)] = W[(size_t)(k0 + kk) * N + n0 + (lane & 31)]; }
    asm volatile("s_waitcnt lgkmcnt(0)" ::: "memory");
    int rbase = n0;
    if (mode == 1) rbase = (n0 >> 7) * 256 + (n0 & 127);
    if (mode == 2) rbase = (n0 >> 7) * 256 + 128 + (n0 & 127);
    const int c = lane & 7;
#pragma unroll
    for (int j = 0; j < 4; ++j) { const int n = (lane >> 3) + 8 * j; const LAS float* s = scr + (8 * c) * 33 + n;
        u32x4 o; o.x = pk2(s[0 * 33], s[1 * 33]); o.y = pk2(s[2 * 33], s[3 * 33]); o.z = pk2(s[4 * 33], s[5 * 33]); o.w = pk2(s[6 * 33], s[7 * 33]);
        *(u32x4*)(WT + (size_t)(rbase + n) * K + k0 + 8 * c) = o; }
    asm volatile("s_waitcnt lgkmcnt(0)" ::: "memory");
}
constexpr int I_ADA = (DM / 64) * (NMOD / 32), I_FU = (DM / 64) * (FF / 32), I_FD = (FF / 64) * (DM / 32), I_IN = (DM / 64) * (INW / 32), I_OUT = (DM / 64) * (DM / 32), I_POOL = 4 * 8;
constexpr int IPL = I_ADA + 4 * I_FU + 2 * I_FD + I_IN + I_OUT + I_POOL;
DI int t5_bucket(int n) {
    if (n < 16) return n;
    int b = 16;
    b += (n >= 19); b += (n >= 21); b += (n >= 24); b += (n >= 27); b += (n >= 31); b += (n >= 35); b += (n >= 40); b += (n >= 46);
    b += (n >= 52); b += (n >= 59); b += (n >= 67); b += (n >= 77); b += (n >= 87); b += (n >= 99); b += (n >= 113);
    return b;
}
DI void prologue(KP P, LAS unsigned char* lds, int gw, int NGW, int gtid, int GT, int wid, int lane) {
    LAS float* scr = (LAS float*)(lds + wid * 8448);
    for (int it = gw; it < 2 * IPL; it += NGW) {
        const int l = it / IPL; int r = it - l * IPL;
        unsigned char* wl = P->ws + WS_L0 + (size_t)l * LAYER_BYTES;
        const float* src; bf16_t* dst; int K, N, mode = 0;
        if (r < I_ADA) { src = P->in[7] + (size_t)l * DM * NMOD; K = DM; N = NMOD; dst = (bf16_t*)(P->ws + WS_WADA) + (size_t)l * NMOD * DM; }
        else if ((r -= I_ADA) < I_FU) { src = P->in[16] + (size_t)l * DM * FF; K = DM; N = FF; dst = (bf16_t*)(wl + LW_GU1); mode = 1; }
        else if ((r -= I_FU) < I_FU) { src = P->in[17] + (size_t)l * DM * FF; K = DM; N = FF; dst = (bf16_t*)(wl + LW_GU1); mode = 2; }
        else if ((r -= I_FU) < I_FD) { src = P->in[18] + (size_t)l * FF * DM; K = FF; N = DM; dst = (bf16_t*)(wl + LW_D1); }
        else if ((r -= I_FD) < I_IN) { src = P->in[10] + (size_t)l * DM * INW; K = DM; N = INW; dst = (bf16_t*)(wl + LW_IN); }
        else if ((r -= I_IN) < I_OUT) { src = P->in[11] + (size_t)l * DM * DM; K = DM; N = DM; dst = (bf16_t*)(wl + LW_OUT); }
        else if ((r -= I_OUT) < I_FU) { src = P->in[19] + (size_t)l * DM * FF; K = DM; N = FF; dst = (bf16_t*)(wl + LW_GU2); mode = 1; }
        else if ((r -= I_FU) < I_FU) { src = P->in[20] + (size_t)l * DM * FF; K = DM; N = FF; dst = (bf16_t*)(wl + LW_GU2); mode = 2; }
        else if ((r -= I_FU) < I_FD) { src = P->in[21] + (size_t)l * FF * DM; K = FF; N = DM; dst = (bf16_t*)(wl + LW_D2); }
        else { r -= I_FD; const int g = r >> 3; r &= 7; src = P->in[14] + (size_t)(l * 4 + g) * 16384; K = 128; N = 128; dst = (bf16_t*)(wl + LW_POOL) + (size_t)g * 16384; }
        transpose_item(src, K, N, dst, mode, scr, r, lane);
    }
    bf16_t* CS = (bf16_t*)(P->ws + WS_CS);
    for (int idx = gtid; idx < 256 * DM; idx += GT) {
        const int row = idx >> 10; float v = 0.f;
        if (row < 8) v = P->in[2][idx]; else if (row < 136) v = P->in[3][idx - 8 * DM];
        const float s = v / (1.0f + __expf(-v));
        CS[idx] = (bf16_t)(pk2(row < 136 ? s : 0.f, 0.f) & 0xffffu);
    }
    float* TB = (float*)(P->ws + WS_TB);
    for (int idx = gtid; idx < 8 * TBLD; idx += GT) { const int h = idx / TBLD, d = idx % TBLD; const int dd = d < 128 ? d : 128;
        TB[idx] = P->in[13][t5_bucket(dd) * 8 + h] * LOG2E; }
}

template <bool FINAL>
DI void norm_phase(const float* xp, const float* xs, const float* gain, const float* modsh, bf16_t* H, float* Y, int gw, int NGW, int lane, float* xcopy = nullptr) {
    for (int blk = gw; blk < TT / 16; blk += NGW) {
        const int row0 = blk * 16; const bool prompt = row0 < TP;
        f32x4 Gv[4], Sv[4];
        if (FINAL) {
#pragma unroll
            for (int j = 0; j < 4; ++j) { Gv[j] = ((const f32x4*)gain)[lane + 64 * j]; Sv[j] = (f32x4){0.f, 0.f, 0.f, 0.f}; }
        } else if (prompt) {
            const float* mp = modsh + (size_t)(row0 >> 12) * MODLD;
#pragma unroll
            for (int j = 0; j < 4; ++j) { Gv[j] = ((const f32x4*)gain)[lane + 64 * j] * (((const f32x4*)(mp + DM))[lane + 64 * j] + 1.0f); Sv[j] = ((const f32x4*)mp)[lane + 64 * j]; }
        }
#pragma unroll 1
        for (int r4 = 0; r4 < 16; r4 += 4) {
            f32x4 v[4][4]; float ss[4];
#pragma unroll
            for (int q = 0; q < 4; ++q) { const int row = row0 + r4 + q;
                const float* xr = row < TP ? xp + (size_t)row * DM : xs + (size_t)(row - TP) * DM;
#pragma unroll
                for (int j = 0; j < 4; ++j) v[q][j] = ((const f32x4*)xr)[lane + 64 * j]; }
#pragma unroll
            for (int q = 0; q < 4; ++q) { float a = 0.f;
#pragma unroll
                for (int j = 0; j < 4; ++j) a += (v[q][j].x * v[q][j].x + v[q][j].y * v[q][j].y) + (v[q][j].z * v[q][j].z + v[q][j].w * v[q][j].w);
                ss[q] = a; }
#pragma unroll
            for (int o = 1; o < 64; o <<= 1) {
#pragma unroll
                for (int q = 0; q < 4; ++q) ss[q] += __shfl_xor(ss[q], o); }
#pragma unroll
            for (int q = 0; q < 4; ++q) { const int row = row0 + r4 + q;
                if (!FINAL && !prompt) {
                    const float* mp = modsh + (size_t)(8 + row - TP) * MODLD;
#pragma unroll
                    for (int j = 0; j < 4; ++j) { Gv[j] = ((const f32x4*)gain)[lane + 64 * j] * (((const f32x4*)(mp + DM))[lane + 64 * j] + 1.0f); Sv[j] = ((const f32x4*)mp)[lane + 64 * j]; }
                    if (xcopy) {
#pragma unroll
                        for (int j = 0; j < 4; ++j) ((f32x4*)(xcopy + (size_t)row * DM))[lane + 64 * j] = v[q][j]; }
                }
                const float rstd = 1.0f / sqrtf(ss[q] * (1.0f / DM) + EPS);
                if (FINAL) {
#pragma unroll
                    for (int j = 0; j < 4; ++j) ((f32x4*)(Y + (size_t)row * DM))[lane + 64 * j] = v[q][j] * rstd * Gv[j];
                } else {
#pragma unroll
                    for (int j = 0; j < 4; ++j) { const f32x4 h = v[q][j] * rstd * Gv[j] + Sv[j]; u32x2 w; w.x = pk2(h.x, h.y); w.y = pk2(h.z, h.w);
                        ((u32x2*)(H + (size_t)row * DM))[lane + 64 * j] = w; }
                }
            }
        }
    }
}

constexpr int KS_LD = 72, VT_LD = 264;
constexpr int ATT_KS = 0, ATT_VT = 256 * KS_LD * 2, ATT_TB = ATT_VT + 64 * VT_LD * 2;
DI void attn_unit(LAS unsigned char* lds, const bf16_t* Z, bf16_t* MIX, const float* TB, const float* sinks_l, int b, int n, int kvh, int tid) {
    const int lane = tid & 63, wid = tid >> 6, r = lane & 31, hh = lane >> 5;
    LAS bf16_t* Ks = (LAS bf16_t*)(lds + ATT_KS); LAS bf16_t* Vt = (LAS bf16_t*)(lds + ATT_VT); LAS float* tb = (LAS float*)(lds + ATT_TB);
    const int base = b * SEQ + n * 128;
#pragma unroll
    for (int i = 0; i < 4; ++i) {
        const int c = tid + 512 * i, key = c >> 3, part = c & 7;
        u32x4 kv = {0u, 0u, 0u, 0u}, vv = {0u, 0u, 0u, 0u};
        if (n > 0 || key >= 128) { const bf16_t* zr = Z + (size_t)(base - 128 + key) * INW + kvh * 64 + part * 8; kv = *(const u32x4*)(zr + 512); vv = *(const u32x4*)(zr + 640); }
        *(LAS u32x4*)(Ks + key * KS_LD + part * 8) = kv;
        LAS bf16_t* vd = Vt + (part * 8) * VT_LD + key;
        vd[0 * VT_LD] = (bf16_t)(vv.x & 0xffffu); vd[1 * VT_LD] = (bf16_t)(vv.x >> 16); vd[2 * VT_LD] = (bf16_t)(vv.y & 0xffffu); vd[3 * VT_LD] = (bf16_t)(vv.y >> 16);
        vd[4 * VT_LD] = (bf16_t)(vv.z & 0xffffu); vd[5 * VT_LD] = (bf16_t)(vv.z >> 16); vd[6 * VT_LD] = (bf16_t)(vv.w & 0xffffu); vd[7 * VT_LD] = (bf16_t)(vv.w >> 16);
    }
    for (int i = tid; i < 4 * TBLD; i += 512) tb[i] = TB[kvh * 4 * TBLD + i];
    const int hl = wid >> 1, h = kvh * 4 + hl;
    const float sink2 = sinks_l[h] * LOG2E;
    LAS const float* tbh = tb + hl * TBLD;
    bf16x8 qf[4];
    {   const bf16_t* qrow = Z + (size_t)(base + (wid & 1) * 64 + r) * INW + h * 64 + 8 * hh;
#pragma unroll
        for (int c = 0; c < 4; ++c) qf[c] = *(const bf16x8*)(qrow + 16 * c); }
    __syncthreads();
#pragma unroll 1
    for (int sub = 0; sub < 2; ++sub) {
        const int qoff = (wid & 1) * 64 + sub * 32, kt0 = qoff >> 5, q = qoff + r;
        f32x16 sc[5];
#pragma unroll
        for (int t = 0; t < 5; ++t) {
#pragma unroll
            for (int i = 0; i < 16; ++i) sc[t][i] = 0.f;
#pragma unroll
            for (int c = 0; c < 4; ++c) { const bf16x8 a = *(LAS const bf16x8*)(Ks + (32 * (kt0 + t) + r) * KS_LD + 16 * c + 8 * hh); sc[t] = MFMA32(a, qf[c], sc[t]); }
        }
        if (sub == 0) {
            const bf16_t* qrow = Z + (size_t)(base + q + 32) * INW + h * 64 + 8 * hh;
#pragma unroll
            for (int c = 0; c < 4; ++c) qf[c] = *(const bf16x8*)(qrow + 16 * c);
        }
        float m = -INFINITY;
        const int rel = r - 4 * hh;
#pragma unroll
        for (int t = 0; t < 5; ++t) {
            const bool dead = (n == 0) && (kt0 + t < 4);
#pragma unroll
            for (int i = 0; i < 16; ++i) {
                const int cc = (i & 3) + 8 * (i >> 2);
                const int dist = 128 - 32 * t + rel - cc;
                bool valid = !dead;
                if (t == 0) valid = valid && (dist <= 128);
                if (t == 4) valid = valid && (dist >= 0);
                const float bias = tbh[(t == 0 || t == 4) ? (valid ? dist : 0) : dist];
                const float val = valid ? sc[t][i] * C2 + bias : -INFINITY;
                sc[t][i] = val; m = fmaxf(m, val);
            }
        }
        m = fmaxf(m, __shfl_xor(m, 32)); m = fmaxf(m, sink2);
        float sum = 0.f;
#pragma unroll
        for (int t = 0; t < 5; ++t)
#pragma unroll
            for (int i = 0; i < 16; ++i) { const float p = __builtin_amdgcn_exp2f(sc[t][i] - m); sc[t][i] = p; sum += p; }
        sum += __shfl_xor(sum, 32); sum += __builtin_amdgcn_exp2f(sink2 - m);
        const float inv = 1.0f / sum;
        f32x16 o[2];
#pragma unroll
        for (int i = 0; i < 16; ++i) { o[0][i] = 0.f; o[1][i] = 0.f; }
#pragma unroll
        for (int t = 0; t < 5; ++t)
#pragma unroll
            for (int s = 0; s < 2; ++s) {
                u32x4 pw; pw.x = pk2(sc[t][8 * s + 0], sc[t][8 * s + 1]); pw.y = pk2(sc[t][8 * s + 2], sc[t][8 * s + 3]); pw.z = pk2(sc[t][8 * s + 4], sc[t][8 * s + 5]); pw.w = pk2(sc[t][8 * s + 6], sc[t][8 * s + 7]);
                const bf16x8 pb = __builtin_bit_cast(bf16x8, pw);
#pragma unroll
                for (int dt = 0; dt < 2; ++dt) {
                    LAS const bf16_t* vr = Vt + (32 * dt + r) * VT_LD + 32 * (kt0 + t) + 16 * s + 4 * hh;
                    const s16x4 lo = *(LAS const s16x4*)vr, hi = *(LAS const s16x4*)(vr + 8);
                    const bf16x8 a = __builtin_shufflevector(lo, hi, 0, 1, 2, 3, 4, 5, 6, 7);
                    o[dt] = MFMA32(a, pb, o[dt]);
                }
            }
        bf16_t* orow = MIX + (size_t)(base + q) * DM + h * 64 + 4 * hh;
#pragma unroll
        for (int dt = 0; dt < 2; ++dt)
#pragma unroll
            for (int g4 = 0; g4 < 4; ++g4) { u32x2 w; w.x = pk2(o[dt][4 * g4 + 0] * inv, o[dt][4 * g4 + 1] * inv); w.y = pk2(o[dt][4 * g4 + 2] * inv, o[dt][4 * g4 + 3] * inv);
                *(u32x2*)(orow + 32 * dt + 8 * g4) = w; }
    }
    __syncthreads();
}

DI void sattn_task(LAS float* wl, const bf16_t* Z, const float* ck, const float* cv, bf16_t* MIX, const float* TB, const float* sinks_l, int s, int kvh, int lane) {
    const bf16_t* zrow = Z + (size_t)(TP + s) * INW;
#pragma unroll
    for (int hl = 0; hl < 4; ++hl) wl[hl * 64 + lane] = bf2f(zrow[(kvh * 4 + hl) * 64 + lane]) * C2;
    const float kn = bf2f(zrow[512 + kvh * 64 + lane]);
    asm volatile("s_waitcnt lgkmcnt(0)" ::: "memory");
    float sc[4][2];
#pragma unroll
    for (int kk = 0; kk < 2; ++kk) {
        const int j = lane + 64 * kk;
        const float* krow = ck + ((size_t)(s * 128 + j) * 2 + kvh) * 64;
        float a[4] = {0.f, 0.f, 0.f, 0.f};
#pragma unroll 8
        for (int d4 = 0; d4 < 16; ++d4) { const f32x4 kv = *(const f32x4*)(krow + 4 * d4);
#pragma unroll
            for (int hl = 0; hl < 4; ++hl) { const f32x4 qv = *(LAS const f32x4*)(wl + hl * 64 + 4 * d4); a[hl] += (kv.x * qv.x + kv.y * qv.y) + (kv.z * qv.z + kv.w * qv.w); } }
#pragma unroll
        for (int hl = 0; hl < 4; ++hl) sc[hl][kk] = a[hl] + TB[(kvh * 4 + hl) * TBLD + (128 - j)];
    }
    float pn[4];
#pragma unroll
    for (int hl = 0; hl < 4; ++hl) {
        const float sink2 = sinks_l[kvh * 4 + hl] * LOG2E;
        const float snew = wave_sum(kn * wl[hl * 64 + lane]) + TB[(kvh * 4 + hl) * TBLD + 0];
        float m = wave_max(fmaxf(sc[hl][0], sc[hl][1])); m = fmaxf(m, fmaxf(snew, sink2));
        const float p0 = __builtin_amdgcn_exp2f(sc[hl][0] - m), p1 = __builtin_amdgcn_exp2f(sc[hl][1] - m), pnw = __builtin_amdgcn_exp2f(snew - m);
        const float sum = wave_sum(p0 + p1) + pnw + __builtin_amdgcn_exp2f(sink2 - m);
        const float inv = 1.0f / sum;
        wl[256 + hl * TBLD + lane] = p0 * inv; wl[256 + hl * TBLD + 64 + lane] = p1 * inv; pn[hl] = pnw * inv;
    }
    asm volatile("s_waitcnt lgkmcnt(0)" ::: "memory");
    const int jg = lane >> 4, d4 = lane & 15;
    f32x4 o[4];
#pragma unroll
    for (int hl = 0; hl < 4; ++hl) o[hl] = (f32x4){0.f, 0.f, 0.f, 0.f};
    const float* vb = cv + ((size_t)(s * 128 + jg) * 2 + kvh) * 64 + 4 * d4;
#pragma unroll 8
    for (int i = 0; i < 32; ++i) { const f32x4 vv = *(const f32x4*)(vb + (size_t)i * 512);
#pragma unroll
        for (int hl = 0; hl < 4; ++hl) o[hl] += vv * wl[256 + hl * TBLD + 4 * i + jg]; }
    const f32x4 vn4 = bf4_to_f4(zrow + 640 + kvh * 64 + 4 * d4);
#pragma unroll
    for (int hl = 0; hl < 4; ++hl) {
#pragma unroll
        for (int e = 0; e < 4; ++e) { float v = o[hl][e]; v += __shfl_xor(v, 16); v += __shfl_xor(v, 32); o[hl][e] = v + pn[hl] * vn4[e]; }
        if (jg == 0) { u32x2 w; w.x = pk2(o[hl][0], o[hl][1]); w.y = pk2(o[hl][2], o[hl][3]); *(u32x2*)(MIX + (size_t)(TP + s) * DM + (kvh * 4 + hl) * 64 + 4 * d4) = w; }
    }
    asm volatile("s_waitcnt lgkmcnt(0)" ::: "memory");
}

constexpr int PU_LD = 136;
constexpr int POOL_U = 0, POOL_P = 144 * PU_LD * 2;
DI void pool_unit(LAS unsigned char* lds, const bf16_t* Z, const float* sp_l, const bf16_t* PWT, const float* pscale_l, bf16_t* MIX, int ub, int tid) {
    const int lane = tid & 63, wid = tid >> 6, r = lane & 31, hh = lane >> 5;
    LAS bf16_t* Ug = (LAS bf16_t*)(lds + POOL_U); LAS bf16_t* Pg = (LAS bf16_t*)(lds + POOL_P);
    const bool prompt = ub < 256; const int b = ub >> 5, n = ub & 31;
    const int s0 = ((ub - 256) & 3) * 32;
    const int rowbase = prompt ? b * SEQ + n * 128 : TP + s0;
    const int g_lo = prompt ? 0 : (ub - 256) >> 2, g_hi = prompt ? 4 : g_lo + 1, mtiles = prompt ? 4 : 1;
#pragma unroll 1
    for (int g = g_lo; g < g_hi; ++g) {
        const int w = 2 << g;
        const int mt = wid >> 1, nt0 = (wid & 1) * 2;
        bf16x8 bfr[8][2];
#pragma unroll
        for (int ks = 0; ks < 8; ++ks)
#pragma unroll
            for (int qq = 0; qq < 2; ++qq) bfr[ks][qq] = *(const bf16x8*)(PWT + (size_t)g * 16384 + (32 * (nt0 + qq) + r) * 128 + 16 * ks + 8 * hh);
        if (prompt) {
            for (int c = tid; c < 143 * 16; c += 512) { const int row = c >> 4, part = c & 15, pos = n * 128 - 15 + row;
                u32x4 v = {0u, 0u, 0u, 0u};
                if (pos >= 0) v = *(const u32x4*)(Z + (size_t)(b * SEQ + pos) * INW + 768 + g * 128 + part * 8);
                *(LAS u32x4*)(Ug + row * PU_LD + part * 8) = v; }
            __syncthreads();
            const int c2 = tid & 63, t0 = wid * 16;
            float s0 = 0.f, s1 = 0.f;
            for (int s = 0; s < w; ++s) { const unsigned uv = *(LAS const unsigned*)(Ug + (t0 + 15 - s) * PU_LD + 2 * c2); s0 += __uint_as_float(uv << 16); s1 += __uint_as_float(uv & 0xffff0000u); }
            for (int t = t0; t < t0 + 16; ++t) {
                const unsigned uv = *(LAS const unsigned*)(Ug + (t + 15) * PU_LD + 2 * c2);
                const float u0 = __uint_as_float(uv << 16), u1 = __uint_as_float(uv & 0xffff0000u);
                const int pos1 = n * 128 + t + 1; const float ic = 1.0f / (float)(pos1 < w ? pos1 : w);
                *(LAS unsigned*)(Pg + t * PU_LD + 2 * c2) = pk2(s0 * ic - u0, s1 * ic - u1);
                if (t + 1 < t0 + 16) {
                    const unsigned ua = *(LAS const unsigned*)(Ug + (t + 16) * PU_LD + 2 * c2), ud = *(LAS const unsigned*)(Ug + (t + 16 - w) * PU_LD + 2 * c2);
                    s0 += __uint_as_float(ua << 16) - __uint_as_float(ud << 16); s1 += __uint_as_float(ua & 0xffff0000u) - __uint_as_float(ud & 0xffff0000u);
                }
            }
        } else {
            for (int idx = tid; idx < 32 * 64; idx += 512) { const int sl = idx >> 6, c2 = idx & 63, s = s0 + sl;
                const unsigned uv = *(const unsigned*)(Z + (size_t)(TP + s) * INW + 768 + g * 128 + 2 * c2);
                const float u0 = __uint_as_float(uv << 16), u1 = __uint_as_float(uv & 0xffff0000u);
                float a0 = u0, a1 = u1;
#pragma unroll
                for (int i = 0; i < 15; ++i) { if (i >= 16 - w) { const f32x2 sv = *(const f32x2*)(sp_l + ((size_t)s * 15 + i) * 512 + g * 128 + 2 * c2); a0 += sv.x; a1 += sv.y; } }
                const float ic = 1.0f / (float)w;
                *(LAS unsigned*)(Pg + sl * PU_LD + 2 * c2) = pk2(a0 * ic - u0, a1 * ic - u1); }
        }
        __syncthreads();
        f32x16 acc[2];
#pragma unroll
        for (int i = 0; i < 16; ++i) { acc[0][i] = 0.f; acc[1][i] = 0.f; }
        if (mt < mtiles) {
#pragma unroll
        for (int ks = 0; ks < 8; ++ks) {
            const bf16x8 a = *(LAS const bf16x8*)(Pg + (32 * mt + r) * PU_LD + 16 * ks + 8 * hh);
#pragma unroll
            for (int qq = 0; qq < 2; ++qq) acc[qq] = MFMA32(a, bfr[ks][qq], acc[qq]);
        }
#pragma unroll
        for (int qq = 0; qq < 2; ++qq) { const int col = g * 128 + 32 * (nt0 + qq) + r; const float ps = pscale_l[col];
#pragma unroll
            for (int i = 0; i < 16; ++i) { const int row = 32 * mt + crow(i, hh);
                MIX[(size_t)(rowbase + row) * DM + 512 + col] = (bf16_t)(pk2(acc[qq][i] * ps, 0.f) & 0xffffu); } }
        }
        __syncthreads();
    }
}

DI void states_copy(KP P, const bf16_t* Z, int l, int gtid, int GT) {
    float* out = P->out;
    for (int idx = gtid; idx < 8 * 128 * 32; idx += GT) { const int c4 = idx & 31, j = (idx >> 5) & 127, b = idx >> 12;
        const bf16_t* zr = Z + (size_t)(b * SEQ + SEQ - 128 + j) * INW + c4 * 4;
        *(f32x4*)(out + O_KP + ((size_t)(l * 8 + b) * 128 + j) * 128 + c4 * 4) = bf4_to_f4(zr + 512);
        *(f32x4*)(out + O_VP + ((size_t)(l * 8 + b) * 128 + j) * 128 + c4 * 4) = bf4_to_f4(zr + 640); }
    for (int idx = gtid; idx < 8 * 15 * 128; idx += GT) { const int c4 = idx & 127, bi = idx >> 7, i = bi % 15, b = bi / 15;
        *(f32x4*)(out + O_PP + ((size_t)(l * 8 + b) * 15 + i) * 512 + c4 * 4) = bf4_to_f4(Z + (size_t)(b * SEQ + SEQ - 15 + i) * INW + 768 + c4 * 4); }
    const float* ck = P->in[4] + (size_t)l * 128 * 128 * 128; const float* cv = P->in[5] + (size_t)l * 128 * 128 * 128; const float* sp = P->in[6] + (size_t)l * 128 * 15 * 512;
    for (int idx = gtid; idx < 128 * 128 * 32; idx += GT) { const int c4 = idx & 31, j = (idx >> 5) & 127, s = idx >> 12;
        const bf16_t* zr = Z + (size_t)(TP + s) * INW + c4 * 4;
        f32x4 kv, vv;
        if (j < 127) { kv = *(const f32x4*)(ck + ((size_t)s * 128 + j + 1) * 128 + c4 * 4); vv = *(const f32x4*)(cv + ((size_t)s * 128 + j + 1) * 128 + c4 * 4); }
        else { kv = bf4_to_f4(zr + 512); vv = bf4_to_f4(zr + 640); }
        *(f32x4*)(out + O_KS + ((size_t)(l * 128 + s) * 128 + j) * 128 + c4 * 4) = kv;
        *(f32x4*)(out + O_VS + ((size_t)(l * 128 + s) * 128 + j) * 128 + c4 * 4) = vv; }
    for (int idx = gtid; idx < 128 * 15 * 128; idx += GT) { const int c4 = idx & 127, si = idx >> 7, i = si % 15, s = si / 15;
        f32x4 v;
        if (i < 14) v = *(const f32x4*)(sp + ((size_t)s * 15 + i + 1) * 512 + c4 * 4); else v = bf4_to_f4(Z + (size_t)(TP + s) * INW + 768 + c4 * 4);
        *(f32x4*)(out + O_PS + ((size_t)(l * 128 + s) * 15 + i) * 512 + c4 * 4) = v; }
}

#define XB_TMO      128
#define XB_XCNT(j)  (256  + 64 * (j))
#define XB_XSUB(j)  (1280 + 64 * (j))
#define XB_XGEN(j)  (2304 + 64 * (j))
#define XB_TOP      3328
#define XB_TOPGEN   3392
#define XCD_BAR_WORDS 3456
#define XB_SPIN_CAP (1u << 18)

__device__ __forceinline__ unsigned xb_ld(unsigned* p)              { return __hip_atomic_load(p, __ATOMIC_RELAXED, __HIP_MEMORY_SCOPE_AGENT); }
__device__ __forceinline__ unsigned xb_add(unsigned* p, unsigned v) { return __hip_atomic_fetch_add(p, v, __ATOMIC_RELAXED, __HIP_MEMORY_SCOPE_AGENT); }
__device__ __forceinline__ unsigned xb_xcc_id() { return (unsigned)__builtin_amdgcn_s_getreg((3 << 11) | 20) & 0xFu; }
#define XB_SPIN(cond, bar) do { unsigned _sp = 0; while (cond) { __builtin_amdgcn_s_sleep(1); \
    if ((++_sp & 255u) == 0u) { if (xb_ld(&(bar)[XB_TMO])) break; if (_sp > XB_SPIN_CAP) { atomicAdd(&(bar)[XB_TMO], 1u); break; } } } } while (0)

struct XcdBarrier {
    unsigned* bar; unsigned x;
    volatile LAS unsigned* st;
};

__device__ __forceinline__ XcdBarrier xcd_barrier_post(unsigned* bar, volatile LAS unsigned* st) {
    XcdBarrier b; b.bar = bar; b.x = xb_xcc_id(); b.st = st;
    if (threadIdx.x == 0) (void)xb_add(&bar[XB_XCNT(b.x)], 1u);
    return b;
}
__device__ __forceinline__ void xcd_barrier_complete(unsigned* bar, unsigned x, unsigned& nloc, unsigned& nx) {
    const unsigned G = gridDim.x * gridDim.y * gridDim.z;
    unsigned sum, cnt, mine, sp = 0u;
    for (;;) {
        sum = 0u; cnt = 0u; mine = 0u;
#pragma unroll
        for (unsigned j = 0; j < 16; ++j) { const unsigned c = xb_ld(&bar[XB_XCNT(j)]); sum += c; cnt += (c > 0u) ? 1u : 0u; mine = (j == x) ? c : mine; }
        if (sum == G) break;
        __builtin_amdgcn_s_sleep(1);
        if ((++sp & 255u) == 0u) { if (xb_ld(&bar[XB_TMO])) break; if (sp > XB_SPIN_CAP) { atomicAdd(&bar[XB_TMO], 1u); break; } }
    }
    nloc = mine > 0u ? mine : 1u; nx = cnt > 0u ? cnt : 1u;
}

__device__ __forceinline__ void xcd_barrier(const XcdBarrier& b) {
    asm volatile("s_waitcnt vmcnt(0)" ::: "memory");
    __syncthreads();
    if (threadIdx.x == 0) {
        unsigned* bar = b.bar;
        __builtin_amdgcn_s_waitcnt(0);
        unsigned nloc = b.st[0], nx = b.st[1];
        if (nloc == 0u) { xcd_barrier_complete(bar, b.x, nloc, nx); b.st[0] = nloc; b.st[1] = nx; }
        const unsigned old = xb_add(&bar[XB_XSUB(b.x)], 1u);
        const unsigned gen = old / nloc;
        if (old + 1u == (gen + 1u) * nloc) {
            __builtin_amdgcn_fence(__ATOMIC_RELEASE, "agent");
            asm volatile("s_waitcnt vmcnt(0)" ::: "memory");
            const unsigned og = xb_add(&bar[XB_TOP], 1u);
            const unsigned tg = og / nx;
            if (og + 1u == (tg + 1u) * nx) xb_add(&bar[XB_TOPGEN], 1u);
            else XB_SPIN(xb_ld(&bar[XB_TOPGEN]) == tg, bar);
            __builtin_amdgcn_fence(__ATOMIC_ACQUIRE, "agent");
            xb_add(&bar[XB_XGEN(b.x)], 1u);
            asm volatile("s_waitcnt vmcnt(0)" ::: "memory");
        } else {
            XB_SPIN(xb_ld(&bar[XB_XGEN(b.x)]) == gen, bar);
            __builtin_amdgcn_fence(__ATOMIC_ACQUIRE, "agent");
            asm volatile("s_waitcnt vmcnt(0)" ::: "memory");
        }
    }
    __syncthreads();
}
DI KP kargs() { unsigned long long v = (unsigned long long)__builtin_amdgcn_kernarg_segment_ptr(); asm volatile("" : "+s"(v)); return (KP)v; }
#define PH_VARS KP Pk = kargs(); int tid = threadIdx.x; asm volatile("" : "+v"(tid)); const int lane = tid & 63, wid = __builtin_amdgcn_readfirstlane(tid >> 6); \
    const int G = gridDim.x, bx = blockIdx.x; const int gw = bx * 8 + wid, NGW = G * 8, gtid = bx * 512 + tid, GT = G * 512; unsigned char* ws = Pk->ws; (void)lane; (void)gw; (void)NGW; (void)gtid; (void)GT; (void)ws;
__global__ void __launch_bounds__(512, 2) fwd(Params Pdummy) {
    extern __shared__ __attribute__((aligned(16))) unsigned char lds_g[];
    LAS unsigned char* lds = (LAS unsigned char*)lds_g;
    cg::grid_group grid = cg::this_grid();
    int lo, hi; unsigned* barw; { KP Pk = kargs(); lo = Pk->ph_lo; hi = Pk->ph_hi; barw = (unsigned*)(Pk->ws + WS_BAR); }
    if (hi > 1000) grid.sync();
    if (threadIdx.x < 2) ((volatile LAS unsigned*)(lds + 131072))[threadIdx.x] = 0u;
    __syncthreads();
    XcdBarrier xb; xb.bar = barw; xb.x = 0; xb.st = nullptr;
    if (hi - lo > 1) xb = xcd_barrier_post(barw, (volatile LAS unsigned*)(lds + 131072));
#ifndef PROBE_REP
#define PROBE_REP -1
#endif
#ifndef PROBE_N
#define PROBE_N 0
#endif
#ifndef PROBE_MIX
#define PROBE_MIX 0
#endif
#ifndef PROBE_SYNC
#define PROBE_SYNC 0
#endif
#define REPS(k) for (int rep_ = 0; rep_ < ((k) == PROBE_REP ? 1 + PROBE_N : 1); ++rep_)
#define IN(k) (lo <= (k) && (k) < hi)
#define SEAM(k) do { if (IN(k) && IN((k) + 1)) xcd_barrier(xb); } while (0)
    if (IN(0)) REPS(0) { PH_VARS prologue(Pk, lds, gw, NGW, gtid, GT, wid, lane); }
    SEAM(0);
    for (int i_ = 0; i_ < PROBE_SYNC; ++i_) xcd_barrier(xb);
    if (IN(1)) REPS(1) { PH_VARS
        pg8::Gemm g{(const bf16_t*)(ws + WS_CS), (const bf16_t*)(ws + WS_WADA), 256, MODLD, DM}; pg8::StaticOrder S; S.init(256, MODLD, G, bx);
        EpiMod E{(float*)(ws + WS_MOD), Pk->in[8]};
        pg8::gemm_phase<EpiMod, pg8::StaticOrder, PG8_ALIGN, PG8_SP2>(lds, g, S, E, tid);
    }
    SEAM(1);
#pragma unroll 1
    for (int l = 0; l < 2; ++l) {
        const int pb = 2 + 10 * l;
#define LAYER_VARS unsigned char* wl = ws + WS_L0 + (size_t)l * LAYER_BYTES; float* X = (float*)(ws + WS_X); bf16_t* H = (bf16_t*)(ws + WS_H); bf16_t* ACT = (bf16_t*)(ws + WS_ACT); bf16_t* Z = (bf16_t*)(ws + WS_Z); bf16_t* MIX = (bf16_t*)(ws + WS_MIX); \
        const float* modl = (const float*)(ws + WS_MOD) + (size_t)l * NMOD; const float* gain_l = Pk->in[9] + (size_t)l * 3 * DM; \
        (void)wl; (void)X; (void)H; (void)ACT; (void)Z; (void)MIX; (void)modl; (void)gain_l;
        if (IN(pb + 0)) REPS(pb + 0) { PH_VARS LAYER_VARS
            const float* xin_p = l == 0 ? Pk->in[0] : X; const float* xin_s = l == 0 ? Pk->in[1] : X + (size_t)TP * DM;
            norm_phase<false>(xin_p, xin_s, gain_l, modl, H, nullptr, gw, NGW, lane, l == 0 ? X : nullptr); }
        SEAM(pb + 0);
        if (IN(pb + 1)) REPS(pb + 1) { PH_VARS LAYER_VARS
            pg8::Gemm g{H, (const bf16_t*)(wl + LW_GU1), MPAD, 2 * FF, DM}; pg8::StaticOrder S; S.init(MPAD, 2 * FF, G, bx, DM, TP / 256);
            EpiSwiGLU E{ACT};
            pg8::gemm_phase<EpiSwiGLU, pg8::StaticOrder, PG8_ALIGN, PG8_SP2>(lds, g, S, E, tid);
        }
        SEAM(pb + 1);
        if (IN(pb + 2)) REPS(pb + 2) { PH_VARS LAYER_VARS
            const float* xin_p = l == 0 ? Pk->in[0] : X; const float* xin_s = l == 0 ? Pk->in[1] : X + (size_t)TP * DM;
            pg8::Gemm g{ACT, (const bf16_t*)(wl + LW_D1), MPAD, DM, FF}; SplitOrder S; S.init(DM, FF, G, bx);
            EpiResid E{xin_p, xin_s, X, modl + 2 * DM, 0.5f};
            pg8::gemm_phase<EpiResid, SplitOrder, PG8_ALIGN, PG8_SP2>(lds, g, S, E, tid);
#ifdef PROBE_FD
            if (l == 0) { pg8::StaticOrder S2; S2.init(TP, DM, G, bx); pg8::gemm_phase<EpiResid, pg8::StaticOrder, PG8_ALIGN, PG8_SP2>(lds, g, S2, E, tid); }
#endif
        }
        SEAM(pb + 2);
        if (IN(pb + 3)) REPS(pb + 3) { PH_VARS LAYER_VARS norm_phase<false>(X, X + (size_t)TP * DM, gain_l + DM, modl + 3 * DM, H, nullptr, gw, NGW, lane); }
        SEAM(pb + 3);
        if (IN(pb + 4)) REPS(pb + 4) { PH_VARS LAYER_VARS
            pg8::Gemm g{H, (const bf16_t*)(wl + LW_IN), MPAD, INW, DM}; pg8::StaticOrder S; S.init(MPAD, INW, G, bx, DM, TP / 256);
            EpiStoreBf16 E{Z, INW};
            pg8::gemm_phase<EpiStoreBf16, pg8::StaticOrder, PG8_ALIGN, PG8_SP2>(lds, g, S, E, tid);
        }
        SEAM(pb + 4);
        if (IN(pb + 5)) REPS(pb + 5) { PH_VARS LAYER_VARS
            const float* TB = (const float*)(ws + WS_TB);
            const float* sinks_l = Pk->in[12] + l * 8;
            const float* ck = Pk->in[4] + (size_t)l * 128 * 128 * 128; const float* cv = Pk->in[5] + (size_t)l * 128 * 128 * 128; const float* sp = Pk->in[6] + (size_t)l * 128 * 15 * 512;
            for (int id = bx; id < 816; id += G) {
                if (id < 512) { for (int rp = 0; rp < (PROBE_MIX == 1 ? 2 : 1); ++rp) { const int kvh = id & 1, bn = id >> 1; attn_unit(lds, Z, MIX, TB, sinks_l, bn >> 5, bn & 31, kvh, tid); } }
                else if (id < 784) { for (int rp = 0; rp < (PROBE_MIX == 2 ? 2 : 1); ++rp) pool_unit(lds, Z, sp, (const bf16_t*)(wl + LW_POOL), Pk->in[15] + l * 512, MIX, id - 512, tid); }
                else { for (int rp = 0; rp < (PROBE_MIX == 3 ? 2 : 1); ++rp) { const int task = (id - 784) * 8 + wid; sattn_task((LAS float*)(lds + wid * 4096), Z, ck, cv, MIX, TB, sinks_l, task >> 1, task & 1, lane); __syncthreads(); } }
            }
            for (int rp = 0; rp < (PROBE_MIX == 4 ? 2 : 1); ++rp) states_copy(Pk, Z, l, gtid, GT);
        }
        SEAM(pb + 5);
        if (IN(pb + 6)) REPS(pb + 6) { PH_VARS LAYER_VARS
            pg8::Gemm g{MIX, (const bf16_t*)(wl + LW_OUT), MPAD, DM, DM}; SplitOrder S; S.init(DM, DM, G, bx);
            EpiResid E{X, X + (size_t)TP * DM, X, modl + 5 * DM, 1.0f};
            pg8::gemm_phase<EpiResid, SplitOrder, PG8_ALIGN, PG8_SP2>(lds, g, S, E, tid);
        }
        SEAM(pb + 6);
        if (IN(pb + 7)) REPS(pb + 7) { PH_VARS LAYER_VARS norm_phase<false>(X, X + (size_t)TP * DM, gain_l + 2 * DM, modl + 6 * DM, H, nullptr, gw, NGW, lane); }
        SEAM(pb + 7);
        if (IN(pb + 8)) REPS(pb + 8) { PH_VARS LAYER_VARS
            pg8::Gemm g{H, (const bf16_t*)(wl + LW_GU2), MPAD, 2 * FF, DM}; pg8::StaticOrder S; S.init(MPAD, 2 * FF, G, bx, DM, TP / 256);
            EpiSwiGLU E{ACT};
            pg8::gemm_phase<EpiSwiGLU, pg8::StaticOrder, PG8_ALIGN, PG8_SP2>(lds, g, S, E, tid);
        }
        SEAM(pb + 8);
        if (IN(pb + 9)) REPS(pb + 9) { PH_VARS LAYER_VARS
            pg8::Gemm g{ACT, (const bf16_t*)(wl + LW_D2), MPAD, DM, FF}; SplitOrder S; S.init(DM, FF, G, bx);
            EpiResid E{X, X + (size_t)TP * DM, X, modl + 8 * DM, 0.5f};
            pg8::gemm_phase<EpiResid, SplitOrder, PG8_ALIGN, PG8_SP2>(lds, g, S, E, tid);
        }
        SEAM(pb + 9);
    }
    if (IN(22)) REPS(22) { PH_VARS float* X = (float*)(ws + WS_X); norm_phase<true>(X, X + (size_t)TP * DM, Pk->in[22], nullptr, nullptr, Pk->out, gw, NGW, lane); }
#undef IN
#undef SEAM
}

extern "C" void kernel_launch(void* const* d_in, const int* in_sizes, int n_in, void* d_out, int out_size, void* d_ws, size_t ws_size, hipStream_t stream) {
    static int grid = 0;
    if (grid == 0) {
        if (n_in != 23 || (size_t)out_size != O_END || ws_size < WS_END) { fprintf(stderr, "kernel_launch: unexpected sizes n_in %d out %d ws %zu\n", n_in, out_size, ws_size); grid = -1; return; }
        int dev = 0, cus = 0, per_cu = 0;
        (void)hipGetDevice(&dev); (void)hipDeviceGetAttribute(&cus, hipDeviceAttributeMultiprocessorCount, dev);
        if (hipFuncSetAttribute((const void*)fwd, hipFuncAttributeMaxDynamicSharedMemorySize, LDS_BYTES) != hipSuccess) { fprintf(stderr, "kernel_launch: hipFuncSetAttribute failed\n"); grid = -1; return; }
        if (hipOccupancyMaxActiveBlocksPerMultiprocessor(&per_cu, (const void*)fwd, 512, LDS_BYTES) != hipSuccess || per_cu < 1) { fprintf(stderr, "kernel_launch: occupancy query says %d\n", per_cu); per_cu = 1; }
        (void)hipGetLastError();
        grid = cus * per_cu;
    }
    if (grid < 0) return;
    Params p{};
    for (int i = 0; i < 23; ++i) p.in[i] = (const float*)d_in[i];
    p.out = (float*)d_out; p.ws = (unsigned char*)d_ws;
#if N_LAUNCH_PER_PHASE
    for (int ph = 0; ph < NPH; ++ph) { p.ph_lo = ph; p.ph_hi = ph + 1; hipLaunchKernelGGL(fwd, dim3(grid), dim3(512), LDS_BYTES, stream, p); }
#else
    p.ph_lo = 0; p.ph_hi = NPH;
    if (hipMemsetAsync((char*)d_ws + WS_BAR, 0, WS_BAR_BYTES, stream) != hipSuccess) { fprintf(stderr, "kernel_launch: memset failed\n"); return; }
    void* args[] = {&p};
    hipError_t e = hipLaunchCooperativeKernel((const void*)fwd, dim3(grid), dim3(512), args, LDS_BYTES, stream);
    if (e != hipSuccess) fprintf(stderr, "kernel_launch: cooperative launch failed: %s (grid %d)\n", hipGetErrorString(e), grid);
#endif
}
```

```cpp
#include <hip/hip_runtime.h>
#include <hip/hip_cooperative_groups.h>
#include <cstdio>
#include <cstdint>
namespace cg = cooperative_groups;
namespace pg8 {
#define PG8_LAS __attribute__((address_space(3)))
typedef unsigned short bf16_t;
typedef short bf16x8 __attribute__((ext_vector_type(8)));
typedef float f32x4 __attribute__((ext_vector_type(4)));
typedef unsigned u32x4 __attribute__((ext_vector_type(4)));
constexpr int BM = 256, BK = 64, HALF = 128, HTB = HALF * BK * 2  , STAGE_BYTES = 8 * HTB, NXCD = 8, WGM = 8;

__host__ __device__ __forceinline__ int lds_byte(int r, int c) { const int st = (r >> 4) * 2 + (c >> 5), rr = r & 15, cc = c & 31, ob = rr * 64 + cc * 2; return st * 1024 + (ob ^ (((ob >> 9) & 1) << 5)); }
__host__ __device__ __forceinline__ void stage_rc(int b, int& R, int& C) { const int st = b / 1024, sb = b % 1024, swz = sb ^ (((sb >> 9) & 1) << 5); R = (st >> 1) * 16 + swz / 64; C = (st & 1) * 32 + (swz % 64) / 2; }
__host__ __device__ __forceinline__ int perm32(int rho) { const int n = rho >> 4, i = rho & 15; return 8 * (i >> 2) + 4 * n + (i & 3); }

struct Unit { int pm, pn, k0; };
struct Gemm { const bf16_t* A; const bf16_t* Bt; int M, N, K; };

struct StaticOrder {
    static constexpr bool SPLIT = false;
    int nM, nN, nwg, G, c;
    __host__ __device__ void init(int M, int N, int G_, int c_, int K_ = 1024, int half_pm_ = -1) { nM = M / BM; nN = N / BM; nwg = nM * nN; G = G_; c = c_; (void)K_; (void)half_pm_; }
    __host__ __device__ bool next(int i, Unit& u) const {
        const long L = (long)i * G + c; if (L >= nwg) return false;
        int wgid = (int)L; { const int q = nwg / NXCD, r = nwg % NXCD, xcd = wgid % NXCD, off = wgid / NXCD; wgid = (xcd < r ? xcd * (q + 1) : r * (q + 1) + (xcd - r) * q) + off; }
        const int nig = WGM * nN, gid = wgid / nig, fm = gid * WGM, gsz = (nM - fm) < WGM ? (nM - fm) : WGM;
        u.pm = fm + ((wgid % nig) % gsz); u.pn = (wgid % nig) / gsz; u.k0 = 0; return true;
    }
    __device__ __forceinline__ void a_ready(const Unit&) const {}
    __device__ __forceinline__ void done(const Unit&) const {}
};

__device__ __forceinline__ unsigned cvt_pk_bf16(float lo, float hi) { unsigned r; asm volatile("v_cvt_pk_bf16_f32 %0, %1, %2" : "=v"(r) : "v"(lo), "v"(hi)); return r; }
typedef float f32x2 __attribute__((ext_vector_type(2)));
template <class Epi, class Sched, bool ALIGN_EPI = false, bool SP2 = false>
__device__ __forceinline__ void gemm_phase(PG8_LAS unsigned char* lds, const Gemm g, const Sched& S, const Epi& E, const int tid_in) {
    const int tid = tid_in, wid = __builtin_amdgcn_readfirstlane(tid >> 6), lane = tid & 63, wr = wid >> 2, wc = wid & 3, fr = lane & 15, fq = lane >> 4;
    const int K = g.K;
    unsigned voffA[2], voffB[2];
#pragma unroll
    for (int i = 0; i < 2; ++i) { int R, C; stage_rc(tid * 16 + i * 8192, R, C); const int Rb = Epi::PERM ? ((R & ~31) + perm32(R & 31)) : R;
        voffA[i] = (unsigned)(R * K + C) * 2u; voffB[i] = (unsigned)(Rb * K + C) * 2u; }
    const size_t kstep = (size_t)(BK * 2);
    const size_t hstep = (size_t)HALF * K * 2;
    const size_t tstep = 2 * hstep;
    const unsigned ldsw = (unsigned)wid * 1024u;
    const int aoff = lds_byte(wr * 64 + fr, fq * 8), boff = lds_byte(wc * 32 + fr, fq * 8);
#define PG8_SA(b, h) (((b) * 2 + (h)) * HTB)
#define PG8_SB(b, h) ((4 + (b) * 2 + (h)) * HTB)
#define PG8_STAGE(bufoff, gbase, voff) do { _Pragma("unroll") for (int _i = 0; _i < 2; ++_i) \
        __builtin_amdgcn_global_load_lds((const unsigned*)((const char*)(gbase) + (voff)[_i]), (PG8_LAS unsigned*)(lds + (bufoff) + ldsw + _i * 8192), 16, 0, 0); } while (0)
#define PG8_LDA(dst, b, h) do { _Pragma("unroll") for (int m = 0; m < 4; ++m) _Pragma("unroll") for (int k = 0; k < 2; ++k) dst[m][k] = *(const PG8_LAS bf16x8*)(lds + PG8_SA(b, h) + aoff + m * 2048 + k * 1024); } while (0)
#define PG8_LDB(dst, b, h) do { _Pragma("unroll") for (int n = 0; n < 2; ++n) _Pragma("unroll") for (int k = 0; k < 2; ++k) dst[n][k] = *(const PG8_LAS bf16x8*)(lds + PG8_SB(b, h) + boff + n * 2048 + k * 1024); } while (0)
#define PG8_MMA(ai, bj, At, Bt) do { __builtin_amdgcn_s_setprio(1); _Pragma("unroll") for (int m = 0; m < 4; ++m) _Pragma("unroll") for (int n = 0; n < 2; ++n) _Pragma("unroll") for (int k = 0; k < 2; ++k) \
        acc[ai][bj][m][n] = __builtin_amdgcn_mfma_f32_16x16x32_bf16(Bt[n][k], At[m][k], acc[ai][bj][m][n], 0, 0, 0); __builtin_amdgcn_s_setprio(0); } while (0)
#define PG8_WAIT_V(n) asm volatile("s_waitcnt vmcnt(" #n ")" ::: "memory")
#define PG8_WAIT_L(n) asm volatile("s_waitcnt lgkmcnt(" #n ")" ::: "memory")
#define PG8_BAR __builtin_amdgcn_s_barrier()
#define PG8_SCHED __builtin_amdgcn_sched_barrier(0)
    Unit cur, nxt; int ui = 0;
    if (!S.next(0, cur)) return;
    f32x4 acc[2][2][4][2];
#pragma unroll
    for (int a = 0; a < 2; ++a)
#pragma unroll
        for (int b = 0; b < 2; ++b)
#pragma unroll
            for (int m = 0; m < 4; ++m)
#pragma unroll
                for (int n = 0; n < 2; ++n) acc[a][b][m][n] = (f32x4){0.f, 0.f, 0.f, 0.f};
    bf16x8 At[4][2], B0[2][2], B1[2][2];
    const char* cA = (const char*)g.A + (size_t)cur.pm * tstep + (size_t)cur.k0 * kstep; const char* cB = (const char*)g.Bt + (size_t)cur.pn * tstep + (size_t)cur.k0 * kstep;
    S.a_ready(cur);
    if constexpr (SP2) {
        PG8_STAGE(PG8_SB(0, 0), cB, voffB); PG8_STAGE(PG8_SB(0, 1), cB + hstep, voffB); PG8_STAGE(PG8_SA(0, 0), cA, voffA); PG8_STAGE(PG8_SA(0, 1), cA + hstep, voffA);
        if (wr == 1) PG8_BAR;
        PG8_WAIT_V(2); PG8_BAR;
        PG8_STAGE(PG8_SB(1, 0), cB + kstep, voffB); PG8_STAGE(PG8_SA(1, 0), cA + kstep, voffA); PG8_STAGE(PG8_SB(1, 1), cB + hstep + kstep, voffB);
        PG8_WAIT_V(6); PG8_BAR;
    } else {
        PG8_STAGE(PG8_SB(0, 0), cB, voffB); PG8_STAGE(PG8_SA(0, 0), cA, voffA); PG8_STAGE(PG8_SB(0, 1), cB + hstep, voffB); PG8_STAGE(PG8_SA(0, 1), cA + hstep, voffA);
        if (wr == 1) PG8_BAR;
        PG8_WAIT_V(4); PG8_BAR;
        PG8_STAGE(PG8_SB(1, 0), cB + kstep, voffB); PG8_STAGE(PG8_SA(1, 0), cA + kstep, voffA); PG8_STAGE(PG8_SB(1, 1), cB + hstep + kstep, voffB);
        PG8_WAIT_V(6); PG8_BAR;
    }
    for (;;) {
        const bool has_next = S.next(ui + 1, nxt);
        const char* nA = has_next ? (const char*)g.A + (size_t)nxt.pm * tstep + (size_t)nxt.k0 * kstep : cA; const char* nB = has_next ? (const char*)g.Bt + (size_t)nxt.pn * tstep + (size_t)nxt.k0 * kstep : cB;
        const bool full = (cur.pm != 128); const int nt = (Sched::SPLIT && !full) ? 4 : K / BK;
        for (int t = 0; t < nt; t += 2) {
            const bool last = (t == nt - 2);
            const char* a1 = cA + (size_t)(t + 1) * kstep;
            const char* a2 = last ? nA : cA + (size_t)(t + 2) * kstep; const char* b2 = last ? nB : cB + (size_t)(t + 2) * kstep;
            const char* a3 = a2 + kstep; const char* b3 = b2 + kstep;
            if (last && has_next) S.a_ready(nxt);
            if constexpr (SP2) {
            PG8_LDB(B0, 0, 0); PG8_LDB(B1, 0, 1); PG8_SCHED; PG8_LDA(At, 0, 0); PG8_STAGE(PG8_SA(1, 1), a1 + hstep, voffA);
            PG8_WAIT_V(8); PG8_WAIT_L(0); PG8_BAR; PG8_MMA(0, 0, At, B0); PG8_MMA(0, 1, At, B1); PG8_BAR; PG8_SCHED;
            PG8_LDA(At, 0, 1); PG8_STAGE(PG8_SB(0, 0), b2, voffB); PG8_STAGE(PG8_SB(0, 1), b2 + hstep, voffB); PG8_STAGE(PG8_SA(0, 0), a2, voffA);
            PG8_WAIT_V(8); PG8_WAIT_L(0); PG8_BAR; if (full) { PG8_MMA(1, 0, At, B0); PG8_MMA(1, 1, At, B1); } PG8_BAR; PG8_SCHED;
            PG8_LDB(B0, 1, 0); PG8_LDB(B1, 1, 1); PG8_SCHED; PG8_LDA(At, 1, 0); PG8_STAGE(PG8_SA(0, 1), a2 + hstep, voffA);
            PG8_WAIT_V(8); PG8_WAIT_L(0); PG8_BAR; PG8_MMA(0, 0, At, B0); PG8_MMA(0, 1, At, B1); PG8_BAR; PG8_SCHED;
            PG8_LDA(At, 1, 1); PG8_STAGE(PG8_SB(1, 0), b3, voffB); PG8_STAGE(PG8_SB(1, 1), b3 + hstep, voffB); PG8_STAGE(PG8_SA(1, 0), a3, voffA);
            PG8_WAIT_V(8); PG8_WAIT_L(0); PG8_BAR; if (full) { PG8_MMA(1, 0, At, B0); PG8_MMA(1, 1, At, B1); } PG8_BAR; PG8_SCHED;
            } else {
            PG8_LDB(B0, 0, 0); PG8_SCHED; PG8_LDA(At, 0, 0); PG8_STAGE(PG8_SA(1, 1), a1 + hstep, voffA);
            PG8_WAIT_L(8); PG8_BAR; PG8_WAIT_L(0); PG8_MMA(0, 0, At, B0); PG8_BAR; PG8_SCHED;
            PG8_LDB(B1, 0, 1); PG8_STAGE(PG8_SB(0, 0), b2, voffB);
            PG8_BAR; PG8_WAIT_L(0); PG8_MMA(0, 1, At, B1); PG8_BAR;
            PG8_LDA(At, 0, 1); PG8_STAGE(PG8_SA(0, 0), a2, voffA);
            PG8_BAR; PG8_WAIT_L(0); PG8_MMA(1, 0, At, B0); PG8_BAR; PG8_SCHED;
            PG8_STAGE(PG8_SB(0, 1), b2 + hstep, voffB);
            PG8_WAIT_V(6); PG8_BAR; PG8_MMA(1, 1, At, B1); PG8_BAR;
            PG8_LDB(B0, 1, 0); PG8_SCHED; PG8_LDA(At, 1, 0); PG8_STAGE(PG8_SA(0, 1), a2 + hstep, voffA);
            PG8_WAIT_L(8); PG8_BAR; PG8_WAIT_L(0); PG8_MMA(0, 0, At, B0); PG8_BAR; PG8_SCHED;
            PG8_LDB(B1, 1, 1); PG8_STAGE(PG8_SB(1, 0), b3, voffB);
            PG8_BAR; PG8_WAIT_L(0); PG8_MMA(0, 1, At, B1); PG8_BAR;
            PG8_LDA(At, 1, 1); PG8_STAGE(PG8_SA(1, 0), a3, voffA);
            PG8_BAR; PG8_WAIT_L(0); PG8_MMA(1, 0, At, B0); PG8_BAR; PG8_SCHED;
            PG8_STAGE(PG8_SB(1, 1), b3 + hstep, voffB);
            PG8_WAIT_V(6); PG8_BAR; PG8_MMA(1, 1, At, B1); PG8_BAR;
            }
        }
        if constexpr (ALIGN_EPI) { if (wr == 0) PG8_BAR; }
        if constexpr (!Epi::AFTER_DRAIN) { E(acc, cur, wr, wc, fr, fq); S.done(cur); }
        if (!has_next) break;
#pragma unroll
        for (int a = 0; a < 2; ++a)
#pragma unroll
            for (int b = 0; b < 2; ++b)
#pragma unroll
                for (int m = 0; m < 4; ++m)
#pragma unroll
                    for (int n = 0; n < 2; ++n) acc[a][b][m][n] = (f32x4){0.f, 0.f, 0.f, 0.f};
        cur = nxt; cA = nA; cB = nB; ++ui;
        if constexpr (ALIGN_EPI) { if (wr == 1) PG8_BAR; }
    }
    PG8_WAIT_V(0);
    if constexpr (!ALIGN_EPI) { if (wr == 0) PG8_BAR; }
    PG8_BAR;
    if constexpr (Epi::AFTER_DRAIN) { E.fused(acc, cur, wr, wc, fr, fq, lds, wid, lane); S.done(cur); }
#undef PG8_SA
#undef PG8_SB
#undef PG8_STAGE
#undef PG8_LDA
#undef PG8_LDB
#undef PG8_MMA
#undef PG8_WAIT_V
#undef PG8_WAIT_L
#undef PG8_BAR
#undef PG8_SCHED
}
}
#ifndef PG8_SP2
#define PG8_SP2 true
#endif
#ifndef PG8_ALIGN
#define PG8_ALIGN true
#endif
#ifndef N_LAUNCH_PER_PHASE
#define N_LAUNCH_PER_PHASE 0
#endif

#define DI __device__ __forceinline__
#define LAS __attribute__((address_space(3)))
typedef unsigned short bf16_t;
typedef short bf16x8 __attribute__((ext_vector_type(8)));
typedef short s16x4 __attribute__((ext_vector_type(4)));
typedef float f32x4 __attribute__((ext_vector_type(4)));
typedef float f32x2 __attribute__((ext_vector_type(2)));
typedef float f32x16 __attribute__((ext_vector_type(16)));
typedef unsigned u32x4 __attribute__((ext_vector_type(4)));
typedef unsigned u32x2 __attribute__((ext_vector_type(2)));
typedef __bf16 bf16x2_t __attribute__((ext_vector_type(2)));

constexpr int TP = 32768, TS = 128, TT = TP + TS, MPAD = 33024;
constexpr int DM = 1024, FF = 2816, INW = 1280, NMOD = 9216, MODLD = 2 * NMOD;
constexpr int SEQ = 4096;
constexpr float EPS = 1e-6f, LOG2E = 1.4426950408889634f, C2 = 0.125f * 1.4426950408889634f;
constexpr int TBLD = 132;
constexpr size_t O_Y = 0, O_KP = 33685504, O_VP = 33947648, O_PP = 34209792, O_KS = 34332672, O_VS = 38526976, O_PS = 42721280, O_END = 44687360;
constexpr size_t MiB = 1u << 20;
constexpr size_t WS_XS = 1 * (1u << 20) + 512 * 1024;
constexpr size_t WS_BAR = 65536, WS_BAR_BYTES = 16384;
constexpr size_t WS_TB = 0, WS_CS = 1 * MiB, WS_MOD = 2 * MiB, WS_WADA = 12 * MiB, WS_L0 = 48 * MiB, LAYER_BYTES = 38 * MiB;
constexpr size_t LW_GU1 = 0, LW_D1 = 11 * MiB, LW_IN = 16 * MiB + MiB / 2, LW_OUT = 19 * MiB, LW_GU2 = 21 * MiB, LW_D2 = 32 * MiB, LW_POOL = 37 * MiB + MiB / 2;
constexpr size_t WS_X = 124 * MiB, WS_H = 253 * MiB, WS_ACT = 318 * MiB, WS_Z = WS_ACT, WS_MIX = WS_ACT + 96 * MiB, WS_END = 496 * MiB;
static_assert(WS_X + (size_t)MPAD * DM * 4 <= WS_H && WS_H + (size_t)MPAD * DM * 2 <= WS_ACT && WS_ACT + (size_t)MPAD * FF * 2 <= WS_END, "ws map");
static_assert(WS_Z + (size_t)MPAD * INW * 2 <= WS_MIX && WS_MIX + (size_t)MPAD * DM * 2 <= WS_END, "ws map 2");
static_assert(WS_MOD + (size_t)136 * MODLD * 4 <= WS_WADA && WS_WADA + (size_t)MODLD * DM * 2 <= WS_L0 && WS_L0 + 2 * LAYER_BYTES <= WS_X, "ws map 3");
constexpr int LDS_BYTES = 147456;
constexpr int NPH = 23;

struct Params { const float* in[23]; float* out; unsigned char* ws; int ph_lo, ph_hi; };

DI float bf2f(bf16_t b) { return __uint_as_float((unsigned)b << 16); }
DI unsigned pk2(float lo, float hi) { f32x2 v = {lo, hi}; bf16x2_t b = __builtin_convertvector(v, bf16x2_t); return __builtin_bit_cast(unsigned, b); }
DI float wave_sum(float v) {
#pragma unroll
    for (int o = 1; o < 64; o <<= 1) v += __shfl_xor(v, o);
    return v;
}
DI float wave_max(float v) {
#pragma unroll
    for (int o = 1; o < 64; o <<= 1) v = fmaxf(v, __shfl_xor(v, o));
    return v;
}
DI int crow(int r, int hi) { return (r & 3) + 8 * (r >> 2) + 4 * hi; }
DI f32x4 bf4_to_f4(const bf16_t* p) { const u32x2 v = *(const u32x2*)p; return (f32x4){__uint_as_float(v.x << 16), __uint_as_float(v.x & 0xffff0000u), __uint_as_float(v.y << 16), __uint_as_float(v.y & 0xffff0000u)}; }
#define MFMA32(a, b, c) __builtin_amdgcn_mfma_f32_32x32x16_bf16((a), (b), (c), 0, 0, 0)

struct EpiStoreBf16 {
    static constexpr bool PERM = true, AFTER_DRAIN = false;
    bf16_t* O; int ldc;
    DI void operator()(const pg8::f32x4 (&acc)[2][2][4][2], const pg8::Unit& u, int wr, int wc, int fr, int fq) const {
        const int row0 = u.pm * 256 + wr * 64 + fr, col0 = u.pn * 256 + wc * 32 + 8 * fq;
#pragma unroll
        for (int ai = 0; ai < 2; ++ai)
#pragma unroll
            for (int m = 0; m < 4; ++m) { bf16_t* rowp = O + (size_t)(row0 + ai * 128 + m * 16) * ldc + col0;
#pragma unroll
                for (int bj = 0; bj < 2; ++bj) { const f32x4 v0 = acc[ai][bj][m][0], v1 = acc[ai][bj][m][1];
                    u32x4 w; w.x = pk2(v0[0], v0[1]); w.y = pk2(v0[2], v0[3]); w.z = pk2(v1[0], v1[1]); w.w = pk2(v1[2], v1[3]);
                    *(u32x4*)(rowp + bj * 128) = w; } }
    }
};
DI float silu_mul(float g, float u) { return g * u * __builtin_amdgcn_rcpf(1.0f + __builtin_amdgcn_exp2f(-g * LOG2E)); }
struct EpiSwiGLU {
    static constexpr bool PERM = true, AFTER_DRAIN = false;
    bf16_t* O;
    DI void operator()(const pg8::f32x4 (&acc)[2][2][4][2], const pg8::Unit& u, int wr, int wc, int fr, int fq) const {
        const int row0 = u.pm * 256 + wr * 64 + fr, col0 = u.pn * 128 + wc * 32 + 8 * fq;
#pragma unroll
        for (int ai = 0; ai < 2; ++ai)
#pragma unroll
            for (int m = 0; m < 4; ++m) { bf16_t* rowp = O + (size_t)(row0 + ai * 128 + m * 16) * FF + col0;
                const f32x4 g0 = acc[ai][0][m][0], g1 = acc[ai][0][m][1], u0 = acc[ai][1][m][0], u1 = acc[ai][1][m][1];
                u32x4 w; w.x = pk2(silu_mul(g0[0], u0[0]), silu_mul(g0[1], u0[1])); w.y = pk2(silu_mul(g0[2], u0[2]), silu_mul(g0[3], u0[3]));
                w.z = pk2(silu_mul(g1[0], u1[0]), silu_mul(g1[1], u1[1])); w.w = pk2(silu_mul(g1[2], u1[2]), silu_mul(g1[3], u1[3]));
                *(u32x4*)rowp = w; }
    }
};
struct SplitOrder {
    static constexpr bool SPLIT = true;
    pg8::StaticOrder base; int nmain, nN, nchunk, G, c;
    DI void init(int N, int K, int G_, int c_) { base.init(TP, N, G_, c_, K, -1); nN = N / 256; nmain = (TP / 256) * nN; nchunk = K / 256; G = G_; c = c_; }
    DI bool next(int i, pg8::Unit& u) const {
        const int L = i * G + c;
        if (L < nmain) return base.next(i, u);
        const int s = L - nmain; if (s >= nN * nchunk) return false;
        u.pm = TP / 256; u.pn = s % nN; u.k0 = (s / nN) * 4; return true;
    }
    DI void a_ready(const pg8::Unit&) const {}
    DI void done(const pg8::Unit&) const {}
};
struct EpiResid {
    static constexpr bool PERM = true, AFTER_DRAIN = false;
    const float* xin_f32; bf16_t* XB; float* XSv; const float* gate; float coef;
    DI void operator()(const pg8::f32x4 (&acc)[2][2][4][2], const pg8::Unit& u, int wr, int wc, int fr, int fq) const {
        const int row0 = u.pm * 256 + wr * 64 + fr, col0 = u.pn * 256 + wc * 32 + 8 * fq;
        if (u.pm == TP / 256) {
#pragma unroll
            for (int m = 0; m < 4; ++m) { const int row = row0 + m * 16; const float* gp = gate + (size_t)(8 + row - TP) * MODLD; float* dst = XSv + (size_t)row * DM;
#pragma unroll
                for (int bj = 0; bj < 2; ++bj)
#pragma unroll
                    for (int n = 0; n < 2; ++n) { const int col = col0 + bj * 128 + n * 4; const f32x4 gv = *(const f32x4*)(gp + col); const f32x4 v = (gv * coef) * acc[0][bj][m][n];
                        unsafeAtomicAdd(dst + col + 0, v[0]); unsafeAtomicAdd(dst + col + 1, v[1]); unsafeAtomicAdd(dst + col + 2, v[2]); unsafeAtomicAdd(dst + col + 3, v[3]); } }
            return;
        }
        const float* gp = gate + (size_t)(u.pm >> 4) * MODLD;
        f32x4 gv[2][2];
#pragma unroll
        for (int bj = 0; bj < 2; ++bj)
#pragma unroll
            for (int n = 0; n < 2; ++n) gv[bj][n] = *(const f32x4*)(gp + col0 + bj * 128 + n * 4) * coef;
        if (xin_f32) {
#pragma unroll
            for (int ai = 0; ai < 2; ++ai)
#pragma unroll
                for (int m = 0; m < 4; ++m) { const size_t ro = (size_t)(row0 + ai * 128 + m * 16) * DM + col0;
#pragma unroll
                    for (int bj = 0; bj < 2; ++bj) { const f32x4 x0 = *(const f32x4*)(xin_f32 + ro + bj * 128), x1 = *(const f32x4*)(xin_f32 + ro + bj * 128 + 4);
                        const f32x4 o0 = x0 + gv[bj][0] * acc[ai][bj][m][0], o1 = x1 + gv[bj][1] * acc[ai][bj][m][1];
                        u32x4 w; w.x = pk2(o0[0], o0[1]); w.y = pk2(o0[2], o0[3]); w.z = pk2(o1[0], o1[1]); w.w = pk2(o1[2], o1[3]);
                        *(u32x4*)(XB + ro + bj * 128) = w; } }
        } else {
#pragma unroll
            for (int ai = 0; ai < 2; ++ai) {
                u32x4 xr[4][2];
#pragma unroll
                for (int m = 0; m < 4; ++m)
#pragma unroll
                    for (int bj = 0; bj < 2; ++bj) xr[m][bj] = *(const u32x4*)(XB + (size_t)(row0 + ai * 128 + m * 16) * DM + col0 + bj * 128);
                asm volatile("" ::: "memory");
#pragma unroll
                for (int m = 0; m < 4; ++m)
#pragma unroll
                    for (int bj = 0; bj < 2; ++bj) { const u32x4 r = xr[m][bj];
                        const f32x4 x0 = {__uint_as_float(r.x << 16), __uint_as_float(r.x & 0xffff0000u), __uint_as_float(r.y << 16), __uint_as_float(r.y & 0xffff0000u)};
                        const f32x4 x1 = {__uint_as_float(r.z << 16), __uint_as_float(r.z & 0xffff0000u), __uint_as_float(r.w << 16), __uint_as_float(r.w & 0xffff0000u)};
                        const f32x4 o0 = x0 + gv[bj][0] * acc[ai][bj][m][0], o1 = x1 + gv[bj][1] * acc[ai][bj][m][1];
                        u32x4 w; w.x = pk2(o0[0], o0[1]); w.y = pk2(o0[2], o0[3]); w.z = pk2(o1[0], o1[1]); w.w = pk2(o1[2], o1[3]);
                        *(u32x4*)(XB + (size_t)(row0 + ai * 128 + m * 16) * DM + col0 + bj * 128) = w; }
                asm volatile("" ::: "memory");
            }
        }
    }
};
struct EpiMod {
    static constexpr bool PERM = false, AFTER_DRAIN = false;
    float* mod; const float* bias;
    DI void operator()(const pg8::f32x4 (&acc)[2][2][4][2], const pg8::Unit& u, int wr, int wc, int fr, int fq) const {
        const int row0 = u.pm * 256 + wr * 64 + fr, col0 = u.pn * 256 + wc * 32 + 4 * fq;
#pragma unroll
        for (int ai = 0; ai < 2; ++ai)
#pragma unroll
            for (int m = 0; m < 4; ++m) { const int row = row0 + ai * 128 + m * 16;
                if (row < 136) {
#pragma unroll
                    for (int bj = 0; bj < 2; ++bj)
#pragma unroll
                        for (int n = 0; n < 2; ++n) { const int col = col0 + bj * 128 + n * 16;
                            *(f32x4*)(mod + (size_t)row * MODLD + col) = acc[ai][bj][m][n] + *(const f32x4*)(bias + col); } } }
    }
};
typedef const __attribute__((address_space(4))) Params* KP;
DI void transpose_item(const float* W, int K, int N, bf16_t* WT, int mode, LAS float* scr, int item, int lane) {
    const int nblk = N / 32, kb = item / nblk, nb = item % nblk, k0 = 64 * kb, n0 = 32 * nb;
#pragma unroll 8
    for (int i = 0; i < 32; ++i) { const int kk = 2 * i + (lane >> 5); scr[kk * 33 + (lane & 31)] = W[(size_t)(k0 + kk) * N + n0 + (lane & 31)]; }
    asm volatile("s_waitcnt lgkmcnt(0)" ::: "memory");
    int rbase = n0;
    if (mode == 1) rbase = (n0 >> 7) * 256 + (n0 & 127);
    if (mode == 2) rbase = (n0 >> 7) * 256 + 128 + (n0 & 127);
    const int c = lane & 7;
#pragma unroll
    for (int j = 0; j < 4; ++j) { const int n = (lane >> 3) + 8 * j; const LAS float* s = scr + (8 * c) * 33 + n;
        u32x4 o; o.x = pk2(s[0 * 33], s[1 * 33]); o.y = pk2(s[2 * 33], s[3 * 33]); o.z = pk2(s[4 * 33], s[5 * 33]); o.w = pk2(s[6 * 33], s[7 * 33]);
        *(u32x4*)(WT + (size_t)(rbase + n) * K + k0 + 8 * c) = o; }
    asm volatile("s_waitcnt lgkmcnt(0)" ::: "memory");
}
constexpr int I_ADA = (DM / 64) * (NMOD / 32), I_FU = (DM / 64) * (FF / 32), I_FD = (FF / 64) * (DM / 32), I_IN = (DM / 64) * (INW / 32), I_OUT = (DM / 64) * (DM / 32), I_POOL = 4 * 8;
constexpr int IPL = I_ADA + 4 * I_FU + 2 * I_FD + I_IN + I_OUT + I_POOL;
DI int t5_bucket(int n) {
    if (n < 16) return n;
    int b = 16;
    b += (n >= 19); b += (n >= 21); b += (n >= 24); b += (n >= 27); b += (n >= 31); b += (n >= 35); b += (n >= 40); b += (n >= 46);
    b += (n >= 52); b += (n >= 59); b += (n >= 67); b += (n >= 77); b += (n >= 87); b += (n >= 99); b += (n >= 113);
    return b;
}
DI void prologue(KP P, LAS unsigned char* lds, int gw, int NGW, int gtid, int GT, int wid, int lane) {
    LAS float* scr = (LAS float*)(lds + wid * 8448);
    for (int it = gw; it < 2 * IPL; it += NGW) {
        const int l = it / IPL; int r = it - l * IPL;
        unsigned char* wl = P->ws + WS_L0 + (size_t)l * LAYER_BYTES;
        const float* src; bf16_t* dst; int K, N, mode = 0;
        if (r < I_ADA) { src = P->in[7] + (size_t)l * DM * NMOD; K = DM; N = NMOD; dst = (bf16_t*)(P->ws + WS_WADA) + (size_t)l * NMOD * DM; }
        else if ((r -= I_ADA) < I_FU) { src = P->in[16] + (size_t)l * DM * FF; K = DM; N = FF; dst = (bf16_t*)(wl + LW_GU1); mode = 1; }
        else if ((r -= I_FU) < I_FU) { src = P->in[17] + (size_t)l * DM * FF; K = DM; N = FF; dst = (bf16_t*)(wl + LW_GU1); mode = 2; }
        else if ((r -= I_FU) < I_FD) { src = P->in[18] + (size_t)l * FF * DM; K = FF; N = DM; dst = (bf16_t*)(wl + LW_D1); }
        else if ((r -= I_FD) < I_IN) { src = P->in[10] + (size_t)l * DM * INW; K = DM; N = INW; dst = (bf16_t*)(wl + LW_IN); }
        else if ((r -= I_IN) < I_OUT) { src = P->in[11] + (size_t)l * DM * DM; K = DM; N = DM; dst = (bf16_t*)(wl + LW_OUT); }
        else if ((r -= I_OUT) < I_FU) { src = P->in[19] + (size_t)l * DM * FF; K = DM; N = FF; dst = (bf16_t*)(wl + LW_GU2); mode = 1; }
        else if ((r -= I_FU) < I_FU) { src = P->in[20] + (size_t)l * DM * FF; K = DM; N = FF; dst = (bf16_t*)(wl + LW_GU2); mode = 2; }
        else if ((r -= I_FU) < I_FD) { src = P->in[21] + (size_t)l * FF * DM; K = FF; N = DM; dst = (bf16_t*)(wl + LW_D2); }
        else { r -= I_FD; const int g = r >> 3; r &= 7; src = P->in[14] + (size_t)(l * 4 + g) * 16384; K = 128; N = 128; dst = (bf16_t*)(wl + LW_POOL) + (size_t)g * 16384; }
        transpose_item(src, K, N, dst, mode, scr, r, lane);
    }
    bf16_t* CS = (bf16_t*)(P->ws + WS_CS);
    for (int idx = gtid; idx < 256 * DM; idx += GT) {
        const int row = idx >> 10; float v = 0.f;
        if (row < 8) v = P->in[2][idx]; else if (row < 136) v = P->in[3][idx - 8 * DM];
        const float s = v / (1.0f + __expf(-v));
        CS[idx] = (bf16_t)(pk2(row < 136 ? s : 0.f, 0.f) & 0xffffu);
    }
    float* TB = (float*)(P->ws + WS_TB);
    for (int idx = gtid; idx < 8 * TBLD; idx += GT) { const int h = idx / TBLD, d = idx % TBLD; const int dd = d < 128 ? d : 128;
        TB[idx] = P->in[13][t5_bucket(dd) * 8 + h] * LOG2E; }
}

template <bool FINAL>
DI void norm_phase(const float* xp, const float* xs, const float* gain, const float* modsh, bf16_t* H, float* Y, int gw, int NGW, int lane, float* xcopy = nullptr, int blk_lo = 0) {
    for (int blk = blk_lo + gw; blk < TT / 16; blk += NGW) {
        const int row0 = blk * 16; const bool prompt = row0 < TP;
        f32x4 Gv[4], Sv[4];
        if (FINAL) {
#pragma unroll
            for (int j = 0; j < 4; ++j) { Gv[j] = ((const f32x4*)gain)[lane + 64 * j]; Sv[j] = (f32x4){0.f, 0.f, 0.f, 0.f}; }
        } else if (prompt) {
            const float* mp = modsh + (size_t)(row0 >> 12) * MODLD;
#pragma unroll
            for (int j = 0; j < 4; ++j) { Gv[j] = ((const f32x4*)gain)[lane + 64 * j] * (((const f32x4*)(mp + DM))[lane + 64 * j] + 1.0f); Sv[j] = ((const f32x4*)mp)[lane + 64 * j]; }
        }
#pragma unroll 1
        for (int r4 = 0; r4 < 16; r4 += 4) {
            f32x4 v[4][4]; float ss[4];
#pragma unroll
            for (int q = 0; q < 4; ++q) { const int row = row0 + r4 + q;
                const float* xr = row < TP ? xp + (size_t)row * DM : xs + (size_t)(row - TP) * DM;
#pragma unroll
                for (int j = 0; j < 4; ++j) v[q][j] = ((const f32x4*)xr)[lane + 64 * j]; }
#pragma unroll
            for (int q = 0; q < 4; ++q) { float a = 0.f;
#pragma unroll
                for (int j = 0; j < 4; ++j) a += (v[q][j].x * v[q][j].x + v[q][j].y * v[q][j].y) + (v[q][j].z * v[q][j].z + v[q][j].w * v[q][j].w);
                ss[q] = a; }
#pragma unroll
            for (int o = 1; o < 64; o <<= 1) {
#pragma unroll
                for (int q = 0; q < 4; ++q) ss[q] += __shfl_xor(ss[q], o); }
#pragma unroll
            for (int q = 0; q < 4; ++q) { const int row = row0 + r4 + q;
                if (!FINAL && !prompt) {
                    const float* mp = modsh + (size_t)(8 + row - TP) * MODLD;
#pragma unroll
                    for (int j = 0; j < 4; ++j) { Gv[j] = ((const f32x4*)gain)[lane + 64 * j] * (((const f32x4*)(mp + DM))[lane + 64 * j] + 1.0f); Sv[j] = ((const f32x4*)mp)[lane + 64 * j]; }
                    if (xcopy) {
#pragma unroll
                        for (int j = 0; j < 4; ++j) ((f32x4*)(xcopy + (size_t)row * DM))[lane + 64 * j] = v[q][j]; }
                }
                const float rstd = 1.0f / sqrtf(ss[q] * (1.0f / DM) + EPS);
                if (FINAL) {
#pragma unroll
                    for (int j = 0; j < 4; ++j) ((f32x4*)(Y + (size_t)row * DM))[lane + 64 * j] = v[q][j] * rstd * Gv[j];
                } else {
#pragma unroll
                    for (int j = 0; j < 4; ++j) { const f32x4 h = v[q][j] * rstd * Gv[j] + Sv[j]; u32x2 w; w.x = pk2(h.x, h.y); w.y = pk2(h.z, h.w);
                        ((u32x2*)(H + (size_t)row * DM))[lane + 64 * j] = w; }
                }
            }
        }
    }
}

template <bool FINAL>
DI void norm_phase_bf(const bf16_t* XB, const float* gain, const float* modsh, bf16_t* H, float* Y, int gw, int NGW, int lane) {
    for (int blk = gw; blk < TP / 16; blk += NGW) {
        const int row0 = blk * 16;
        f32x4 Gv[2][2], Sv[2][2];
        const float* mp = FINAL ? nullptr : modsh + (size_t)(row0 >> 12) * MODLD;
#pragma unroll
        for (int j = 0; j < 2; ++j)
#pragma unroll
            for (int h = 0; h < 2; ++h) { const int fi = 2 * lane + 128 * j + h;
                if (FINAL) { Gv[j][h] = ((const f32x4*)gain)[fi]; Sv[j][h] = (f32x4){0.f, 0.f, 0.f, 0.f}; }
                else { Gv[j][h] = ((const f32x4*)gain)[fi] * (((const f32x4*)(mp + DM))[fi] + 1.0f); Sv[j][h] = ((const f32x4*)mp)[fi]; } }
#pragma unroll 1
        for (int r8 = 0; r8 < 16; r8 += 8) {
            u32x4 raw[8][2]; float ss[8];
#pragma unroll
            for (int q = 0; q < 8; ++q)
#pragma unroll
                for (int j = 0; j < 2; ++j) raw[q][j] = *(const u32x4*)(XB + (size_t)(row0 + r8 + q) * DM + 8 * lane + 512 * j);
#pragma unroll
            for (int q = 0; q < 8; ++q) { float a = 0.f;
#pragma unroll
                for (int j = 0; j < 2; ++j)
#pragma unroll
                    for (int e = 0; e < 4; ++e) { const float lo = __uint_as_float(raw[q][j][e] << 16), hi = __uint_as_float(raw[q][j][e] & 0xffff0000u); a += lo * lo + hi * hi; }
                ss[q] = a; }
#pragma unroll
            for (int o = 1; o < 64; o <<= 1) {
#pragma unroll
                for (int q = 0; q < 8; ++q) ss[q] += __shfl_xor(ss[q], o); }
#pragma unroll
            for (int q = 0; q < 8; ++q) { const int row = row0 + r8 + q;
                const float rstd = 1.0f / sqrtf(ss[q] * (1.0f / DM) + EPS);
#pragma unroll
                for (int j = 0; j < 2; ++j) { const u32x4 r = raw[q][j];
                    const f32x4 x0 = {__uint_as_float(r.x << 16), __uint_as_float(r.x & 0xffff0000u), __uint_as_float(r.y << 16), __uint_as_float(r.y & 0xffff0000u)};
                    const f32x4 x1 = {__uint_as_float(r.z << 16), __uint_as_float(r.z & 0xffff0000u), __uint_as_float(r.w << 16), __uint_as_float(r.w & 0xffff0000u)};
                    const f32x4 h0 = x0 * rstd * Gv[j][0] + Sv[j][0], h1 = x1 * rstd * Gv[j][1] + Sv[j][1];
                    if (FINAL) { float* yp = Y + (size_t)row * DM + 8 * lane + 512 * j; *(f32x4*)yp = h0; *(f32x4*)(yp + 4) = h1; }
                    else { u32x4 w; w.x = pk2(h0[0], h0[1]); w.y = pk2(h0[2], h0[3]); w.z = pk2(h1[0], h1[1]); w.w = pk2(h1[2], h1[3]);
                        *(u32x4*)(H + (size_t)row * DM + 8 * lane + 512 * j) = w; }
                }
            }
        }
    }
}

constexpr int KS_LD = 72, VT_LD = 264;
constexpr int ATT_KS = 0, ATT_VT = 256 * KS_LD * 2, ATT_TB = ATT_VT + 64 * VT_LD * 2;
DI void attn_unit(LAS unsigned char* lds, const bf16_t* Z, bf16_t* MIX, const float* TB, const float* sinks_l, int b, int n, int kvh, int tid) {
    const int lane = tid & 63, wid = tid >> 6, r = lane & 31, hh = lane >> 5;
    LAS bf16_t* Ks = (LAS bf16_t*)(lds + ATT_KS); LAS bf16_t* Vt = (LAS bf16_t*)(lds + ATT_VT); LAS float* tb = (LAS float*)(lds + ATT_TB);
    const int base = b * SEQ + n * 128;
#pragma unroll
    for (int i = 0; i < 4; ++i) {
        const int c = tid + 512 * i, key = c >> 3, part = c & 7;
        u32x4 kv = {0u, 0u, 0u, 0u}, vv = {0u, 0u, 0u, 0u};
        if (n > 0 || key >= 128) { const bf16_t* zr = Z + (size_t)(base - 128 + key) * INW + kvh * 64 + part * 8; kv = *(const u32x4*)(zr + 512); vv = *(const u32x4*)(zr + 640); }
        *(LAS u32x4*)(Ks + key * KS_LD + part * 8) = kv;
        LAS bf16_t* vd = Vt + (part * 8) * VT_LD + key;
        vd[0 * VT_LD] = (bf16_t)(vv.x & 0xffffu); vd[1 * VT_LD] = (bf16_t)(vv.x >> 16); vd[2 * VT_LD] = (bf16_t)(vv.y & 0xffffu); vd[3 * VT_LD] = (bf16_t)(vv.y >> 16);
        vd[4 * VT_LD] = (bf16_t)(vv.z & 0xffffu); vd[5 * VT_LD] = (bf16_t)(vv.z >> 16); vd[6 * VT_LD] = (bf16_t)(vv.w & 0xffffu); vd[7 * VT_LD] = (bf16_t)(vv.w >> 16);
    }
    for (int i = tid; i < 4 * TBLD; i += 512) tb[i] = TB[kvh * 4 * TBLD + i];
    const int hl = wid >> 1, h = kvh * 4 + hl;
    const float sink2 = sinks_l[h] * LOG2E;
    LAS const float* tbh = tb + hl * TBLD;
    bf16x8 qf[4];
    {   const bf16_t* qrow = Z + (size_t)(base + (wid & 1) * 64 + r) * INW + h * 64 + 8 * hh;
#pragma unroll
        for (int c = 0; c < 4; ++c) qf[c] = *(const bf16x8*)(qrow + 16 * c); }
    __syncthreads();
#pragma unroll 1
    for (int sub = 0; sub < 2; ++sub) {
        const int qoff = (wid & 1) * 64 + sub * 32, kt0 = qoff >> 5, q = qoff + r;
        f32x16 sc[5];
#pragma unroll
        for (int t = 0; t < 5; ++t) {
#pragma unroll
            for (int i = 0; i < 16; ++i) sc[t][i] = 0.f;
#pragma unroll
            for (int c = 0; c < 4; ++c) { const bf16x8 a = *(LAS const bf16x8*)(Ks + (32 * (kt0 + t) + r) * KS_LD + 16 * c + 8 * hh); sc[t] = MFMA32(a, qf[c], sc[t]); }
        }
        if (sub == 0) {
            const bf16_t* qrow = Z + (size_t)(base + q + 32) * INW + h * 64 + 8 * hh;
#pragma unroll
            for (int c = 0; c < 4; ++c) qf[c] = *(const bf16x8*)(qrow + 16 * c);
        }
        float m = -INFINITY;
        const int rel = r - 4 * hh;
#pragma unroll
        for (int t = 0; t < 5; ++t) {
            const bool dead = (n == 0) && (kt0 + t < 4);
#pragma unroll
            for (int i = 0; i < 16; ++i) {
                const int cc = (i & 3) + 8 * (i >> 2);
                const int dist = 128 - 32 * t + rel - cc;
                bool valid = !dead;
                if (t == 0) valid = valid && (dist <= 128);
                if (t == 4) valid = valid && (dist >= 0);
                const float bias = tbh[(t == 0 || t == 4) ? (valid ? dist : 0) : dist];
                const float val = valid ? sc[t][i] * C2 + bias : -INFINITY;
                sc[t][i] = val; m = fmaxf(m, val);
            }
        }
        m = fmaxf(m, __shfl_xor(m, 32)); m = fmaxf(m, sink2);
        float sum = 0.f;
#pragma unroll
        for (int t = 0; t < 5; ++t)
#pragma unroll
            for (int i = 0; i < 16; ++i) { const float p = __builtin_amdgcn_exp2f(sc[t][i] - m); sc[t][i] = p; sum += p; }
        sum += __shfl_xor(sum, 32); sum += __builtin_amdgcn_exp2f(sink2 - m);
        const float inv = 1.0f / sum;
        f32x16 o[2];
#pragma unroll
        for (int i = 0; i < 16; ++i) { o[0][i] = 0.f; o[1][i] = 0.f; }
#pragma unroll
        for (int t = 0; t < 5; ++t)
#pragma unroll
            for (int s = 0; s < 2; ++s) {
                u32x4 pw; pw.x = pk2(sc[t][8 * s + 0], sc[t][8 * s + 1]); pw.y = pk2(sc[t][8 * s + 2], sc[t][8 * s + 3]); pw.z = pk2(sc[t][8 * s + 4], sc[t][8 * s + 5]); pw.w = pk2(sc[t][8 * s + 6], sc[t][8 * s + 7]);
                const bf16x8 pb = __builtin_bit_cast(bf16x8, pw);
#pragma unroll
                for (int dt = 0; dt < 2; ++dt) {
                    LAS const bf16_t* vr = Vt + (32 * dt + r) * VT_LD + 32 * (kt0 + t) + 16 * s + 4 * hh;
                    const s16x4 lo = *(LAS const s16x4*)vr, hi = *(LAS const s16x4*)(vr + 8);
                    const bf16x8 a = __builtin_shufflevector(lo, hi, 0, 1, 2, 3, 4, 5, 6, 7);
                    o[dt] = MFMA32(a, pb, o[dt]);
                }
            }
        bf16_t* orow = MIX + (size_t)(base + q) * DM + h * 64 + 4 * hh;
#pragma unroll
        for (int dt = 0; dt < 2; ++dt)
#pragma unroll
            for (int g4 = 0; g4 < 4; ++g4) { u32x2 w; w.x = pk2(o[dt][4 * g4 + 0] * inv, o[dt][4 * g4 + 1] * inv); w.y = pk2(o[dt][4 * g4 + 2] * inv, o[dt][4 * g4 + 3] * inv);
                *(u32x2*)(orow + 32 * dt + 8 * g4) = w; }
    }
    __syncthreads();
}

DI void sattn_task(LAS float* wl, const bf16_t* Z, const float* ck, const float* cv, bf16_t* MIX, const float* TB, const float* sinks_l, int s, int kvh, int lane) {
    const bf16_t* zrow = Z + (size_t)(TP + s) * INW;
#pragma unroll
    for (int hl = 0; hl < 4; ++hl) wl[hl * 64 + lane] = bf2f(zrow[(kvh * 4 + hl) * 64 + lane]) * C2;
    const float kn = bf2f(zrow[512 + kvh * 64 + lane]);
    asm volatile("s_waitcnt lgkmcnt(0)" ::: "memory");
    float sc[4][2];
#pragma unroll
    for (int kk = 0; kk < 2; ++kk) {
        const int j = lane + 64 * kk;
        const float* krow = ck + ((size_t)(s * 128 + j) * 2 + kvh) * 64;
        float a[4] = {0.f, 0.f, 0.f, 0.f};
#pragma unroll 8
        for (int d4 = 0; d4 < 16; ++d4) { const f32x4 kv = *(const f32x4*)(krow + 4 * d4);
#pragma unroll
            for (int hl = 0; hl < 4; ++hl) { const f32x4 qv = *(LAS const f32x4*)(wl + hl * 64 + 4 * d4); a[hl] += (kv.x * qv.x + kv.y * qv.y) + (kv.z * qv.z + kv.w * qv.w); } }
#pragma unroll
        for (int hl = 0; hl < 4; ++hl) sc[hl][kk] = a[hl] + TB[(kvh * 4 + hl) * TBLD + (128 - j)];
    }
    float pn[4];
#pragma unroll
    for (int hl = 0; hl < 4; ++hl) {
        const float sink2 = sinks_l[kvh * 4 + hl] * LOG2E;
        const float snew = wave_sum(kn * wl[hl * 64 + lane]) + TB[(kvh * 4 + hl) * TBLD + 0];
        float m = wave_max(fmaxf(sc[hl][0], sc[hl][1])); m = fmaxf(m, fmaxf(snew, sink2));
        const float p0 = __builtin_amdgcn_exp2f(sc[hl][0] - m), p1 = __builtin_amdgcn_exp2f(sc[hl][1] - m), pnw = __builtin_amdgcn_exp2f(snew - m);
        const float sum = wave_sum(p0 + p1) + pnw + __builtin_amdgcn_exp2f(sink2 - m);
        const float inv = 1.0f / sum;
        wl[256 + hl * TBLD + lane] = p0 * inv; wl[256 + hl * TBLD + 64 + lane] = p1 * inv; pn[hl] = pnw * inv;
    }
    asm volatile("s_waitcnt lgkmcnt(0)" ::: "memory");
    const int jg = lane >> 4, d4 = lane & 15;
    f32x4 o[4];
#pragma unroll
    for (int hl = 0; hl < 4; ++hl) o[hl] = (f32x4){0.f, 0.f, 0.f, 0.f};
    const float* vb = cv + ((size_t)(s * 128 + jg) * 2 + kvh) * 64 + 4 * d4;
#pragma unroll 8
    for (int i = 0; i < 32; ++i) { const f32x4 vv = *(const f32x4*)(vb + (size_t)i * 512);
#pragma unroll
        for (int hl = 0; hl < 4; ++hl) o[hl] += vv * wl[256 + hl * TBLD + 4 * i + jg]; }
    const f32x4 vn4 = bf4_to_f4(zrow + 640 + kvh * 64 + 4 * d4);
#pragma unroll
    for (int hl = 0; hl < 4; ++hl) {
#pragma unroll
        for (int e = 0; e < 4; ++e) { float v = o[hl][e]; v += __shfl_xor(v, 16); v += __shfl_xor(v, 32); o[hl][e] = v + pn[hl] * vn4[e]; }
        if (jg == 0) { u32x2 w; w.x = pk2(o[hl][0], o[hl][1]); w.y = pk2(o[hl][2], o[hl][3]); *(u32x2*)(MIX + (size_t)(TP + s) * DM + (kvh * 4 + hl) * 64 + 4 * d4) = w; }
    }
    asm volatile("s_waitcnt lgkmcnt(0)" ::: "memory");
}

constexpr int PU_LD = 136;
constexpr int POOL_U = 0, POOL_P = 144 * PU_LD * 2;
DI void pool_unit(LAS unsigned char* lds, const bf16_t* Z, const float* sp_l, const bf16_t* PWT, const float* pscale_l, bf16_t* MIX, int ub, int tid) {
    const int lane = tid & 63, wid = tid >> 6, r = lane & 31, hh = lane >> 5;
    LAS bf16_t* Ug = (LAS bf16_t*)(lds + POOL_U); LAS bf16_t* Pg = (LAS bf16_t*)(lds + POOL_P);
    const bool prompt = ub < 256; const int b = ub >> 5, n = ub & 31;
    const int s0 = ((ub - 256) & 3) * 32;
    const int rowbase = prompt ? b * SEQ + n * 128 : TP + s0;
    const int g_lo = prompt ? 0 : (ub - 256) >> 2, g_hi = prompt ? 4 : g_lo + 1, mtiles = prompt ? 4 : 1;
#pragma unroll 1
    for (int g = g_lo; g < g_hi; ++g) {
        const int w = 2 << g;
        const int mt = wid >> 1, nt0 = (wid & 1) * 2;
        bf16x8 bfr[8][2];
#pragma unroll
        for (int ks = 0; ks < 8; ++ks)
#pragma unroll
            for (int qq = 0; qq < 2; ++qq) bfr[ks][qq] = *(const bf16x8*)(PWT + (size_t)g * 16384 + (32 * (nt0 + qq) + r) * 128 + 16 * ks + 8 * hh);
        if (prompt) {
            for (int c = tid; c < 143 * 16; c += 512) { const int row = c >> 4, part = c & 15, pos = n * 128 - 15 + row;
                u32x4 v = {0u, 0u, 0u, 0u};
                if (pos >= 0) v = *(const u32x4*)(Z + (size_t)(b * SEQ + pos) * INW + 768 + g * 128 + part * 8);
                *(LAS u32x4*)(Ug + row * PU_LD + part * 8) = v; }
            __syncthreads();
            const int c2 = tid & 63, t0 = wid * 16;
            float s0 = 0.f, s1 = 0.f;
            for (int s = 0; s < w; ++s) { const unsigned uv = *(LAS const unsigned*)(Ug + (t0 + 15 - s) * PU_LD + 2 * c2); s0 += __uint_as_float(uv << 16); s1 += __uint_as_float(uv & 0xffff0000u); }
            for (int t = t0; t < t0 + 16; ++t) {
                const unsigned uv = *(LAS const unsigned*)(Ug + (t + 15) * PU_LD + 2 * c2);
                const float u0 = __uint_as_float(uv << 16), u1 = __uint_as_float(uv & 0xffff0000u);
                const int pos1 = n * 128 + t + 1; const float ic = 1.0f / (float)(pos1 < w ? pos1 : w);
                *(LAS unsigned*)(Pg + t * PU_LD + 2 * c2) = pk2(s0 * ic - u0, s1 * ic - u1);
                if (t + 1 < t0 + 16) {
                    const unsigned ua = *(LAS const unsigned*)(Ug + (t + 16) * PU_LD + 2 * c2), ud = *(LAS const unsigned*)(Ug + (t + 16 - w) * PU_LD + 2 * c2);
                    s0 += __uint_as_float(ua << 16) - __uint_as_float(ud << 16); s1 += __uint_as_float(ua & 0xffff0000u) - __uint_as_float(ud & 0xffff0000u);
                }
            }
        } else {
            for (int idx = tid; idx < 32 * 64; idx += 512) { const int sl = idx >> 6, c2 = idx & 63, s = s0 + sl;
                const unsigned uv = *(const unsigned*)(Z + (size_t)(TP + s) * INW + 768 + g * 128 + 2 * c2);
                const float u0 = __uint_as_float(uv << 16), u1 = __uint_as_float(uv & 0xffff0000u);
                float a0 = u0, a1 = u1;
#pragma unroll
                for (int i = 0; i < 15; ++i) { if (i >= 16 - w) { const f32x2 sv = *(const f32x2*)(sp_l + ((size_t)s * 15 + i) * 512 + g * 128 + 2 * c2); a0 += sv.x; a1 += sv.y; } }
                const float ic = 1.0f / (float)w;
                *(LAS unsigned*)(Pg + sl * PU_LD + 2 * c2) = pk2(a0 * ic - u0, a1 * ic - u1); }
        }
        __syncthreads();
        f32x16 acc[2];
#pragma unroll
        for (int i = 0; i < 16; ++i) { acc[0][i] = 0.f; acc[1][i] = 0.f; }
        if (mt < mtiles) {
#pragma unroll
        for (int ks = 0; ks < 8; ++ks) {
            const bf16x8 a = *(LAS const bf16x8*)(Pg + (32 * mt + r) * PU_LD + 16 * ks + 8 * hh);
#pragma unroll
            for (int qq = 0; qq < 2; ++qq) acc[qq] = MFMA32(a, bfr[ks][qq], acc[qq]);
        }
#pragma unroll
        for (int qq = 0; qq < 2; ++qq) { const int col = g * 128 + 32 * (nt0 + qq) + r; const float ps = pscale_l[col];
#pragma unroll
            for (int i = 0; i < 16; ++i) { const int row = 32 * mt + crow(i, hh);
                MIX[(size_t)(rowbase + row) * DM + 512 + col] = (bf16_t)(pk2(acc[qq][i] * ps, 0.f) & 0xffffu); } }
        }
        __syncthreads();
    }
}

DI void states_copy(KP P, const bf16_t* Z, int l, int gtid, int GT) {
    float* out = P->out;
    for (int idx = gtid; idx < 8 * 128 * 32; idx += GT) { const int c4 = idx & 31, j = (idx >> 5) & 127, b = idx >> 12;
        const bf16_t* zr = Z + (size_t)(b * SEQ + SEQ - 128 + j) * INW + c4 * 4;
        *(f32x4*)(out + O_KP + ((size_t)(l * 8 + b) * 128 + j) * 128 + c4 * 4) = bf4_to_f4(zr + 512);
        *(f32x4*)(out + O_VP + ((size_t)(l * 8 + b) * 128 + j) * 128 + c4 * 4) = bf4_to_f4(zr + 640); }
    for (int idx = gtid; idx < 8 * 15 * 128; idx += GT) { const int c4 = idx & 127, bi = idx >> 7, i = bi % 15, b = bi / 15;
        *(f32x4*)(out + O_PP + ((size_t)(l * 8 + b) * 15 + i) * 512 + c4 * 4) = bf4_to_f4(Z + (size_t)(b * SEQ + SEQ - 15 + i) * INW + 768 + c4 * 4); }
    const float* ck = P->in[4] + (size_t)l * 128 * 128 * 128; const float* cv = P->in[5] + (size_t)l * 128 * 128 * 128; const float* sp = P->in[6] + (size_t)l * 128 * 15 * 512;
    for (int idx = gtid; idx < 128 * 128 * 32; idx += GT) { const int c4 = idx & 31, j = (idx >> 5) & 127, s = idx >> 12;
        const bf16_t* zr = Z + (size_t)(TP + s) * INW + c4 * 4;
        f32x4 kv, vv;
        if (j < 127) { kv = *(const f32x4*)(ck + ((size_t)s * 128 + j + 1) * 128 + c4 * 4); vv = *(const f32x4*)(cv + ((size_t)s * 128 + j + 1) * 128 + c4 * 4); }
        else { kv = bf4_to_f4(zr + 512); vv = bf4_to_f4(zr + 640); }
        *(f32x4*)(out + O_KS + ((size_t)(l * 128 + s) * 128 + j) * 128 + c4 * 4) = kv;
        *(f32x4*)(out + O_VS + ((size_t)(l * 128 + s) * 128 + j) * 128 + c4 * 4) = vv; }
    for (int idx = gtid; idx < 128 * 15 * 128; idx += GT) { const int c4 = idx & 127, si = idx >> 7, i = si % 15, s = si / 15;
        f32x4 v;
        if (i < 14) v = *(const f32x4*)(sp + ((size_t)s * 15 + i + 1) * 512 + c4 * 4); else v = bf4_to_f4(Z + (size_t)(TP + s) * INW + 768 + c4 * 4);
        *(f32x4*)(out + O_PS + ((size_t)(l * 128 + s) * 15 + i) * 512 + c4 * 4) = v; }
}

#define XB_TMO      128
#define XB_XCNT(j)  (256  + 64 * (j))
#define XB_XSUB(j)  (1280 + 64 * (j))
#define XB_XGEN(j)  (2304 + 64 * (j))
#define XB_TOP      3328
#define XB_TOPGEN   3392
#define XCD_BAR_WORDS 3456
#define XB_SPIN_CAP (1u << 18)

__device__ __forceinline__ unsigned xb_ld(unsigned* p)              { return __hip_atomic_load(p, __ATOMIC_RELAXED, __HIP_MEMORY_SCOPE_AGENT); }
__device__ __forceinline__ unsigned xb_add(unsigned* p, unsigned v) { return __hip_atomic_fetch_add(p, v, __ATOMIC_RELAXED, __HIP_MEMORY_SCOPE_AGENT); }
__device__ __forceinline__ unsigned xb_xcc_id() { return (unsigned)__builtin_amdgcn_s_getreg((3 << 11) | 20) & 0xFu; }
#define XB_SPIN(cond, bar) do { unsigned _sp = 0; while (cond) { __builtin_amdgcn_s_sleep(1); \
    if ((++_sp & 255u) == 0u) { if (xb_ld(&(bar)[XB_TMO])) break; if (_sp > XB_SPIN_CAP) { atomicAdd(&(bar)[XB_TMO], 1u); break; } } } } while (0)

struct XcdBarrier {
    unsigned* bar; unsigned x;
    volatile LAS unsigned* st;
};

__device__ __forceinline__ XcdBarrier xcd_barrier_post(unsigned* bar, volatile LAS unsigned* st) {
    XcdBarrier b; b.bar = bar; b.x = xb_xcc_id(); b.st = st;
    if (threadIdx.x == 0) (void)xb_add(&bar[XB_XCNT(b.x)], 1u);
    return b;
}
__device__ __forceinline__ void xcd_barrier_complete(unsigned* bar, unsigned x, unsigned& nloc, unsigned& nx) {
    const unsigned G = gridDim.x * gridDim.y * gridDim.z;
    unsigned sum, cnt, mine, sp = 0u;
    for (;;) {
        sum = 0u; cnt = 0u; mine = 0u;
#pragma unroll
        for (unsigned j = 0; j < 16; ++j) { const unsigned c = xb_ld(&bar[XB_XCNT(j)]); sum += c; cnt += (c > 0u) ? 1u : 0u; mine = (j == x) ? c : mine; }
        if (sum == G) break;
        __builtin_amdgcn_s_sleep(1);
        if ((++sp & 255u) == 0u) { if (xb_ld(&bar[XB_TMO])) break; if (sp > XB_SPIN_CAP) { atomicAdd(&bar[XB_TMO], 1u); break; } }
    }
    nloc = mine > 0u ? mine : 1u; nx = cnt > 0u ? cnt : 1u;
}

__device__ __forceinline__ void xcd_barrier(const XcdBarrier& b) {
    asm volatile("s_waitcnt vmcnt(0)" ::: "memory");
    __syncthreads();
    if (threadIdx.x == 0) {
        unsigned* bar = b.bar;
        __builtin_amdgcn_s_waitcnt(0);
        unsigned nloc = b.st[0], nx = b.st[1];
        if (nloc == 0u) { xcd_barrier_complete(bar, b.x, nloc, nx); b.st[0] = nloc; b.st[1] = nx; }
        const unsigned old = xb_add(&bar[XB_XSUB(b.x)], 1u);
        const unsigned gen = old / nloc;
        if (old + 1u == (gen + 1u) * nloc) {
            __builtin_amdgcn_fence(__ATOMIC_RELEASE, "agent");
            asm volatile("s_waitcnt vmcnt(0)" ::: "memory");
            const unsigned og = xb_add(&bar[XB_TOP], 1u);
            const unsigned tg = og / nx;
            if (og + 1u == (tg + 1u) * nx) xb_add(&bar[XB_TOPGEN], 1u);
            else XB_SPIN(xb_ld(&bar[XB_TOPGEN]) == tg, bar);
            __builtin_amdgcn_fence(__ATOMIC_ACQUIRE, "agent");
            xb_add(&bar[XB_XGEN(b.x)], 1u);
            asm volatile("s_waitcnt vmcnt(0)" ::: "memory");
        } else {
            XB_SPIN(xb_ld(&bar[XB_XGEN(b.x)]) == gen, bar);
            __builtin_amdgcn_fence(__ATOMIC_ACQUIRE, "agent");
            asm volatile("s_waitcnt vmcnt(0)" ::: "memory");
        }
    }
    __syncthreads();
}
DI KP kargs() { unsigned long long v = (unsigned long long)__builtin_amdgcn_kernarg_segment_ptr(); asm volatile("" : "+s"(v)); return (KP)v; }
#define PH_VARS KP Pk = kargs(); int tid = threadIdx.x; asm volatile("" : "+v"(tid)); const int lane = tid & 63, wid = __builtin_amdgcn_readfirstlane(tid >> 6); \
    const int G = gridDim.x, bx = blockIdx.x; const int gw = bx * 8 + wid, NGW = G * 8, gtid = bx * 512 + tid, GT = G * 512; unsigned char* ws = Pk->ws; (void)lane; (void)gw; (void)NGW; (void)gtid; (void)GT; (void)ws;
__global__ void __launch_bounds__(512, 2) fwd(Params Pdummy) {
    extern __shared__ __attribute__((aligned(16))) unsigned char lds_g[];
    LAS unsigned char* lds = (LAS unsigned char*)lds_g;
    cg::grid_group grid = cg::this_grid();
    int lo, hi; unsigned* barw; { KP Pk = kargs(); lo = Pk->ph_lo; hi = Pk->ph_hi; barw = (unsigned*)(Pk->ws + WS_BAR); }
    if (hi > 1000) grid.sync();
    if (threadIdx.x < 2) ((volatile LAS unsigned*)(lds + 131072))[threadIdx.x] = 0u;
    __syncthreads();
    XcdBarrier xb; xb.bar = barw; xb.x = 0; xb.st = nullptr;
    if (hi - lo > 1) xb = xcd_barrier_post(barw, (volatile LAS unsigned*)(lds + 131072));
#ifndef PROBE_REP
#define PROBE_REP -1
#endif
#ifndef PROBE_N
#define PROBE_N 0
#endif
#ifndef PROBE_MIX
#define PROBE_MIX 0
#endif
#ifndef PROBE_SYNC
#define PROBE_SYNC 0
#endif
#define REPS(k) for (int rep_ = 0; rep_ < ((k) == PROBE_REP ? 1 + PROBE_N : 1); ++rep_)
#define IN(k) (lo <= (k) && (k) < hi)
#define SEAM(k) do { if (IN(k) && IN((k) + 1)) xcd_barrier(xb); } while (0)
    if (IN(0)) REPS(0) { PH_VARS prologue(Pk, lds, gw, NGW, gtid, GT, wid, lane); }
    SEAM(0);
    for (int i_ = 0; i_ < PROBE_SYNC; ++i_) xcd_barrier(xb);
    if (IN(1)) REPS(1) { PH_VARS
        pg8::Gemm g{(const bf16_t*)(ws + WS_CS), (const bf16_t*)(ws + WS_WADA), 256, MODLD, DM}; pg8::StaticOrder S; S.init(256, MODLD, G, bx);
        EpiMod E{(float*)(ws + WS_MOD), Pk->in[8]};
        pg8::gemm_phase<EpiMod, pg8::StaticOrder, PG8_ALIGN, PG8_SP2>(lds, g, S, E, tid);
    }
    SEAM(1);
#pragma unroll 1
    for (int l = 0; l < 2; ++l) {
        const int pb = 2 + 10 * l;
#define LAYER_VARS unsigned char* wl = ws + WS_L0 + (size_t)l * LAYER_BYTES; bf16_t* XB = (bf16_t*)(ws + WS_X); float* XS = (float*)(ws + WS_XS); float* XSv = XS - (size_t)TP * DM; bf16_t* H = (bf16_t*)(ws + WS_H); bf16_t* ACT = (bf16_t*)(ws + WS_ACT); bf16_t* Z = (bf16_t*)(ws + WS_Z); bf16_t* MIX = (bf16_t*)(ws + WS_MIX); \
        const float* modl = (const float*)(ws + WS_MOD) + (size_t)l * NMOD; const float* gain_l = Pk->in[9] + (size_t)l * 3 * DM; \
        (void)wl; (void)XB; (void)XS; (void)XSv; (void)H; (void)ACT; (void)Z; (void)MIX; (void)modl; (void)gain_l;
        if (IN(pb + 0)) REPS(pb + 0) { PH_VARS LAYER_VARS
            if (l == 0) norm_phase<false>(Pk->in[0], Pk->in[1], gain_l, modl, H, nullptr, gw, NGW, lane, XSv);
            else { norm_phase_bf<false>(XB, gain_l, modl, H, nullptr, gw, NGW, lane); norm_phase<false>(nullptr, XS, gain_l, modl, H, nullptr, gw, NGW, lane, nullptr, TP / 16); } }
        SEAM(pb + 0);
        if (IN(pb + 1)) REPS(pb + 1) { PH_VARS LAYER_VARS
            pg8::Gemm g{H, (const bf16_t*)(wl + LW_GU1), MPAD, 2 * FF, DM}; pg8::StaticOrder S; S.init(MPAD, 2 * FF, G, bx, DM, TP / 256);
            EpiSwiGLU E{ACT};
            pg8::gemm_phase<EpiSwiGLU, pg8::StaticOrder, PG8_ALIGN, PG8_SP2>(lds, g, S, E, tid);
        }
        SEAM(pb + 1);
        if (IN(pb + 2)) REPS(pb + 2) { PH_VARS LAYER_VARS
            pg8::Gemm g{ACT, (const bf16_t*)(wl + LW_D1), MPAD, DM, FF}; SplitOrder S; S.init(DM, FF, G, bx);
            EpiResid E{l == 0 ? Pk->in[0] : nullptr, XB, XSv, modl + 2 * DM, 0.5f};
            pg8::gemm_phase<EpiResid, SplitOrder, PG8_ALIGN, PG8_SP2>(lds, g, S, E, tid);
        }
        SEAM(pb + 2);
        if (IN(pb + 3)) REPS(pb + 3) { PH_VARS LAYER_VARS norm_phase_bf<false>(XB, gain_l + DM, modl + 3 * DM, H, nullptr, gw, NGW, lane); norm_phase<false>(nullptr, XS, gain_l + DM, modl + 3 * DM, H, nullptr, gw, NGW, lane, nullptr, TP / 16); }
        SEAM(pb + 3);
        if (IN(pb + 4)) REPS(pb + 4) { PH_VARS LAYER_VARS
            pg8::Gemm g{H, (const bf16_t*)(wl + LW_IN), MPAD, INW, DM}; pg8::StaticOrder S; S.init(MPAD, INW, G, bx, DM, TP / 256);
            EpiStoreBf16 E{Z, INW};
            pg8::gemm_phase<EpiStoreBf16, pg8::StaticOrder, PG8_ALIGN, PG8_SP2>(lds, g, S, E, tid);
        }
        SEAM(pb + 4);
        if (IN(pb + 5)) REPS(pb + 5) { PH_VARS LAYER_VARS
            const float* TB = (const float*)(ws + WS_TB);
            const float* sinks_l = Pk->in[12] + l * 8;
            const float* ck = Pk->in[4] + (size_t)l * 128 * 128 * 128; const float* cv = Pk->in[5] + (size_t)l * 128 * 128 * 128; const float* sp = Pk->in[6] + (size_t)l * 128 * 15 * 512;
            for (int id = bx; id < 816; id += G) {
                if (id < 512) { for (int rp = 0; rp < (PROBE_MIX == 1 ? 2 : 1); ++rp) { const int kvh = id & 1, bn = id >> 1; attn_unit(lds, Z, MIX, TB, sinks_l, bn >> 5, bn & 31, kvh, tid); } }
                else if (id < 784) { for (int rp = 0; rp < (PROBE_MIX == 2 ? 2 : 1); ++rp) pool_unit(lds, Z, sp, (const bf16_t*)(wl + LW_POOL), Pk->in[15] + l * 512, MIX, id - 512, tid); }
                else { for (int rp = 0; rp < (PROBE_MIX == 3 ? 2 : 1); ++rp) { const int task = (id - 784) * 8 + wid; sattn_task((LAS float*)(lds + wid * 4096), Z, ck, cv, MIX, TB, sinks_l, task >> 1, task & 1, lane); __syncthreads(); } }
            }
            for (int rp = 0; rp < (PROBE_MIX == 4 ? 2 : 1); ++rp) states_copy(Pk, Z, l, gtid, GT);
        }
        SEAM(pb + 5);
        if (IN(pb + 6)) REPS(pb + 6) { PH_VARS LAYER_VARS
            pg8::Gemm g{MIX, (const bf16_t*)(wl + LW_OUT), MPAD, DM, DM}; SplitOrder S; S.init(DM, DM, G, bx);
            EpiResid E{nullptr, XB, XSv, modl + 5 * DM, 1.0f};
            pg8::gemm_phase<EpiResid, SplitOrder, PG8_ALIGN, PG8_SP2>(lds, g, S, E, tid);
        }
        SEAM(pb + 6);
        if (IN(pb + 7)) REPS(pb + 7) { PH_VARS LAYER_VARS norm_phase_bf<false>(XB, gain_l + 2 * DM, modl + 6 * DM, H, nullptr, gw, NGW, lane); norm_phase<false>(nullptr, XS, gain_l + 2 * DM, modl + 6 * DM, H, nullptr, gw, NGW, lane, nullptr, TP / 16); }
        SEAM(pb + 7);
        if (IN(pb + 8)) REPS(pb + 8) { PH_VARS LAYER_VARS
            pg8::Gemm g{H, (const bf16_t*)(wl + LW_GU2), MPAD, 2 * FF, DM}; pg8::StaticOrder S; S.init(MPAD, 2 * FF, G, bx, DM, TP / 256);
            EpiSwiGLU E{ACT};
            pg8::gemm_phase<EpiSwiGLU, pg8::StaticOrder, PG8_ALIGN, PG8_SP2>(lds, g, S, E, tid);
        }
        SEAM(pb + 8);
        if (IN(pb + 9)) REPS(pb + 9) { PH_VARS LAYER_VARS
            pg8::Gemm g{ACT, (const bf16_t*)(wl + LW_D2), MPAD, DM, FF}; SplitOrder S; S.init(DM, FF, G, bx);
            EpiResid E{nullptr, XB, XSv, modl + 8 * DM, 0.5f};
            pg8::gemm_phase<EpiResid, SplitOrder, PG8_ALIGN, PG8_SP2>(lds, g, S, E, tid);
        }
        SEAM(pb + 9);
    }
    if (IN(22)) REPS(22) { PH_VARS norm_phase_bf<true>((const bf16_t*)(ws + WS_X), Pk->in[22], nullptr, nullptr, Pk->out, gw, NGW, lane); norm_phase<true>(nullptr, (const float*)(ws + WS_XS), Pk->in[22], nullptr, nullptr, Pk->out, gw, NGW, lane, nullptr, TP / 16); }
#undef IN
#undef SEAM
}

extern "C" void kernel_launch(void* const* d_in, const int* in_sizes, int n_in, void* d_out, int out_size, void* d_ws, size_t ws_size, hipStream_t stream) {
    static int grid = 0;
    if (grid == 0) {
        if (n_in != 23 || (size_t)out_size != O_END || ws_size < WS_END) { fprintf(stderr, "kernel_launch: unexpected sizes n_in %d out %d ws %zu\n", n_in, out_size, ws_size); grid = -1; return; }
        int dev = 0, cus = 0, per_cu = 0;
        (void)hipGetDevice(&dev); (void)hipDeviceGetAttribute(&cus, hipDeviceAttributeMultiprocessorCount, dev);
        if (hipFuncSetAttribute((const void*)fwd, hipFuncAttributeMaxDynamicSharedMemorySize, LDS_BYTES) != hipSuccess) { fprintf(stderr, "kernel_launch: hipFuncSetAttribute failed\n"); grid = -1; return; }
        if (hipOccupancyMaxActiveBlocksPerMultiprocessor(&per_cu, (const void*)fwd, 512, LDS_BYTES) != hipSuccess || per_cu < 1) { fprintf(stderr, "kernel_launch: occupancy query says %d\n", per_cu); per_cu = 1; }
        (void)hipGetLastError();
        grid = cus * per_cu;
    }
    if (grid < 0) return;
    Params p{};
    for (int i = 0; i < 23; ++i) p.in[i] = (const float*)d_in[i];
    p.out = (float*)d_out; p.ws = (unsigned char*)d_ws;
#if N_LAUNCH_PER_PHASE
    for (int ph = 0; ph < NPH; ++ph) { p.ph_lo = ph; p.ph_hi = ph + 1; hipLaunchKernelGGL(fwd, dim3(grid), dim3(512), LDS_BYTES, stream, p); }
#else
    p.ph_lo = 0; p.ph_hi = NPH;
    if (hipMemsetAsync((char*)d_ws + WS_BAR, 0, WS_BAR_BYTES, stream) != hipSuccess) { fprintf(stderr, "kernel_launch: memset failed\n"); return; }
    void* args[] = {&p};
    hipError_t e = hipLaunchCooperativeKernel((const void*)fwd, dim3(grid), dim3(512), args, LDS_BYTES, stream);
    if (e != hipSuccess) fprintf(stderr, "kernel_launch: cooperative launch failed: %s (grid %d)\n", hipGetErrorString(e), grid);
#endif
}
```

```cpp
#define STAG_TICKS 0
#include <hip/hip_runtime.h>
#include <hip/hip_cooperative_groups.h>
#include <cstdio>
#include <cstdint>
namespace cg = cooperative_groups;
namespace pg8 {
#define PG8_LAS __attribute__((address_space(3)))
typedef unsigned short bf16_t;
typedef short bf16x8 __attribute__((ext_vector_type(8)));
typedef float f32x4 __attribute__((ext_vector_type(4)));
typedef unsigned u32x4 __attribute__((ext_vector_type(4)));
constexpr int BM = 256, BK = 64, HALF = 128, HTB = HALF * BK * 2  , STAGE_BYTES = 8 * HTB, NXCD = 8, WGM = 8;

__host__ __device__ __forceinline__ int lds_byte(int r, int c) { const int st = (r >> 4) * 2 + (c >> 5), rr = r & 15, cc = c & 31, ob = rr * 64 + cc * 2; return st * 1024 + (ob ^ (((ob >> 9) & 1) << 5)); }
__host__ __device__ __forceinline__ void stage_rc(int b, int& R, int& C) { const int st = b / 1024, sb = b % 1024, swz = sb ^ (((sb >> 9) & 1) << 5); R = (st >> 1) * 16 + swz / 64; C = (st & 1) * 32 + (swz % 64) / 2; }
__host__ __device__ __forceinline__ int perm32(int rho) { const int n = rho >> 4, i = rho & 15; return 8 * (i >> 2) + 4 * n + (i & 3); }

struct Unit { int pm, pn, k0; };
struct Gemm { const bf16_t* A; const bf16_t* Bt; int M, N, K; };

struct StaticOrder {
    static constexpr bool SPLIT = false;
    int nM, nN, nwg, G, c;
    __host__ __device__ void init(int M, int N, int G_, int c_, int K_ = 1024, int half_pm_ = -1) { nM = M / BM; nN = N / BM; nwg = nM * nN; G = G_; c = c_; (void)K_; (void)half_pm_; }
    __host__ __device__ bool next(int i, Unit& u) const {
        const long L = (long)i * G + c; if (L >= nwg) return false;
        int wgid = (int)L; { const int q = nwg / NXCD, r = nwg % NXCD, xcd = wgid % NXCD, off = wgid / NXCD; wgid = (xcd < r ? xcd * (q + 1) : r * (q + 1) + (xcd - r) * q) + off; }
        const int nig = WGM * nN, gid = wgid / nig, fm = gid * WGM, gsz = (nM - fm) < WGM ? (nM - fm) : WGM;
        u.pm = fm + ((wgid % nig) % gsz); u.pn = (wgid % nig) / gsz; u.k0 = 0; return true;
    }
    __device__ __forceinline__ void a_ready(const Unit&) const {}
    __device__ __forceinline__ void done(const Unit&) const {}
};

__device__ __forceinline__ unsigned cvt_pk_bf16(float lo, float hi) { unsigned r; asm volatile("v_cvt_pk_bf16_f32 %0, %1, %2" : "=v"(r) : "v"(lo), "v"(hi)); return r; }
typedef float f32x2 __attribute__((ext_vector_type(2)));
template <class Epi, class Sched, bool ALIGN_EPI = false, bool SP2 = false>
__device__ __forceinline__ void gemm_phase(PG8_LAS unsigned char* lds, const Gemm g, const Sched& S, const Epi& E, const int tid_in) {
    const int tid = tid_in, wid = __builtin_amdgcn_readfirstlane(tid >> 6), lane = tid & 63, wr = wid >> 2, wc = wid & 3, fr = lane & 15, fq = lane >> 4;
    const int K = g.K;
    unsigned voffA[2], voffB[2];
#pragma unroll
    for (int i = 0; i < 2; ++i) { int R, C; stage_rc(tid * 16 + i * 8192, R, C); const int Rb = Epi::PERM ? ((R & ~31) + perm32(R & 31)) : R;
        voffA[i] = (unsigned)(R * K + C) * 2u; voffB[i] = (unsigned)(Rb * K + C) * 2u; }
    const size_t kstep = (size_t)(BK * 2);
    const size_t hstep = (size_t)HALF * K * 2;
    const size_t tstep = 2 * hstep;
    const unsigned ldsw = (unsigned)wid * 1024u;
    const int aoff = lds_byte(wr * 64 + fr, fq * 8), boff = lds_byte(wc * 32 + fr, fq * 8);
#define PG8_SA(b, h) (((b) * 2 + (h)) * HTB)
#define PG8_SB(b, h) ((4 + (b) * 2 + (h)) * HTB)
#define PG8_STAGE(bufoff, gbase, voff) do { _Pragma("unroll") for (int _i = 0; _i < 2; ++_i) \
        __builtin_amdgcn_global_load_lds((const unsigned*)((const char*)(gbase) + (voff)[_i]), (PG8_LAS unsigned*)(lds + (bufoff) + ldsw + _i * 8192), 16, 0, 0); } while (0)
#define PG8_LDA(dst, b, h) do { _Pragma("unroll") for (int m = 0; m < 4; ++m) _Pragma("unroll") for (int k = 0; k < 2; ++k) dst[m][k] = *(const PG8_LAS bf16x8*)(lds + PG8_SA(b, h) + aoff + m * 2048 + k * 1024); } while (0)
#define PG8_LDB(dst, b, h) do { _Pragma("unroll") for (int n = 0; n < 2; ++n) _Pragma("unroll") for (int k = 0; k < 2; ++k) dst[n][k] = *(const PG8_LAS bf16x8*)(lds + PG8_SB(b, h) + boff + n * 2048 + k * 1024); } while (0)
#define PG8_MMA(ai, bj, At, Bt) do { __builtin_amdgcn_s_setprio(1); _Pragma("unroll") for (int m = 0; m < 4; ++m) _Pragma("unroll") for (int n = 0; n < 2; ++n) _Pragma("unroll") for (int k = 0; k < 2; ++k) \
        acc[ai][bj][m][n] = __builtin_amdgcn_mfma_f32_16x16x32_bf16(Bt[n][k], At[m][k], acc[ai][bj][m][n], 0, 0, 0); __builtin_amdgcn_s_setprio(0); } while (0)
#define PG8_WAIT_V(n) asm volatile("s_waitcnt vmcnt(" #n ")" ::: "memory")
#define PG8_WAIT_L(n) asm volatile("s_waitcnt lgkmcnt(" #n ")" ::: "memory")
#define PG8_BAR __builtin_amdgcn_s_barrier()
#define PG8_SCHED __builtin_amdgcn_sched_barrier(0)
    Unit cur, nxt; int ui = 0;
    if (!S.next(0, cur)) return;
    f32x4 acc[2][2][4][2];
#pragma unroll
    for (int a = 0; a < 2; ++a)
#pragma unroll
        for (int b = 0; b < 2; ++b)
#pragma unroll
            for (int m = 0; m < 4; ++m)
#pragma unroll
                for (int n = 0; n < 2; ++n) acc[a][b][m][n] = (f32x4){0.f, 0.f, 0.f, 0.f};
    bf16x8 At[4][2], B0[2][2], B1[2][2];
    const char* cA = (const char*)g.A + (size_t)cur.pm * tstep + (size_t)cur.k0 * kstep; const char* cB = (const char*)g.Bt + (size_t)cur.pn * tstep + (size_t)cur.k0 * kstep;
    S.a_ready(cur);
    if constexpr (SP2) {
        PG8_STAGE(PG8_SB(0, 0), cB, voffB); PG8_STAGE(PG8_SB(0, 1), cB + hstep, voffB); PG8_STAGE(PG8_SA(0, 0), cA, voffA); PG8_STAGE(PG8_SA(0, 1), cA + hstep, voffA);
        if (wr == 1) PG8_BAR;
        PG8_WAIT_V(2); PG8_BAR;
        PG8_STAGE(PG8_SB(1, 0), cB + kstep, voffB); PG8_STAGE(PG8_SA(1, 0), cA + kstep, voffA); PG8_STAGE(PG8_SB(1, 1), cB + hstep + kstep, voffB);
        PG8_WAIT_V(6); PG8_BAR;
    } else {
        PG8_STAGE(PG8_SB(0, 0), cB, voffB); PG8_STAGE(PG8_SA(0, 0), cA, voffA); PG8_STAGE(PG8_SB(0, 1), cB + hstep, voffB); PG8_STAGE(PG8_SA(0, 1), cA + hstep, voffA);
        if (wr == 1) PG8_BAR;
        PG8_WAIT_V(4); PG8_BAR;
        PG8_STAGE(PG8_SB(1, 0), cB + kstep, voffB); PG8_STAGE(PG8_SA(1, 0), cA + kstep, voffA); PG8_STAGE(PG8_SB(1, 1), cB + hstep + kstep, voffB);
        PG8_WAIT_V(6); PG8_BAR;
    }
    for (;;) {
        const bool has_next = S.next(ui + 1, nxt);
        const char* nA = has_next ? (const char*)g.A + (size_t)nxt.pm * tstep + (size_t)nxt.k0 * kstep : cA; const char* nB = has_next ? (const char*)g.Bt + (size_t)nxt.pn * tstep + (size_t)nxt.k0 * kstep : cB;
        const bool full = (cur.pm != 128); const int nt = (Sched::SPLIT && !full) ? 4 : K / BK;
        for (int t = 0; t < nt; t += 2) {
            const bool last = (t == nt - 2);
            const char* a1 = cA + (size_t)(t + 1) * kstep;
            const char* a2 = last ? nA : cA + (size_t)(t + 2) * kstep; const char* b2 = last ? nB : cB + (size_t)(t + 2) * kstep;
            const char* a3 = a2 + kstep; const char* b3 = b2 + kstep;
            if (last && has_next) S.a_ready(nxt);
            if constexpr (SP2) {
            PG8_LDB(B0, 0, 0); PG8_LDB(B1, 0, 1); PG8_SCHED; PG8_LDA(At, 0, 0); PG8_STAGE(PG8_SA(1, 1), a1 + hstep, voffA);
            PG8_WAIT_V(8); PG8_WAIT_L(0); PG8_BAR; PG8_MMA(0, 0, At, B0); PG8_MMA(0, 1, At, B1); PG8_BAR; PG8_SCHED;
            PG8_LDA(At, 0, 1); PG8_STAGE(PG8_SB(0, 0), b2, voffB); PG8_STAGE(PG8_SB(0, 1), b2 + hstep, voffB); PG8_STAGE(PG8_SA(0, 0), a2, voffA);
            PG8_WAIT_V(8); PG8_WAIT_L(0); PG8_BAR; if (full) { PG8_MMA(1, 0, At, B0); PG8_MMA(1, 1, At, B1); } PG8_BAR; PG8_SCHED;
            PG8_LDB(B0, 1, 0); PG8_LDB(B1, 1, 1); PG8_SCHED; PG8_LDA(At, 1, 0); PG8_STAGE(PG8_SA(0, 1), a2 + hstep, voffA);
            PG8_WAIT_V(8); PG8_WAIT_L(0); PG8_BAR; PG8_MMA(0, 0, At, B0); PG8_MMA(0, 1, At, B1); PG8_BAR; PG8_SCHED;
            PG8_LDA(At, 1, 1); PG8_STAGE(PG8_SB(1, 0), b3, voffB); PG8_STAGE(PG8_SB(1, 1), b3 + hstep, voffB); PG8_STAGE(PG8_SA(1, 0), a3, voffA);
            PG8_WAIT_V(8); PG8_WAIT_L(0); PG8_BAR; if (full) { PG8_MMA(1, 0, At, B0); PG8_MMA(1, 1, At, B1); } PG8_BAR; PG8_SCHED;
            } else {
            PG8_LDB(B0, 0, 0); PG8_SCHED; PG8_LDA(At, 0, 0); PG8_STAGE(PG8_SA(1, 1), a1 + hstep, voffA);
            PG8_WAIT_L(8); PG8_BAR; PG8_WAIT_L(0); PG8_MMA(0, 0, At, B0); PG8_BAR; PG8_SCHED;
            PG8_LDB(B1, 0, 1); PG8_STAGE(PG8_SB(0, 0), b2, voffB);
            PG8_BAR; PG8_WAIT_L(0); PG8_MMA(0, 1, At, B1); PG8_BAR;
            PG8_LDA(At, 0, 1); PG8_STAGE(PG8_SA(0, 0), a2, voffA);
            PG8_BAR; PG8_WAIT_L(0); PG8_MMA(1, 0, At, B0); PG8_BAR; PG8_SCHED;
            PG8_STAGE(PG8_SB(0, 1), b2 + hstep, voffB);
            PG8_WAIT_V(6); PG8_BAR; PG8_MMA(1, 1, At, B1); PG8_BAR;
            PG8_LDB(B0, 1, 0); PG8_SCHED; PG8_LDA(At, 1, 0); PG8_STAGE(PG8_SA(0, 1), a2 + hstep, voffA);
            PG8_WAIT_L(8); PG8_BAR; PG8_WAIT_L(0); PG8_MMA(0, 0, At, B0); PG8_BAR; PG8_SCHED;
            PG8_LDB(B1, 1, 1); PG8_STAGE(PG8_SB(1, 0), b3, voffB);
            PG8_BAR; PG8_WAIT_L(0); PG8_MMA(0, 1, At, B1); PG8_BAR;
            PG8_LDA(At, 1, 1); PG8_STAGE(PG8_SA(1, 0), a3, voffA);
            PG8_BAR; PG8_WAIT_L(0); PG8_MMA(1, 0, At, B0); PG8_BAR; PG8_SCHED;
            PG8_STAGE(PG8_SB(1, 1), b3 + hstep, voffB);
            PG8_WAIT_V(6); PG8_BAR; PG8_MMA(1, 1, At, B1); PG8_BAR;
            }
        }
        if constexpr (ALIGN_EPI) { if (wr == 0) PG8_BAR; }
        if constexpr (!Epi::AFTER_DRAIN) { E(acc, cur, wr, wc, fr, fq); S.done(cur); }
        if (!has_next) break;
#pragma unroll
        for (int a = 0; a < 2; ++a)
#pragma unroll
            for (int b = 0; b < 2; ++b)
#pragma unroll
                for (int m = 0; m < 4; ++m)
#pragma unroll
                    for (int n = 0; n < 2; ++n) acc[a][b][m][n] = (f32x4){0.f, 0.f, 0.f, 0.f};
        cur = nxt; cA = nA; cB = nB; ++ui;
        if constexpr (ALIGN_EPI) { if (wr == 1) PG8_BAR; }
    }
    PG8_WAIT_V(0);
    if constexpr (!ALIGN_EPI) { if (wr == 0) PG8_BAR; }
    PG8_BAR;
    if constexpr (Epi::AFTER_DRAIN) { E.fused(acc, cur, wr, wc, fr, fq, lds, wid, lane); S.done(cur); }
#undef PG8_SA
#undef PG8_SB
#undef PG8_STAGE
#undef PG8_LDA
#undef PG8_LDB
#undef PG8_MMA
#undef PG8_WAIT_V
#undef PG8_WAIT_L
#undef PG8_BAR
#undef PG8_SCHED
}
}
#ifndef PG8_SP2
#define PG8_SP2 true
#endif
#ifndef PG8_ALIGN
#define PG8_ALIGN true
#endif
#ifndef N_LAUNCH_PER_PHASE
#define N_LAUNCH_PER_PHASE 0
#endif

#define DI __device__ __forceinline__
#define LAS __attribute__((address_space(3)))
typedef unsigned short bf16_t;
typedef short bf16x8 __attribute__((ext_vector_type(8)));
typedef short s16x4 __attribute__((ext_vector_type(4)));
typedef float f32x4 __attribute__((ext_vector_type(4)));
typedef float f32x2 __attribute__((ext_vector_type(2)));
typedef float f32x16 __attribute__((ext_vector_type(16)));
typedef unsigned u32x4 __attribute__((ext_vector_type(4)));
typedef unsigned u32x2 __attribute__((ext_vector_type(2)));
typedef __bf16 bf16x2_t __attribute__((ext_vector_type(2)));

constexpr int TP = 32768, TS = 128, TT = TP + TS, MPAD = 33024;
constexpr int DM = 1024, FF = 2816, INW = 1280, NMOD = 9216, MODLD = 2 * NMOD;
constexpr int SEQ = 4096;
constexpr float EPS = 1e-6f, LOG2E = 1.4426950408889634f, C2 = 0.125f * 1.4426950408889634f;
constexpr int TBLD = 132;
constexpr size_t O_Y = 0, O_KP = 33685504, O_VP = 33947648, O_PP = 34209792, O_KS = 34332672, O_VS = 38526976, O_PS = 42721280, O_END = 44687360;
constexpr size_t MiB = 1u << 20;
constexpr size_t WS_XS = 1 * (1u << 20) + 512 * 1024;
constexpr size_t WS_BAR = 65536, WS_BAR_BYTES = 16384;
constexpr size_t WS_TB = 0, WS_CS = 1 * MiB, WS_MOD = 2 * MiB, WS_WADA = 12 * MiB, WS_L0 = 48 * MiB, LAYER_BYTES = 38 * MiB;
constexpr size_t LW_GU1 = 0, LW_D1 = 11 * MiB, LW_IN = 16 * MiB + MiB / 2, LW_OUT = 19 * MiB, LW_GU2 = 21 * MiB, LW_D2 = 32 * MiB, LW_POOL = 37 * MiB + MiB / 2;
constexpr size_t WS_X = 124 * MiB, WS_H = 253 * MiB, WS_ACT = 318 * MiB, WS_Z = WS_ACT, WS_MIX = WS_ACT + 96 * MiB, WS_END = 496 * MiB;
static_assert(WS_X + (size_t)MPAD * DM * 4 <= WS_H && WS_H + (size_t)MPAD * DM * 2 <= WS_ACT && WS_ACT + (size_t)MPAD * FF * 2 <= WS_END, "ws map");
static_assert(WS_Z + (size_t)MPAD * INW * 2 <= WS_MIX && WS_MIX + (size_t)MPAD * DM * 2 <= WS_END, "ws map 2");
static_assert(WS_MOD + (size_t)136 * MODLD * 4 <= WS_WADA && WS_WADA + (size_t)MODLD * DM * 2 <= WS_L0 && WS_L0 + 2 * LAYER_BYTES <= WS_X, "ws map 3");
constexpr int LDS_BYTES = 147456;
constexpr int NPH = 23;

struct Params { const float* in[23]; float* out; unsigned char* ws; int ph_lo, ph_hi; };

DI float bf2f(bf16_t b) { return __uint_as_float((unsigned)b << 16); }
DI unsigned pk2(float lo, float hi) { f32x2 v = {lo, hi}; bf16x2_t b = __builtin_convertvector(v, bf16x2_t); return __builtin_bit_cast(unsigned, b); }
DI float wave_sum(float v) {
#pragma unroll
    for (int o = 1; o < 64; o <<= 1) v += __shfl_xor(v, o);
    return v;
}
DI float wave_max(float v) {
#pragma unroll
    for (int o = 1; o < 64; o <<= 1) v = fmaxf(v, __shfl_xor(v, o));
    return v;
}
DI int crow(int r, int hi) { return (r & 3) + 8 * (r >> 2) + 4 * hi; }
DI f32x4 bf4_to_f4(const bf16_t* p) { const u32x2 v = *(const u32x2*)p; return (f32x4){__uint_as_float(v.x << 16), __uint_as_float(v.x & 0xffff0000u), __uint_as_float(v.y << 16), __uint_as_float(v.y & 0xffff0000u)}; }
#define MFMA32(a, b, c) __builtin_amdgcn_mfma_f32_32x32x16_bf16((a), (b), (c), 0, 0, 0)

struct EpiStoreBf16 {
    static constexpr bool PERM = true, AFTER_DRAIN = false;
    bf16_t* O; int ldc;
    DI void operator()(const pg8::f32x4 (&acc)[2][2][4][2], const pg8::Unit& u, int wr, int wc, int fr, int fq) const {
        const int row0 = u.pm * 256 + wr * 64 + fr, col0 = u.pn * 256 + wc * 32 + 8 * fq;
#pragma unroll
        for (int ai = 0; ai < 2; ++ai)
#pragma unroll
            for (int m = 0; m < 4; ++m) { bf16_t* rowp = O + (size_t)(row0 + ai * 128 + m * 16) * ldc + col0;
#pragma unroll
                for (int bj = 0; bj < 2; ++bj) { const f32x4 v0 = acc[ai][bj][m][0], v1 = acc[ai][bj][m][1];
                    u32x4 w; w.x = pk2(v0[0], v0[1]); w.y = pk2(v0[2], v0[3]); w.z = pk2(v1[0], v1[1]); w.w = pk2(v1[2], v1[3]);
                    *(u32x4*)(rowp + bj * 128) = w; } }
    }
};
DI float silu_mul(float g, float u) { return g * u * __builtin_amdgcn_rcpf(1.0f + __builtin_amdgcn_exp2f(-g * LOG2E)); }
struct EpiSwiGLU {
    static constexpr bool PERM = true, AFTER_DRAIN = false;
    bf16_t* O;
    DI void operator()(const pg8::f32x4 (&acc)[2][2][4][2], const pg8::Unit& u, int wr, int wc, int fr, int fq) const {
        const int row0 = u.pm * 256 + wr * 64 + fr, col0 = u.pn * 128 + wc * 32 + 8 * fq;
#pragma unroll
        for (int ai = 0; ai < 2; ++ai)
#pragma unroll
            for (int m = 0; m < 4; ++m) { bf16_t* rowp = O + (size_t)(row0 + ai * 128 + m * 16) * FF + col0;
                const f32x4 g0 = acc[ai][0][m][0], g1 = acc[ai][0][m][1], u0 = acc[ai][1][m][0], u1 = acc[ai][1][m][1];
                u32x4 w; w.x = pk2(silu_mul(g0[0], u0[0]), silu_mul(g0[1], u0[1])); w.y = pk2(silu_mul(g0[2], u0[2]), silu_mul(g0[3], u0[3]));
                w.z = pk2(silu_mul(g1[0], u1[0]), silu_mul(g1[1], u1[1])); w.w = pk2(silu_mul(g1[2], u1[2]), silu_mul(g1[3], u1[3]));
                *(u32x4*)rowp = w; }
    }
};
struct TailOrder {
    static constexpr bool SPLIT = false;
    pg8::StaticOrder base; int nmain, nN, G, c;
    DI void init(int N, int G_, int c_) { base.init(TP, N, G_, c_); nN = N / 256; nmain = (TP / 256) * nN; G = G_; c = c_; }
    DI bool next(int i, pg8::Unit& u) const {
        const int L = i * G + c;
        if (L < nmain) return base.next(i, u);
        const int s = L - nmain; if (s >= nN) return false;
        u.pm = TP / 256; u.pn = s; u.k0 = 0; return true;
    }
    DI void a_ready(const pg8::Unit&) const {}
    DI void done(const pg8::Unit&) const {}
};
struct SplitOrder {
    static constexpr bool SPLIT = true;
    pg8::StaticOrder base; int nmain, nN, nchunk, G, c;
    DI void init(int N, int K, int G_, int c_) { base.init(TP, N, G_, c_, K, -1); nN = N / 256; nmain = (TP / 256) * nN; nchunk = K / 256; G = G_; c = c_; }
    DI bool next(int i, pg8::Unit& u) const {
        const int L = i * G + c;
        if (L < nmain) return base.next(i, u);
        const int s = L - nmain; if (s >= nN * nchunk) return false;
        u.pm = TP / 256; u.pn = s % nN; u.k0 = (s / nN) * 4; return true;
    }
    DI void a_ready(const pg8::Unit&) const {}
    DI void done(const pg8::Unit&) const {}
};
struct EpiResid {
    static constexpr bool PERM = true, AFTER_DRAIN = false;
    const float* xin_f32; bf16_t* XB; float* PART; const float* gate; float coef;
    DI void operator()(const pg8::f32x4 (&acc)[2][2][4][2], const pg8::Unit& u, int wr, int wc, int fr, int fq) const {
        const int row0 = u.pm * 256 + wr * 64 + fr, col0 = u.pn * 256 + wc * 32 + 8 * fq;
        if (u.pm == TP / 256) {
#pragma unroll
            for (int m = 0; m < 4; ++m) { const int row = row0 + m * 16; const float* gp = gate + (size_t)(8 + row - TP) * MODLD; float* dst = PART + ((size_t)(u.k0 >> 2) * 128 + (row - TP)) * DM;
#pragma unroll
                for (int bj = 0; bj < 2; ++bj)
#pragma unroll
                    for (int n = 0; n < 2; ++n) { const int col = col0 + bj * 128 + n * 4; const f32x4 gv = *(const f32x4*)(gp + col); const f32x4 v = (gv * coef) * acc[0][bj][m][n];
                        *(f32x4*)(dst + col) = v; } }
            return;
        }
        const float* gp = gate + (size_t)(u.pm >> 4) * MODLD;
        f32x4 gv[2][2];
#pragma unroll
        for (int bj = 0; bj < 2; ++bj)
#pragma unroll
            for (int n = 0; n < 2; ++n) gv[bj][n] = *(const f32x4*)(gp + col0 + bj * 128 + n * 4) * coef;
        if (xin_f32) {
#pragma unroll
            for (int ai = 0; ai < 2; ++ai)
#pragma unroll
                for (int m = 0; m < 4; ++m) { const size_t ro = (size_t)(row0 + ai * 128 + m * 16) * DM + col0;
#pragma unroll
                    for (int bj = 0; bj < 2; ++bj) { const f32x4 x0 = *(const f32x4*)(xin_f32 + ro + bj * 128), x1 = *(const f32x4*)(xin_f32 + ro + bj * 128 + 4);
                        const f32x4 o0 = x0 + gv[bj][0] * acc[ai][bj][m][0], o1 = x1 + gv[bj][1] * acc[ai][bj][m][1];
                        u32x4 w; w.x = pk2(o0[0], o0[1]); w.y = pk2(o0[2], o0[3]); w.z = pk2(o1[0], o1[1]); w.w = pk2(o1[2], o1[3]);
                        *(u32x4*)(XB + ro + bj * 128) = w; } }
        } else {
#pragma unroll
            for (int ai = 0; ai < 2; ++ai) {
                u32x4 xr[4][2];
#pragma unroll
                for (int m = 0; m < 4; ++m)
#pragma unroll
                    for (int bj = 0; bj < 2; ++bj) xr[m][bj] = *(const u32x4*)(XB + (size_t)(row0 + ai * 128 + m * 16) * DM + col0 + bj * 128);
                asm volatile("" ::: "memory");
#pragma unroll
                for (int m = 0; m < 4; ++m)
#pragma unroll
                    for (int bj = 0; bj < 2; ++bj) { const u32x4 r = xr[m][bj];
                        const f32x4 x0 = {__uint_as_float(r.x << 16), __uint_as_float(r.x & 0xffff0000u), __uint_as_float(r.y << 16), __uint_as_float(r.y & 0xffff0000u)};
                        const f32x4 x1 = {__uint_as_float(r.z << 16), __uint_as_float(r.z & 0xffff0000u), __uint_as_float(r.w << 16), __uint_as_float(r.w & 0xffff0000u)};
                        const f32x4 o0 = x0 + gv[bj][0] * acc[ai][bj][m][0], o1 = x1 + gv[bj][1] * acc[ai][bj][m][1];
                        u32x4 w; w.x = pk2(o0[0], o0[1]); w.y = pk2(o0[2], o0[3]); w.z = pk2(o1[0], o1[1]); w.w = pk2(o1[2], o1[3]);
                        *(u32x4*)(XB + (size_t)(row0 + ai * 128 + m * 16) * DM + col0 + bj * 128) = w; }
                asm volatile("" ::: "memory");
            }
        }
    }
};
struct EpiMod {
    static constexpr bool PERM = false, AFTER_DRAIN = false;
    float* mod; const float* bias;
    DI void operator()(const pg8::f32x4 (&acc)[2][2][4][2], const pg8::Unit& u, int wr, int wc, int fr, int fq) const {
        const int row0 = u.pm * 256 + wr * 64 + fr, col0 = u.pn * 256 + wc * 32 + 4 * fq;
#pragma unroll
        for (int ai = 0; ai < 2; ++ai)
#pragma unroll
            for (int m = 0; m < 4; ++m) { const int row = row0 + ai * 128 + m * 16;
                if (row < 136) {
#pragma unroll
                    for (int bj = 0; bj < 2; ++bj)
#pragma unroll
                        for (int n = 0; n < 2; ++n) { const int col = col0 + bj * 128 + n * 16;
                            *(f32x4*)(mod + (size_t)row * MODLD + col) = acc[ai][bj][m][n] + *(const f32x4*)(bias + col); } } }
    }
};
typedef const __attribute__((address_space(4))) Params* KP;
DI void transpose_item(const float* W, int K, int N, bf16_t* WT, int mode, LAS float* scr, int item, int lane) {
    const int nblk = N / 32, kb = item / nblk, nb = item % nblk, k0 = 64 * kb, n0 = 32 * nb;
#pragma unroll 8
    for (int i = 0; i < 32; ++i) { const int kk = 2 * i + (lane >> 5); scr[kk * 33 + (lane & 31)] = W[(size_t)(k0 + kk) * N + n0 + (lane & 31)]; }
    asm volatile("s_waitcnt lgkmcnt(0)" ::: "memory");
    int rbase = n0;
    if (mode == 1) rbase = (n0 >> 7) * 256 + (n0 & 127);
    if (mode == 2) rbase = (n0 >> 7) * 256 + 128 + (n0 & 127);
    const int c = lane & 7;
#pragma unroll
    for (int j = 0; j < 4; ++j) { const int n = (lane >> 3) + 8 * j; const LAS float* s = scr + (8 * c) * 33 + n;
        u32x4 o; o.x = pk2(s[0 * 33], s[1 * 33]); o.y = pk2(s[2 * 33], s[3 * 33]); o.z = pk2(s[4 * 33], s[5 * 33]); o.w = pk2(s[6 * 33], s[7 * 33]);
        *(u32x4*)(WT + (size_t)(rbase + n) * K + k0 + 8 * c) = o; }
    asm volatile("s_waitcnt lgkmcnt(0)" ::: "memory");
}
constexpr int I_ADA = (DM / 64) * (NMOD / 32), I_FU = (DM / 64) * (FF / 32), I_FD = (FF / 64) * (DM / 32), I_IN = (DM / 64) * (INW / 32), I_OUT = (DM / 64) * (DM / 32), I_POOL = 4 * 8;
constexpr int IPL = I_ADA + 4 * I_FU + 2 * I_FD + I_IN + I_OUT + I_POOL;
DI int t5_bucket(int n) {
    if (n < 16) return n;
    int b = 16;
    b += (n >= 19); b += (n >= 21); b += (n >= 24); b += (n >= 27); b += (n >= 31); b += (n >= 35); b += (n >= 40); b += (n >= 46);
    b += (n >= 52); b += (n >= 59); b += (n >= 67); b += (n >= 77); b += (n >= 87); b += (n >= 99); b += (n >= 113);
    return b;
}
DI void convert_item(KP P, int l, int r, LAS float* scr, int lane) {
    unsigned char* wl = P->ws + WS_L0 + (size_t)l * LAYER_BYTES;
    const float* src; bf16_t* dst; int K, N, mode = 0;
    if (r < I_ADA) { src = P->in[7] + (size_t)l * DM * NMOD; K = DM; N = NMOD; dst = (bf16_t*)(P->ws + WS_WADA) + (size_t)l * NMOD * DM; }
    else if ((r -= I_ADA) < I_FU) { src = P->in[16] + (size_t)l * DM * FF; K = DM; N = FF; dst = (bf16_t*)(wl + LW_GU1); mode = 1; }
    else if ((r -= I_FU) < I_FU) { src = P->in[17] + (size_t)l * DM * FF; K = DM; N = FF; dst = (bf16_t*)(wl + LW_GU1); mode = 2; }
    else if ((r -= I_FU) < I_FD) { src = P->in[18] + (size_t)l * FF * DM; K = FF; N = DM; dst = (bf16_t*)(wl + LW_D1); }
    else if ((r -= I_FD) < I_IN) { src = P->in[10] + (size_t)l * DM * INW; K = DM; N = INW; dst = (bf16_t*)(wl + LW_IN); }
    else if ((r -= I_IN) < I_OUT) { src = P->in[11] + (size_t)l * DM * DM; K = DM; N = DM; dst = (bf16_t*)(wl + LW_OUT); }
    else if ((r -= I_OUT) < I_FU) { src = P->in[19] + (size_t)l * DM * FF; K = DM; N = FF; dst = (bf16_t*)(wl + LW_GU2); mode = 1; }
    else if ((r -= I_FU) < I_FU) { src = P->in[20] + (size_t)l * DM * FF; K = DM; N = FF; dst = (bf16_t*)(wl + LW_GU2); mode = 2; }
    else if ((r -= I_FU) < I_FD) { src = P->in[21] + (size_t)l * FF * DM; K = FF; N = DM; dst = (bf16_t*)(wl + LW_D2); }
    else { r -= I_FD; const int g = r >> 3; r &= 7; src = P->in[14] + (size_t)(l * 4 + g) * 16384; K = 128; N = 128; dst = (bf16_t*)(wl + LW_POOL) + (size_t)g * 16384; }
    transpose_item(src, K, N, dst, mode, scr, r, lane);
}
DI void prologue_rest(KP P, LAS unsigned char* lds, int w, int nw, int wid, int lane) {
    LAS float* scr = (LAS float*)(lds + wid * 8448);
    constexpr int REST = IPL - I_ADA;
    for (int it = w; it < 2 * REST; it += nw) { const int l = it / REST; convert_item(P, l, I_ADA + (it - l * REST), scr, lane); }
}
DI void prologue(KP P, LAS unsigned char* lds, int gw, int NGW, int gtid, int GT, int wid, int lane) {
    LAS float* scr = (LAS float*)(lds + wid * 8448);
    for (int it = gw; it < 2 * I_ADA; it += NGW) { const int l = it / I_ADA; convert_item(P, l, it - l * I_ADA, scr, lane); }
    bf16_t* CS = (bf16_t*)(P->ws + WS_CS);
    for (int idx = gtid; idx < 256 * DM; idx += GT) {
        const int row = idx >> 10; float v = 0.f;
        if (row < 8) v = P->in[2][idx]; else if (row < 136) v = P->in[3][idx - 8 * DM];
        const float s = v / (1.0f + __expf(-v));
        CS[idx] = (bf16_t)(pk2(row < 136 ? s : 0.f, 0.f) & 0xffffu);
    }
    float* TB = (float*)(P->ws + WS_TB);
    for (int idx = gtid; idx < 8 * TBLD; idx += GT) { const int h = idx / TBLD, d = idx % TBLD; const int dd = d < 128 ? d : 128;
        TB[idx] = P->in[13][t5_bucket(dd) * 8 + h] * LOG2E; }
}

template <bool FINAL>
DI void norm_phase(const float* xp, const float* xs, const float* gain, const float* modsh, bf16_t* H, float* Y, int gw, int NGW, int lane, float* xcopy = nullptr, int blk_lo = 0, int blk_hi = TT / 16, int r4_lo = 0, int r4_hi = 16, const float* part = nullptr, int nparts = 0) {
    for (int blk = blk_lo + gw; blk < blk_hi; blk += NGW) {
        const int row0 = blk * 16; const bool prompt = row0 < TP;
        f32x4 Gv[4], Sv[4];
        if (FINAL) {
#pragma unroll
            for (int j = 0; j < 4; ++j) { Gv[j] = ((const f32x4*)gain)[lane + 64 * j]; Sv[j] = (f32x4){0.f, 0.f, 0.f, 0.f}; }
        } else if (prompt) {
            const float* mp = modsh + (size_t)(row0 >> 12) * MODLD;
#pragma unroll
            for (int j = 0; j < 4; ++j) { Gv[j] = ((const f32x4*)gain)[lane + 64 * j] * (((const f32x4*)(mp + DM))[lane + 64 * j] + 1.0f); Sv[j] = ((const f32x4*)mp)[lane + 64 * j]; }
        }
#pragma unroll 1
        for (int r4 = r4_lo; r4 < r4_hi; r4 += 4) {
            f32x4 v[4][4]; float ss[4];
#pragma unroll
            for (int q = 0; q < 4; ++q) { const int row = row0 + r4 + q;
                const float* xr = row < TP ? xp + (size_t)row * DM : xs + (size_t)(row - TP) * DM;
#pragma unroll
                for (int j = 0; j < 4; ++j) v[q][j] = ((const f32x4*)xr)[lane + 64 * j]; }
            if (part) {
#pragma unroll 3
                for (int p = 0; p < nparts; ++p) {
#pragma unroll
                    for (int q = 0; q < 4; ++q) { const float* pr = part + ((size_t)p * 128 + (row0 + r4 + q - TP)) * DM;
#pragma unroll
                        for (int j = 0; j < 4; ++j) v[q][j] += ((const f32x4*)pr)[lane + 64 * j]; } }
            }
#pragma unroll
            for (int q = 0; q < 4; ++q) { float a = 0.f;
#pragma unroll
                for (int j = 0; j < 4; ++j) a += (v[q][j].x * v[q][j].x + v[q][j].y * v[q][j].y) + (v[q][j].z * v[q][j].z + v[q][j].w * v[q][j].w);
                ss[q] = a; }
#pragma unroll
            for (int o = 1; o < 64; o <<= 1) {
#pragma unroll
                for (int q = 0; q < 4; ++q) ss[q] += __shfl_xor(ss[q], o); }
#pragma unroll
            for (int q = 0; q < 4; ++q) { const int row = row0 + r4 + q;
                if (!FINAL && !prompt) {
                    const float* mp = modsh + (size_t)(8 + row - TP) * MODLD;
#pragma unroll
                    for (int j = 0; j < 4; ++j) { Gv[j] = ((const f32x4*)gain)[lane + 64 * j] * (((const f32x4*)(mp + DM))[lane + 64 * j] + 1.0f); Sv[j] = ((const f32x4*)mp)[lane + 64 * j]; }
                    if (xcopy) {
#pragma unroll
                        for (int j = 0; j < 4; ++j) ((f32x4*)(xcopy + (size_t)row * DM))[lane + 64 * j] = v[q][j]; }
                }
                const float rstd = 1.0f / sqrtf(ss[q] * (1.0f / DM) + EPS);
                if (FINAL) {
#pragma unroll
                    for (int j = 0; j < 4; ++j) ((f32x4*)(Y + (size_t)row * DM))[lane + 64 * j] = v[q][j] * rstd * Gv[j];
                } else {
#pragma unroll
                    for (int j = 0; j < 4; ++j) { const f32x4 h = v[q][j] * rstd * Gv[j] + Sv[j]; u32x2 w; w.x = pk2(h.x, h.y); w.y = pk2(h.z, h.w);
                        ((u32x2*)(H + (size_t)row * DM))[lane + 64 * j] = w; }
                }
            }
        }
    }
}

template <bool FINAL>
DI void norm_sample(const float* xs, const float* gain, const float* modsh, bf16_t* H, float* Y, int gw, int NGW, int lane, float* xcopy, const float* part, int nparts) {
    if ((gw & 63) != 0) return;
    const int ns = (NGW >> 6) > 0 ? (NGW >> 6) : 1;
    for (int k = gw >> 6; k < 32; k += ns) norm_phase<FINAL>(nullptr, xs, gain, modsh, H, Y, 0, 1 << 28, lane, xcopy, TP / 16 + (k >> 2), TP / 16 + (k >> 2) + 1, 4 * (k & 3), 4 * (k & 3) + 4, part, nparts);
}
template <bool FINAL>
DI void norm_phase_bf(const bf16_t* XB, const float* gain, const float* modsh, bf16_t* H, float* Y, int gw, int NGW, int lane) {
    for (int blk = gw; blk < TP / 16; blk += NGW) {
        const int row0 = blk * 16;
        f32x4 Gv[2][2], Sv[2][2];
        const float* mp = FINAL ? nullptr : modsh + (size_t)(row0 >> 12) * MODLD;
#pragma unroll
        for (int j = 0; j < 2; ++j)
#pragma unroll
            for (int h = 0; h < 2; ++h) { const int fi = 2 * lane + 128 * j + h;
                if (FINAL) { Gv[j][h] = ((const f32x4*)gain)[fi]; Sv[j][h] = (f32x4){0.f, 0.f, 0.f, 0.f}; }
                else { Gv[j][h] = ((const f32x4*)gain)[fi] * (((const f32x4*)(mp + DM))[fi] + 1.0f); Sv[j][h] = ((const f32x4*)mp)[fi]; } }
#pragma unroll 1
        for (int r8 = 0; r8 < 16; r8 += 8) {
            u32x4 raw[8][2]; float ss[8];
#pragma unroll
            for (int q = 0; q < 8; ++q)
#pragma unroll
                for (int j = 0; j < 2; ++j) raw[q][j] = *(const u32x4*)(XB + (size_t)(row0 + r8 + q) * DM + 8 * lane + 512 * j);
#pragma unroll
            for (int q = 0; q < 8; ++q) { float a = 0.f;
#pragma unroll
                for (int j = 0; j < 2; ++j)
#pragma unroll
                    for (int e = 0; e < 4; ++e) { const float lo = __uint_as_float(raw[q][j][e] << 16), hi = __uint_as_float(raw[q][j][e] & 0xffff0000u); a += lo * lo + hi * hi; }
                ss[q] = a; }
#pragma unroll
            for (int o = 1; o < 64; o <<= 1) {
#pragma unroll
                for (int q = 0; q < 8; ++q) ss[q] += __shfl_xor(ss[q], o); }
#pragma unroll
            for (int q = 0; q < 8; ++q) { const int row = row0 + r8 + q;
                const float rstd = 1.0f / sqrtf(ss[q] * (1.0f / DM) + EPS);
#pragma unroll
                for (int j = 0; j < 2; ++j) { const u32x4 r = raw[q][j];
                    const f32x4 x0 = {__uint_as_float(r.x << 16), __uint_as_float(r.x & 0xffff0000u), __uint_as_float(r.y << 16), __uint_as_float(r.y & 0xffff0000u)};
                    const f32x4 x1 = {__uint_as_float(r.z << 16), __uint_as_float(r.z & 0xffff0000u), __uint_as_float(r.w << 16), __uint_as_float(r.w & 0xffff0000u)};
                    const f32x4 h0 = x0 * rstd * Gv[j][0] + Sv[j][0], h1 = x1 * rstd * Gv[j][1] + Sv[j][1];
                    if (FINAL) { float* yp = Y + (size_t)row * DM + 8 * lane + 512 * j; *(f32x4*)yp = h0; *(f32x4*)(yp + 4) = h1; }
                    else { u32x4 w; w.x = pk2(h0[0], h0[1]); w.y = pk2(h0[2], h0[3]); w.z = pk2(h1[0], h1[1]); w.w = pk2(h1[2], h1[3]);
                        *(u32x4*)(H + (size_t)row * DM + 8 * lane + 512 * j) = w; }
                }
            }
        }
    }
}

constexpr int KS_LD = 72, VT_LD = 264;
constexpr int ATT_KS = 0, ATT_VT = 256 * KS_LD * 2, ATT_TB = ATT_VT + 64 * VT_LD * 2;
DI void attn_unit(LAS unsigned char* lds, const bf16_t* Z, bf16_t* MIX, const float* TB, const float* sinks_l, int b, int n, int kvh, int tid) {
    asm volatile("" : "+v"(tid));
    const int lane = tid & 63, wid = tid >> 6, r = lane & 31, hh = lane >> 5;
    LAS bf16_t* Ks = (LAS bf16_t*)(lds + ATT_KS); LAS bf16_t* Vt = (LAS bf16_t*)(lds + ATT_VT); LAS float* tb = (LAS float*)(lds + ATT_TB);
    const int base = b * SEQ + n * 128;
#pragma unroll
    for (int i = 0; i < 4; ++i) {
        const int c = tid + 512 * i, key = c >> 3, part = c & 7;
        u32x4 kv = {0u, 0u, 0u, 0u}, vv = {0u, 0u, 0u, 0u};
        if (n > 0 || key >= 128) { const bf16_t* zr = Z + (size_t)(base - 128 + key) * INW + kvh * 64 + part * 8; kv = *(const u32x4*)(zr + 512); vv = *(const u32x4*)(zr + 640); }
        *(LAS u32x4*)(Ks + key * KS_LD + part * 8) = kv;
        LAS bf16_t* vd = Vt + (part * 8) * VT_LD + (key ^ (part << 2));
        vd[0 * VT_LD] = (bf16_t)(vv.x & 0xffffu); vd[1 * VT_LD] = (bf16_t)(vv.x >> 16); vd[2 * VT_LD] = (bf16_t)(vv.y & 0xffffu); vd[3 * VT_LD] = (bf16_t)(vv.y >> 16);
        vd[4 * VT_LD] = (bf16_t)(vv.z & 0xffffu); vd[5 * VT_LD] = (bf16_t)(vv.z >> 16); vd[6 * VT_LD] = (bf16_t)(vv.w & 0xffffu); vd[7 * VT_LD] = (bf16_t)(vv.w >> 16);
    }
    for (int i = tid; i < 4 * TBLD; i += 512) tb[i] = TB[kvh * 4 * TBLD + i];
    const int hl = wid >> 1, h = kvh * 4 + hl;
    const float sink2 = sinks_l[h] * LOG2E;
    LAS const float* tbh = tb + hl * TBLD;
    bf16x8 qf[4];
    {   const bf16_t* qrow = Z + (size_t)(base + (wid & 1) * 64 + r) * INW + h * 64 + 8 * hh;
#pragma unroll
        for (int c = 0; c < 4; ++c) qf[c] = *(const bf16x8*)(qrow + 16 * c); }
    __syncthreads();
#pragma unroll 1
    for (int sub = 0; sub < 2; ++sub) {
        const int qoff = (wid & 1) * 64 + sub * 32, kt0 = qoff >> 5, q = qoff + r;
        f32x16 sc[5];
#pragma unroll
        for (int t = 0; t < 5; ++t) {
#pragma unroll
            for (int i = 0; i < 16; ++i) sc[t][i] = 0.f;
#pragma unroll
            for (int c = 0; c < 4; ++c) { const bf16x8 a = *(LAS const bf16x8*)(Ks + (32 * (kt0 + t) + r) * KS_LD + 16 * c + 8 * hh); sc[t] = MFMA32(a, qf[c], sc[t]); }
        }
        if (sub == 0) {
            const bf16_t* qrow = Z + (size_t)(base + q + 32) * INW + h * 64 + 8 * hh;
#pragma unroll
            for (int c = 0; c < 4; ++c) qf[c] = *(const bf16x8*)(qrow + 16 * c);
        }
        float m = -INFINITY;
        const int rel = r - 4 * hh;
#pragma unroll
        for (int t = 0; t < 5; ++t) {
            const bool dead = (n == 0) && (kt0 + t < 4);
#pragma unroll
            for (int i = 0; i < 16; ++i) {
                const int cc = (i & 3) + 8 * (i >> 2);
                const int dist = 128 - 32 * t + rel - cc;
                bool valid = !dead;
                if (t == 0) valid = valid && (dist <= 128);
                if (t == 4) valid = valid && (dist >= 0);
                const float bias = tbh[(t == 0 || t == 4) ? (valid ? dist : 0) : dist];
                const float val = valid ? sc[t][i] * C2 + bias : -INFINITY;
                sc[t][i] = val; m = fmaxf(m, val);
            }
        }
        m = fmaxf(m, __shfl_xor(m, 32)); m = fmaxf(m, sink2);
        float sum = 0.f;
#pragma unroll
        for (int t = 0; t < 5; ++t)
#pragma unroll
            for (int i = 0; i < 16; ++i) { const float p = __builtin_amdgcn_exp2f(sc[t][i] - m); sc[t][i] = p; sum += p; }
        sum += __shfl_xor(sum, 32); sum += __builtin_amdgcn_exp2f(sink2 - m);
        const float inv = 1.0f / sum;
        f32x16 o[2];
#pragma unroll
        for (int i = 0; i < 16; ++i) { o[0][i] = 0.f; o[1][i] = 0.f; }
#pragma unroll
        for (int t = 0; t < 5; ++t)
#pragma unroll
            for (int s = 0; s < 2; ++s) {
                u32x4 pw; pw.x = pk2(sc[t][8 * s + 0], sc[t][8 * s + 1]); pw.y = pk2(sc[t][8 * s + 2], sc[t][8 * s + 3]); pw.z = pk2(sc[t][8 * s + 4], sc[t][8 * s + 5]); pw.w = pk2(sc[t][8 * s + 6], sc[t][8 * s + 7]);
                const bf16x8 pb = __builtin_bit_cast(bf16x8, pw);
#pragma unroll
                for (int dt = 0; dt < 2; ++dt) {
                    const int dd = 32 * dt + r, sw = ((dd >> 3) & 7) << 2, ko = 32 * (kt0 + t) + 16 * s + 4 * hh;
                    LAS const bf16_t* vrow = Vt + dd * VT_LD;
                    const s16x4 lo = *(LAS const s16x4*)(vrow + (ko ^ sw)), hi = *(LAS const s16x4*)(vrow + ((ko + 8) ^ sw));
                    const bf16x8 a = __builtin_shufflevector(lo, hi, 0, 1, 2, 3, 4, 5, 6, 7);
                    o[dt] = MFMA32(a, pb, o[dt]);
                }
            }
        bf16_t* orow = MIX + (size_t)(base + q) * DM + h * 64 + 4 * hh;
#pragma unroll
        for (int dt = 0; dt < 2; ++dt)
#pragma unroll
            for (int g4 = 0; g4 < 4; ++g4) { u32x2 w; w.x = pk2(o[dt][4 * g4 + 0] * inv, o[dt][4 * g4 + 1] * inv); w.y = pk2(o[dt][4 * g4 + 2] * inv, o[dt][4 * g4 + 3] * inv);
                *(u32x2*)(orow + 32 * dt + 8 * g4) = w; }
    }
    __syncthreads();
}

DI void sattn_task(LAS float* wl, const bf16_t* Z, const float* ck, const float* cv, bf16_t* MIX, const float* TB, const float* sinks_l, int s, int kvh, int lane) {
    asm volatile("" : "+v"(lane));
    const bf16_t* zrow = Z + (size_t)(TP + s) * INW;
#pragma unroll
    for (int hl = 0; hl < 4; ++hl) wl[hl * 64 + lane] = bf2f(zrow[(kvh * 4 + hl) * 64 + lane]) * C2;
    const float kn = bf2f(zrow[512 + kvh * 64 + lane]);
    asm volatile("s_waitcnt lgkmcnt(0)" ::: "memory");
    float sc[4][2];
#pragma unroll
    for (int kk = 0; kk < 2; ++kk) {
        const int j = lane + 64 * kk;
        const float* krow = ck + ((size_t)(s * 128 + j) * 2 + kvh) * 64;
        float a[4] = {0.f, 0.f, 0.f, 0.f};
#pragma unroll 8
        for (int d4 = 0; d4 < 16; ++d4) { const f32x4 kv = *(const f32x4*)(krow + 4 * d4);
#pragma unroll
            for (int hl = 0; hl < 4; ++hl) { const f32x4 qv = *(LAS const f32x4*)(wl + hl * 64 + 4 * d4); a[hl] += (kv.x * qv.x + kv.y * qv.y) + (kv.z * qv.z + kv.w * qv.w); } }
#pragma unroll
        for (int hl = 0; hl < 4; ++hl) sc[hl][kk] = a[hl] + TB[(kvh * 4 + hl) * TBLD + (128 - j)];
    }
    float pn[4];
#pragma unroll
    for (int hl = 0; hl < 4; ++hl) {
        const float sink2 = sinks_l[kvh * 4 + hl] * LOG2E;
        const float snew = wave_sum(kn * wl[hl * 64 + lane]) + TB[(kvh * 4 + hl) * TBLD + 0];
        float m = wave_max(fmaxf(sc[hl][0], sc[hl][1])); m = fmaxf(m, fmaxf(snew, sink2));
        const float p0 = __builtin_amdgcn_exp2f(sc[hl][0] - m), p1 = __builtin_amdgcn_exp2f(sc[hl][1] - m), pnw = __builtin_amdgcn_exp2f(snew - m);
        const float sum = wave_sum(p0 + p1) + pnw + __builtin_amdgcn_exp2f(sink2 - m);
        const float inv = 1.0f / sum;
        wl[256 + hl * TBLD + lane] = p0 * inv; wl[256 + hl * TBLD + 64 + lane] = p1 * inv; pn[hl] = pnw * inv;
    }
    asm volatile("s_waitcnt lgkmcnt(0)" ::: "memory");
    const int jg = lane >> 4, d4 = lane & 15;
    f32x4 o[4];
#pragma unroll
    for (int hl = 0; hl < 4; ++hl) o[hl] = (f32x4){0.f, 0.f, 0.f, 0.f};
    const float* vb = cv + ((size_t)(s * 128 + jg) * 2 + kvh) * 64 + 4 * d4;
#pragma unroll 8
    for (int i = 0; i < 32; ++i) { const f32x4 vv = *(const f32x4*)(vb + (size_t)i * 512);
#pragma unroll
        for (int hl = 0; hl < 4; ++hl) o[hl] += vv * wl[256 + hl * TBLD + 4 * i + jg]; }
    const f32x4 vn4 = bf4_to_f4(zrow + 640 + kvh * 64 + 4 * d4);
#pragma unroll
    for (int hl = 0; hl < 4; ++hl) {
#pragma unroll
        for (int e = 0; e < 4; ++e) { float v = o[hl][e]; v += __shfl_xor(v, 16); v += __shfl_xor(v, 32); o[hl][e] = v + pn[hl] * vn4[e]; }
        if (jg == 0) { u32x2 w; w.x = pk2(o[hl][0], o[hl][1]); w.y = pk2(o[hl][2], o[hl][3]); *(u32x2*)(MIX + (size_t)(TP + s) * DM + (kvh * 4 + hl) * 64 + 4 * d4) = w; }
    }
    asm volatile("s_waitcnt lgkmcnt(0)" ::: "memory");
}

constexpr int PU_LD = 136;
constexpr int POOL_U = 0, POOL_P = 144 * PU_LD * 2, POOL_O = POOL_P + 128 * PU_LD * 2;
DI void pool_unit(LAS unsigned char* lds, const bf16_t* Z, const bf16_t* PWT, const float* pscale_l, bf16_t* MIX, int ub, int tid) {
    asm volatile("" : "+v"(tid));
    const int lane = tid & 63, wid = tid >> 6, r = lane & 31, hh = lane >> 5;
    LAS bf16_t* Ug = (LAS bf16_t*)(lds + POOL_U); LAS bf16_t* Pg = (LAS bf16_t*)(lds + POOL_P); LAS bf16_t* Og = (LAS bf16_t*)(lds + POOL_O);
    const int b = ub >> 5, n = ub & 31;
    const bf16_t* zb = Z + (size_t)(b * SEQ + n * 128 - 15) * INW + 768;
    bf16_t* ob = MIX + (size_t)(b * SEQ + n * 128) * DM + 512;
    u32x4 ureg[5];
#define POOL_LOADU(gg) do { _Pragma("unroll") for (int i_ = 0; i_ < 5; ++i_) { const int c_ = tid + 512 * i_, row_ = c_ >> 4, part_ = c_ & 15; \
        u32x4 v_ = {0u, 0u, 0u, 0u}; if (c_ < 143 * 16 && n * 128 - 15 + row_ >= 0) v_ = *(const u32x4*)(zb + (size_t)row_ * INW + (gg) * 128 + part_ * 8); ureg[i_] = v_; } } while (0)
    POOL_LOADU(0);
    const int mt = wid >> 1, nt0 = (wid & 1) * 2;
#pragma unroll 1
    for (int g = 0; g < 4; ++g) {
        const int w = 2 << g;
        bf16x8 bfr[8][2];
#pragma unroll
        for (int ks = 0; ks < 8; ++ks)
#pragma unroll
            for (int qq = 0; qq < 2; ++qq) bfr[ks][qq] = *(const bf16x8*)(PWT + (size_t)g * 16384 + (32 * (nt0 + qq) + r) * 128 + 16 * ks + 8 * hh);
#pragma unroll
        for (int i = 0; i < 5; ++i) { const int c = tid + 512 * i; if (c < 143 * 16) *(LAS u32x4*)(Ug + (c >> 4) * PU_LD + (c & 15) * 8) = ureg[i]; }
        __syncthreads();
        if (g < 3) POOL_LOADU(g + 1);
        {   const int c2 = tid & 63, t0 = wid * 16;
            float a0 = 0.f, a1 = 0.f;
            for (int s = 0; s < w; ++s) { const unsigned uv = *(LAS const unsigned*)(Ug + (t0 + 15 - s) * PU_LD + 2 * c2); a0 += __uint_as_float(uv << 16); a1 += __uint_as_float(uv & 0xffff0000u); }
            for (int t = t0; t < t0 + 16; ++t) {
                const unsigned uv = *(LAS const unsigned*)(Ug + (t + 15) * PU_LD + 2 * c2);
                const float u0 = __uint_as_float(uv << 16), u1 = __uint_as_float(uv & 0xffff0000u);
                const int pos1 = n * 128 + t + 1; const float ic = 1.0f / (float)(pos1 < w ? pos1 : w);
                *(LAS unsigned*)(Pg + t * PU_LD + 2 * c2) = pk2(a0 * ic - u0, a1 * ic - u1);
                if (t + 1 < t0 + 16) {
                    const unsigned ua = *(LAS const unsigned*)(Ug + (t + 16) * PU_LD + 2 * c2), ud = *(LAS const unsigned*)(Ug + (t + 16 - w) * PU_LD + 2 * c2);
                    a0 += __uint_as_float(ua << 16) - __uint_as_float(ud << 16); a1 += __uint_as_float(ua & 0xffff0000u) - __uint_as_float(ud & 0xffff0000u);
                }
            }
        }
        __syncthreads();
        {   f32x16 acc[2];
#pragma unroll
            for (int i = 0; i < 16; ++i) { acc[0][i] = 0.f; acc[1][i] = 0.f; }
#pragma unroll
            for (int ks = 0; ks < 8; ++ks) {
                const bf16x8 a = *(LAS const bf16x8*)(Pg + (32 * mt + r) * PU_LD + 16 * ks + 8 * hh);
#pragma unroll
                for (int qq = 0; qq < 2; ++qq) acc[qq] = MFMA32(a, bfr[ks][qq], acc[qq]);
            }
#pragma unroll
            for (int qq = 0; qq < 2; ++qq) { const int cl = 32 * (nt0 + qq) + r; const float ps = pscale_l[g * 128 + cl];
#pragma unroll
                for (int i = 0; i < 16; ++i) Og[(32 * mt + crow(i, hh)) * PU_LD + cl] = (bf16_t)(pk2(acc[qq][i] * ps, 0.f) & 0xffffu); }
        }
        __syncthreads();
#pragma unroll
        for (int i = 0; i < 4; ++i) { const int c = tid + 512 * i, row = c >> 4, part = c & 15;
            *(u32x4*)(ob + (size_t)row * DM + g * 128 + part * 8) = *(LAS const u32x4*)(Og + row * PU_LD + part * 8); }
    }
#undef POOL_LOADU
}
DI void pool_unit_sample(LAS unsigned char* lds, const bf16_t* Z, const float* sp_l, const bf16_t* PWT, const float* pscale_l, bf16_t* MIX, int k, int tid) {
    asm volatile("" : "+v"(tid));
    const int lane = tid & 63, wid = tid >> 6, r = lane & 31, hh = lane >> 5;
    LAS bf16_t* Pg = (LAS bf16_t*)(lds + POOL_P);
    const int g = k >> 2, s0 = (k & 3) * 32, w = 2 << g;
    for (int idx = tid; idx < 32 * 64; idx += 512) { const int sl = idx >> 6, c2 = idx & 63, s = s0 + sl;
        const unsigned uv = *(const unsigned*)(Z + (size_t)(TP + s) * INW + 768 + g * 128 + 2 * c2);
        const float u0 = __uint_as_float(uv << 16), u1 = __uint_as_float(uv & 0xffff0000u);
        float a0 = u0, a1 = u1;
#pragma unroll
        for (int i = 0; i < 15; ++i) { if (i >= 16 - w) { const f32x2 sv = *(const f32x2*)(sp_l + ((size_t)s * 15 + i) * 512 + g * 128 + 2 * c2); a0 += sv.x; a1 += sv.y; } }
        const float ic = 1.0f / (float)w;
        *(LAS unsigned*)(Pg + sl * PU_LD + 2 * c2) = pk2(a0 * ic - u0, a1 * ic - u1); }
    __syncthreads();
    if (wid < 2) {
        f32x16 acc[2];
#pragma unroll
        for (int i = 0; i < 16; ++i) { acc[0][i] = 0.f; acc[1][i] = 0.f; }
#pragma unroll
        for (int ks = 0; ks < 8; ++ks) {
            const bf16x8 a = *(LAS const bf16x8*)(Pg + r * PU_LD + 16 * ks + 8 * hh);
#pragma unroll
            for (int qq = 0; qq < 2; ++qq) { const bf16x8 bb = *(const bf16x8*)(PWT + (size_t)g * 16384 + (32 * (wid * 2 + qq) + r) * 128 + 16 * ks + 8 * hh); acc[qq] = MFMA32(a, bb, acc[qq]); }
        }
#pragma unroll
        for (int qq = 0; qq < 2; ++qq) { const int col = g * 128 + 32 * (wid * 2 + qq) + r; const float ps = pscale_l[col];
#pragma unroll
            for (int i = 0; i < 16; ++i) MIX[(size_t)(TP + s0 + crow(i, hh)) * DM + 512 + col] = (bf16_t)(pk2(acc[qq][i] * ps, 0.f) & 0xffffu); }
    }
    __syncthreads();
}

DI void states_copy(KP P, const bf16_t* Z, int l, int gtid, int GT) {
    float* out = P->out;
    for (int idx = gtid; idx < 8 * 128 * 32; idx += GT) { const int c4 = idx & 31, j = (idx >> 5) & 127, b = idx >> 12;
        const bf16_t* zr = Z + (size_t)(b * SEQ + SEQ - 128 + j) * INW + c4 * 4;
        *(f32x4*)(out + O_KP + ((size_t)(l * 8 + b) * 128 + j) * 128 + c4 * 4) = bf4_to_f4(zr + 512);
        *(f32x4*)(out + O_VP + ((size_t)(l * 8 + b) * 128 + j) * 128 + c4 * 4) = bf4_to_f4(zr + 640); }
    for (int idx = gtid; idx < 8 * 15 * 128; idx += GT) { const int c4 = idx & 127, bi = idx >> 7, i = bi % 15, b = bi / 15;
        *(f32x4*)(out + O_PP + ((size_t)(l * 8 + b) * 15 + i) * 512 + c4 * 4) = bf4_to_f4(Z + (size_t)(b * SEQ + SEQ - 15 + i) * INW + 768 + c4 * 4); }
    for (int idx = gtid; idx < 128 * 32; idx += GT) { const int c4 = idx & 31, s = idx >> 5;
        const bf16_t* zr = Z + (size_t)(TP + s) * INW + c4 * 4;
        *(f32x4*)(out + O_KS + ((size_t)(l * 128 + s) * 128 + 127) * 128 + c4 * 4) = bf4_to_f4(zr + 512);
        *(f32x4*)(out + O_VS + ((size_t)(l * 128 + s) * 128 + 127) * 128 + c4 * 4) = bf4_to_f4(zr + 640); }
    for (int idx = gtid; idx < 128 * 128; idx += GT) { const int c4 = idx & 127, s = idx >> 7;
        *(f32x4*)(out + O_PS + ((size_t)(l * 128 + s) * 15 + 14) * 512 + c4 * 4) = bf4_to_f4(Z + (size_t)(TP + s) * INW + 768 + c4 * 4); }
}
DI void states_shift(KP P, int t, int NT) {
    float* out = P->out; const float* ck = P->in[4]; const float* cv = P->in[5]; const float* sp = P->in[6];
#pragma unroll 4
    for (int idx = t; idx < 256 * 127 * 32; idx += NT) { const int ls = idx / (127 * 32), r = idx - ls * (127 * 32);
        const size_t so = (size_t)ls * 16384 + 128 + (size_t)r * 4, dd = (size_t)ls * 16384 + (size_t)r * 4;
        const f32x4 a = *(const f32x4*)(ck + so), b = *(const f32x4*)(cv + so);
        *(f32x4*)(out + O_KS + dd) = a; *(f32x4*)(out + O_VS + dd) = b; }
#pragma unroll 4
    for (int idx = t; idx < 256 * 14 * 128; idx += NT) { const int ls = idx / (14 * 128), r = idx - ls * (14 * 128);
        *(f32x4*)(out + O_PS + (size_t)ls * 7680 + (size_t)r * 4) = *(const f32x4*)(sp + (size_t)ls * 7680 + 512 + (size_t)r * 4); }
}

#define XB_TMO      128
#define XB_XCNT(j)  (256  + 64 * (j))
#define XB_XSUB(j)  (1280 + 64 * (j))
#define XB_XGEN(j)  (2304 + 64 * (j))
#define XB_TOP      3328
#define XB_TOPGEN   3392
#define XCD_BAR_WORDS 3456
#define XB_SPIN_CAP (1u << 18)

__device__ __forceinline__ unsigned xb_ld(unsigned* p)              { return __hip_atomic_load(p, __ATOMIC_RELAXED, __HIP_MEMORY_SCOPE_AGENT); }
__device__ __forceinline__ unsigned xb_add(unsigned* p, unsigned v) { return __hip_atomic_fetch_add(p, v, __ATOMIC_RELAXED, __HIP_MEMORY_SCOPE_AGENT); }
__device__ __forceinline__ unsigned xb_xcc_id() { return (unsigned)__builtin_amdgcn_s_getreg((3 << 11) | 20) & 0xFu; }
#define XB_SPIN(cond, bar) do { unsigned _sp = 0; while (cond) { __builtin_amdgcn_s_sleep(1); \
    if ((++_sp & 255u) == 0u) { if (xb_ld(&(bar)[XB_TMO])) break; if (_sp > XB_SPIN_CAP) { atomicAdd(&(bar)[XB_TMO], 1u); break; } } } } while (0)

struct XcdBarrier {
    unsigned* bar; unsigned x;
    volatile LAS unsigned* st;
};

__device__ __forceinline__ XcdBarrier xcd_barrier_post(unsigned* bar, volatile LAS unsigned* st) {
    XcdBarrier b; b.bar = bar; b.x = xb_xcc_id(); b.st = st;
    if (threadIdx.x == 0) (void)xb_add(&bar[XB_XCNT(b.x)], 1u);
    return b;
}
__device__ __forceinline__ void xcd_barrier_complete(unsigned* bar, unsigned x, unsigned& nloc, unsigned& nx) {
    const unsigned G = gridDim.x * gridDim.y * gridDim.z;
    unsigned sum, cnt, mine, sp = 0u;
    for (;;) {
        sum = 0u; cnt = 0u; mine = 0u;
#pragma unroll
        for (unsigned j = 0; j < 16; ++j) { const unsigned c = xb_ld(&bar[XB_XCNT(j)]); sum += c; cnt += (c > 0u) ? 1u : 0u; mine = (j == x) ? c : mine; }
        if (sum == G) break;
        __builtin_amdgcn_s_sleep(1);
        if ((++sp & 255u) == 0u) { if (xb_ld(&bar[XB_TMO])) break; if (sp > XB_SPIN_CAP) { atomicAdd(&bar[XB_TMO], 1u); break; } }
    }
    nloc = mine > 0u ? mine : 1u; nx = cnt > 0u ? cnt : 1u;
}

__device__ __forceinline__ void xcd_barrier(const XcdBarrier& b) {
    asm volatile("s_waitcnt vmcnt(0)" ::: "memory");
    __syncthreads();
    if (threadIdx.x == 0) {
        unsigned* bar = b.bar;
        __builtin_amdgcn_s_waitcnt(0);
        unsigned nloc = b.st[0], nx = b.st[1];
        if (nloc == 0u) { xcd_barrier_complete(bar, b.x, nloc, nx); b.st[0] = nloc; b.st[1] = nx; }
        const unsigned old = xb_add(&bar[XB_XSUB(b.x)], 1u);
        const unsigned gen = old / nloc;
        if (old + 1u == (gen + 1u) * nloc) {
            __builtin_amdgcn_fence(__ATOMIC_RELEASE, "agent");
            asm volatile("s_waitcnt vmcnt(0)" ::: "memory");
            const unsigned og = xb_add(&bar[XB_TOP], 1u);
            const unsigned tg = og / nx;
            if (og + 1u == (tg + 1u) * nx) xb_add(&bar[XB_TOPGEN], 1u);
            else XB_SPIN(xb_ld(&bar[XB_TOPGEN]) == tg, bar);
            __builtin_amdgcn_fence(__ATOMIC_ACQUIRE, "agent");
            xb_add(&bar[XB_XGEN(b.x)], 1u);
            asm volatile("s_waitcnt vmcnt(0)" ::: "memory");
        } else {
            XB_SPIN(xb_ld(&bar[XB_XGEN(b.x)]) == gen, bar);
            __builtin_amdgcn_fence(__ATOMIC_ACQUIRE, "agent");
            asm volatile("s_waitcnt vmcnt(0)" ::: "memory");
        }
    }
    __syncthreads();
}
DI KP kargs() { unsigned long long v = (unsigned long long)__builtin_amdgcn_kernarg_segment_ptr(); asm volatile("" : "+s"(v)); return (KP)v; }
#define PH_VARS KP Pk = kargs(); int tid = threadIdx.x; asm volatile("" : "+v"(tid)); const int lane = tid & 63, wid = __builtin_amdgcn_readfirstlane(tid >> 6); \
    const int G = gridDim.x, bx = blockIdx.x; const int gw = bx * 8 + wid, NGW = G * 8, gtid = bx * 512 + tid, GT = G * 512; unsigned char* ws = Pk->ws; (void)lane; (void)gw; (void)NGW; (void)gtid; (void)GT; (void)ws;
__global__ void __launch_bounds__(512, 2) fwd(Params Pdummy) {
    extern __shared__ __attribute__((aligned(16))) unsigned char lds_g[];
    LAS unsigned char* lds = (LAS unsigned char*)lds_g;
    cg::grid_group grid = cg::this_grid();
    int lo, hi; unsigned* barw; { KP Pk = kargs(); lo = Pk->ph_lo; hi = Pk->ph_hi; barw = (unsigned*)(Pk->ws + WS_BAR); }
    if (hi > 1000) grid.sync();
    if (threadIdx.x < 2) ((volatile LAS unsigned*)(lds + 131072))[threadIdx.x] = 0u;
    __syncthreads();
    XcdBarrier xb; xb.bar = barw; xb.x = 0; xb.st = nullptr;
    if (hi - lo > 1) xb = xcd_barrier_post(barw, (volatile LAS unsigned*)(lds + 131072));
#ifndef PROBE_REP
#define PROBE_REP -1
#endif
#ifndef PROBE_N
#define PROBE_N 0
#endif
#ifndef PROBE_MIX
#define PROBE_MIX 0
#endif
#ifndef STAG_TICKS
#define STAG_TICKS 0
#endif
#define STAGGER() do { if (STAG_TICKS > 0) { const unsigned long long t0_ = __builtin_amdgcn_s_memrealtime(); const unsigned long long d_ = (unsigned long long)((bx >> 3) & 3) * STAG_TICKS; while (__builtin_amdgcn_s_memrealtime() - t0_ < d_) __builtin_amdgcn_s_sleep(8); } } while (0)
#ifndef PROBE_SYNC
#define PROBE_SYNC 0
#endif
#define REPS(k) for (int rep_ = 0; rep_ < ((k) == PROBE_REP ? 1 + PROBE_N : 1); ++rep_)
#define IN(k) (lo <= (k) && (k) < hi)
#define SEAM(k) do { if (IN(k) && IN((k) + 1)) xcd_barrier(xb); } while (0)
    const bool merged = IN(0) && IN(1) && (int)gridDim.x > MODLD / 256;
    if (IN(0)) { PH_VARS
        prologue(Pk, lds, gw, NGW, gtid, GT, wid, lane);
        if (merged) {
            unsigned* flag = (unsigned*)(ws + WS_BAR) + 3840;
            asm volatile("s_waitcnt vmcnt(0)" ::: "memory"); __syncthreads();
            if (tid == 0) { __builtin_amdgcn_fence(__ATOMIC_RELEASE, "agent"); asm volatile("s_waitcnt vmcnt(0)" ::: "memory"); __hip_atomic_fetch_add(flag, 1u, __ATOMIC_RELAXED, __HIP_MEMORY_SCOPE_AGENT); }
            if (bx < MODLD / 256) {
                if (wid == 0) { unsigned sp = 0;
                    while ((unsigned)__builtin_amdgcn_readfirstlane(__hip_atomic_load(flag, __ATOMIC_RELAXED, __HIP_MEMORY_SCOPE_AGENT)) < (unsigned)G) { __builtin_amdgcn_s_sleep(2); if (++sp > (1u << 22)) break; }
                    __builtin_amdgcn_fence(__ATOMIC_ACQUIRE, "agent"); asm volatile("s_waitcnt vmcnt(0)" ::: "memory"); }
                __syncthreads();
                pg8::Gemm g{(const bf16_t*)(ws + WS_CS), (const bf16_t*)(ws + WS_WADA), 256, MODLD, DM}; pg8::StaticOrder S; S.init(256, MODLD, G, bx);
                EpiMod E{(float*)(ws + WS_MOD), Pk->in[8]};
                pg8::gemm_phase<EpiMod, pg8::StaticOrder, PG8_ALIGN, PG8_SP2>(lds, g, S, E, tid);
            } else {
                prologue_rest(Pk, lds, (bx - MODLD / 256) * 8 + wid, (G - MODLD / 256) * 8, wid, lane);
            }
        } else prologue_rest(Pk, lds, gw, NGW, wid, lane);
    }
    SEAM(0);
    for (int i_ = 0; i_ < PROBE_SYNC; ++i_) xcd_barrier(xb);
    if (IN(1) && !merged) { PH_VARS
        pg8::Gemm g{(const bf16_t*)(ws + WS_CS), (const bf16_t*)(ws + WS_WADA), 256, MODLD, DM}; pg8::StaticOrder S; S.init(256, MODLD, G, bx);
        EpiMod E{(float*)(ws + WS_MOD), Pk->in[8]};
        pg8::gemm_phase<EpiMod, pg8::StaticOrder, PG8_ALIGN, PG8_SP2>(lds, g, S, E, tid);
        states_shift(Pk, gtid, GT);
    }
    if (!merged) SEAM(1);
#pragma unroll 1
    for (int l = 0; l < 2; ++l) {
        const int pb = 2 + 10 * l;
#define LAYER_VARS unsigned char* wl = ws + WS_L0 + (size_t)l * LAYER_BYTES; bf16_t* XB = (bf16_t*)(ws + WS_X); float* XS = (float*)(ws + WS_XS); float* XSv = XS - (size_t)TP * DM; float* PART = (float*)(ws + WS_WADA); bf16_t* H = (bf16_t*)(ws + WS_H); bf16_t* ACT = (bf16_t*)(ws + WS_ACT); bf16_t* Z = (bf16_t*)(ws + WS_Z); bf16_t* MIX = (bf16_t*)(ws + WS_MIX); \
        const float* modl = (const float*)(ws + WS_MOD) + (size_t)l * NMOD; const float* gain_l = Pk->in[9] + (size_t)l * 3 * DM; \
        (void)wl; (void)XB; (void)XS; (void)XSv; (void)PART; (void)H; (void)ACT; (void)Z; (void)MIX; (void)modl; (void)gain_l;
        if (IN(pb + 0)) REPS(pb + 0) { PH_VARS LAYER_VARS
            if (l == 0) { norm_phase<false>(Pk->in[0], nullptr, gain_l, modl, H, nullptr, gw, NGW, lane, nullptr, 0, TP / 16); norm_sample<false>(Pk->in[1], gain_l, modl, H, nullptr, gw, NGW, lane, XSv, nullptr, 0); }
            else { norm_phase_bf<false>(XB, gain_l, modl, H, nullptr, gw, NGW, lane); norm_sample<false>(XS, gain_l, modl, H, nullptr, gw, NGW, lane, XSv, PART, FF / 256); } }
        SEAM(pb + 0);
        if (IN(pb + 1)) REPS(pb + 1) { PH_VARS LAYER_VARS
            pg8::Gemm g{H, (const bf16_t*)(wl + LW_GU1), MPAD, 2 * FF, DM}; TailOrder S; S.init(2 * FF, G, bx);
            EpiSwiGLU E{ACT};
            pg8::gemm_phase<EpiSwiGLU, TailOrder, PG8_ALIGN, PG8_SP2>(lds, g, S, E, tid);
        }
        SEAM(pb + 1);
        if (IN(pb + 2)) REPS(pb + 2) { PH_VARS LAYER_VARS
            pg8::Gemm g{ACT, (const bf16_t*)(wl + LW_D1), MPAD, DM, FF}; SplitOrder S; S.init(DM, FF, G, bx);
            EpiResid E{l == 0 ? Pk->in[0] : nullptr, XB, PART, modl + 2 * DM, 0.5f};
            STAGGER(); pg8::gemm_phase<EpiResid, SplitOrder, PG8_ALIGN, PG8_SP2>(lds, g, S, E, tid);
        }
        SEAM(pb + 2);
        if (IN(pb + 3)) REPS(pb + 3) { PH_VARS LAYER_VARS norm_phase_bf<false>(XB, gain_l + DM, modl + 3 * DM, H, nullptr, gw, NGW, lane); norm_sample<false>(XS, gain_l + DM, modl + 3 * DM, H, nullptr, gw, NGW, lane, XSv, PART, FF / 256); }
        SEAM(pb + 3);
        if (IN(pb + 4)) REPS(pb + 4) { PH_VARS LAYER_VARS
            pg8::Gemm g{H, (const bf16_t*)(wl + LW_IN), MPAD, INW, DM}; TailOrder S; S.init(INW, G, bx);
            EpiStoreBf16 E{Z, INW};
            pg8::gemm_phase<EpiStoreBf16, TailOrder, PG8_ALIGN, PG8_SP2>(lds, g, S, E, tid);
            if (l == 0 && merged) {
                constexpr int NB3 = (TP / 256 * (INW / 256) + INW / 256) - 512;
                if (G <= NB3 + 16) states_shift(Pk, gtid, GT); else if (bx >= NB3) states_shift(Pk, (bx - NB3) * 512 + tid, (G - NB3) * 512);
            }
        }
        SEAM(pb + 4);
        if (IN(pb + 5)) REPS(pb + 5) { PH_VARS LAYER_VARS
            const float* TB = (const float*)(ws + WS_TB);
            const float* sinks_l = Pk->in[12] + l * 8;
            const float* ck = Pk->in[4] + (size_t)l * 128 * 128 * 128; const float* cv = Pk->in[5] + (size_t)l * 128 * 128 * 128; const float* sp = Pk->in[6] + (size_t)l * 128 * 15 * 512;
            for (int id = bx; id < 816; id += G) {
                if (id < 512) { for (int rp = 0; rp < (PROBE_MIX == 1 ? 2 : 1); ++rp) { const int kvh = id & 1, bn = id >> 1; attn_unit(lds, Z, MIX, TB, sinks_l, bn >> 5, bn & 31, kvh, tid); } }
                else if (id < 784) { for (int rp = 0; rp < (PROBE_MIX == 2 ? 2 : 1); ++rp) { if (id < 768) pool_unit(lds, Z, (const bf16_t*)(wl + LW_POOL), Pk->in[15] + l * 512, MIX, id - 512, tid); else pool_unit_sample(lds, Z, sp, (const bf16_t*)(wl + LW_POOL), Pk->in[15] + l * 512, MIX, id - 768, tid); } }
                else { for (int rp = 0; rp < (PROBE_MIX == 3 ? 2 : 1); ++rp) { const int task = (id - 784) * 8 + wid; sattn_task((LAS float*)(lds + wid * 4096), Z, ck, cv, MIX, TB, sinks_l, task >> 1, task & 1, lane); __syncthreads(); } }
            }
            for (int rp = 0; rp < (PROBE_MIX == 4 ? 2 : 1); ++rp) states_copy(Pk, Z, l, gtid, GT);
        }
        SEAM(pb + 5);
        if (IN(pb + 6)) REPS(pb + 6) { PH_VARS LAYER_VARS
            pg8::Gemm g{MIX, (const bf16_t*)(wl + LW_OUT), MPAD, DM, DM}; SplitOrder S; S.init(DM, DM, G, bx);
            EpiResid E{nullptr, XB, PART, modl + 5 * DM, 1.0f};
            STAGGER(); pg8::gemm_phase<EpiResid, SplitOrder, PG8_ALIGN, PG8_SP2>(lds, g, S, E, tid);
        }
        SEAM(pb + 6);
        if (IN(pb + 7)) REPS(pb + 7) { PH_VARS LAYER_VARS norm_phase_bf<false>(XB, gain_l + 2 * DM, modl + 6 * DM, H, nullptr, gw, NGW, lane); norm_sample<false>(XS, gain_l + 2 * DM, modl + 6 * DM, H, nullptr, gw, NGW, lane, XSv, PART, DM / 256); }
        SEAM(pb + 7);
        if (IN(pb + 8)) REPS(pb + 8) { PH_VARS LAYER_VARS
            pg8::Gemm g{H, (const bf16_t*)(wl + LW_GU2), MPAD, 2 * FF, DM}; TailOrder S; S.init(2 * FF, G, bx);
            EpiSwiGLU E{ACT};
            pg8::gemm_phase<EpiSwiGLU, TailOrder, PG8_ALIGN, PG8_SP2>(lds, g, S, E, tid);
        }
        SEAM(pb + 8);
        if (IN(pb + 9)) REPS(pb + 9) { PH_VARS LAYER_VARS
            pg8::Gemm g{ACT, (const bf16_t*)(wl + LW_D2), MPAD, DM, FF}; SplitOrder S; S.init(DM, FF, G, bx);
            EpiResid E{nullptr, XB, PART, modl + 8 * DM, 0.5f};
            STAGGER(); pg8::gemm_phase<EpiResid, SplitOrder, PG8_ALIGN, PG8_SP2>(lds, g, S, E, tid);
        }
        SEAM(pb + 9);
    }
    if (IN(22)) REPS(22) { PH_VARS norm_phase_bf<true>((const bf16_t*)(ws + WS_X), Pk->in[22], nullptr, nullptr, Pk->out, gw, NGW, lane); norm_sample<true>((const float*)(ws + WS_XS), Pk->in[22], nullptr, nullptr, Pk->out, gw, NGW, lane, nullptr, (const float*)(ws + WS_WADA), FF / 256); }
#undef IN
#undef SEAM
}

extern "C" void kernel_launch(void* const* d_in, const int* in_sizes, int n_in, void* d_out, int out_size, void* d_ws, size_t ws_size, hipStream_t stream) {
    static int grid = 0;
    if (grid == 0) {
        if (n_in != 23 || (size_t)out_size != O_END || ws_size < WS_END) { fprintf(stderr, "kernel_launch: unexpected sizes n_in %d out %d ws %zu\n", n_in, out_size, ws_size); grid = -1; return; }
        int dev = 0, cus = 0, per_cu = 0;
        (void)hipGetDevice(&dev); (void)hipDeviceGetAttribute(&cus, hipDeviceAttributeMultiprocessorCount, dev);
        if (hipFuncSetAttribute((const void*)fwd, hipFuncAttributeMaxDynamicSharedMemorySize, LDS_BYTES) != hipSuccess) { fprintf(stderr, "kernel_launch: hipFuncSetAttribute failed\n"); grid = -1; return; }
        if (hipOccupancyMaxActiveBlocksPerMultiprocessor(&per_cu, (const void*)fwd, 512, LDS_BYTES) != hipSuccess || per_cu < 1) { fprintf(stderr, "kernel_launch: occupancy query says %d\n", per_cu); per_cu = 1; }
        (void)hipGetLastError();
        grid = cus * per_cu;
    }
    if (grid < 0) return;
    Params p{};
    for (int i = 0; i < 23; ++i) p.in[i] = (const float*)d_in[i];
    p.out = (float*)d_out; p.ws = (unsigned char*)d_ws;
#if N_LAUNCH_PER_PHASE
    for (int ph = 0; ph < NPH; ++ph) { p.ph_lo = ph; p.ph_hi = ph + 1; hipLaunchKernelGGL(fwd, dim3(grid), dim3(512), LDS_BYTES, stream, p); }
#else
    p.ph_lo = 0; p.ph_hi = NPH;
    if (hipMemsetAsync((char*)d_ws + WS_BAR, 0, WS_BAR_BYTES, stream) != hipSuccess) { fprintf(stderr, "kernel_launch: memset failed\n"); return; }
    void* args[] = {&p};
    hipError_t e = hipLaunchCooperativeKernel((const void*)fwd, dim3(grid), dim3(512), args, LDS_BYTES, stream);
    if (e != hipSuccess) fprintf(stderr, "kernel_launch: cooperative launch failed: %s (grid %d)\n", hipGetErrorString(e), grid);
#endif
}
```

```cpp
#define STAG_TICKS 0
#include <hip/hip_runtime.h>
#include <hip/hip_cooperative_groups.h>
#include <cstdio>
#include <cstdint>
namespace cg = cooperative_groups;
namespace pg8 {
#define PG8_LAS __attribute__((address_space(3)))
typedef unsigned short bf16_t;
typedef short bf16x8 __attribute__((ext_vector_type(8)));
typedef float f32x4 __attribute__((ext_vector_type(4)));
typedef unsigned u32x4 __attribute__((ext_vector_type(4)));
constexpr int BM = 256, BK = 64, HALF = 128, HTB = HALF * BK * 2  , STAGE_BYTES = 8 * HTB, NXCD = 8, WGM = 8;

__host__ __device__ __forceinline__ int lds_byte(int r, int c) { const int st = (r >> 4) * 2 + (c >> 5), rr = r & 15, cc = c & 31, ob = rr * 64 + cc * 2; return st * 1024 + (ob ^ (((ob >> 9) & 1) << 5)); }
__host__ __device__ __forceinline__ void stage_rc(int b, int& R, int& C) { const int st = b / 1024, sb = b % 1024, swz = sb ^ (((sb >> 9) & 1) << 5); R = (st >> 1) * 16 + swz / 64; C = (st & 1) * 32 + (swz % 64) / 2; }
__host__ __device__ __forceinline__ int perm32(int rho) { const int n = rho >> 4, i = rho & 15; return 8 * (i >> 2) + 4 * n + (i & 3); }

struct Unit { int pm, pn, k0; };
struct Gemm { const bf16_t* A; const bf16_t* Bt; int M, N, K; };

struct StaticOrder {
    static constexpr bool SPLIT = false;
    int nM, nN, nwg, G, c;
    __host__ __device__ void init(int M, int N, int G_, int c_, int K_ = 1024, int half_pm_ = -1) { nM = M / BM; nN = N / BM; nwg = nM * nN; G = G_; c = c_; (void)K_; (void)half_pm_; }
    __host__ __device__ bool next(int i, Unit& u) const {
        const long L = (long)i * G + c; if (L >= nwg) return false;
        int wgid = (int)L; { const int q = nwg / NXCD, r = nwg % NXCD, xcd = wgid % NXCD, off = wgid / NXCD; wgid = (xcd < r ? xcd * (q + 1) : r * (q + 1) + (xcd - r) * q) + off; }
        const int nig = WGM * nN, gid = wgid / nig, fm = gid * WGM, gsz = (nM - fm) < WGM ? (nM - fm) : WGM;
        u.pm = fm + ((wgid % nig) % gsz); u.pn = (wgid % nig) / gsz; u.k0 = 0; return true;
    }
    __device__ __forceinline__ void a_ready(const Unit&) const {}
    __device__ __forceinline__ void done(const Unit&) const {}
};

__device__ __forceinline__ unsigned cvt_pk_bf16(float lo, float hi) { unsigned r; asm volatile("v_cvt_pk_bf16_f32 %0, %1, %2" : "=v"(r) : "v"(lo), "v"(hi)); return r; }
typedef float f32x2 __attribute__((ext_vector_type(2)));
template <class Epi, class Sched, bool ALIGN_EPI = false, bool SP2 = false>
__device__ __forceinline__ void gemm_phase(PG8_LAS unsigned char* lds, const Gemm g, const Sched& S, const Epi& E, const int tid_in) {
    const int tid = tid_in, wid = __builtin_amdgcn_readfirstlane(tid >> 6), lane = tid & 63, wr = wid >> 2, wc = wid & 3, fr = lane & 15, fq = lane >> 4;
    const int K = g.K;
    unsigned voffA[2], voffB[2];
#pragma unroll
    for (int i = 0; i < 2; ++i) { int R, C; stage_rc(tid * 16 + i * 8192, R, C); const int Rb = Epi::PERM ? ((R & ~31) + perm32(R & 31)) : R;
        voffA[i] = (unsigned)(R * K + C) * 2u; voffB[i] = (unsigned)(Rb * K + C) * 2u; }
    const size_t kstep = (size_t)(BK * 2);
    const size_t hstep = (size_t)HALF * K * 2;
    const size_t tstep = 2 * hstep;
    const unsigned ldsw = (unsigned)wid * 1024u;
    const int aoff = lds_byte(wr * 64 + fr, fq * 8), boff = lds_byte(wc * 32 + fr, fq * 8);
#define PG8_SA(b, h) (((b) * 2 + (h)) * HTB)
#define PG8_SB(b, h) ((4 + (b) * 2 + (h)) * HTB)
#define PG8_STAGE(bufoff, gbase, voff) do { _Pragma("unroll") for (int _i = 0; _i < 2; ++_i) \
        __builtin_amdgcn_global_load_lds((const unsigned*)((const char*)(gbase) + (voff)[_i]), (PG8_LAS unsigned*)(lds + (bufoff) + ldsw + _i * 8192), 16, 0, 0); } while (0)
#define PG8_LDA(dst, b, h) do { _Pragma("unroll") for (int m = 0; m < 4; ++m) _Pragma("unroll") for (int k = 0; k < 2; ++k) dst[m][k] = *(const PG8_LAS bf16x8*)(lds + PG8_SA(b, h) + aoff + m * 2048 + k * 1024); } while (0)
#define PG8_LDB(dst, b, h) do { _Pragma("unroll") for (int n = 0; n < 2; ++n) _Pragma("unroll") for (int k = 0; k < 2; ++k) dst[n][k] = *(const PG8_LAS bf16x8*)(lds + PG8_SB(b, h) + boff + n * 2048 + k * 1024); } while (0)
#define PG8_MMA(ai, bj, At, Bt) do { __builtin_amdgcn_s_setprio(1); _Pragma("unroll") for (int m = 0; m < 4; ++m) _Pragma("unroll") for (int n = 0; n < 2; ++n) _Pragma("unroll") for (int k = 0; k < 2; ++k) \
        acc[ai][bj][m][n] = __builtin_amdgcn_mfma_f32_16x16x32_bf16(Bt[n][k], At[m][k], acc[ai][bj][m][n], 0, 0, 0); __builtin_amdgcn_s_setprio(0); } while (0)
#define PG8_WAIT_V(n) asm volatile("s_waitcnt vmcnt(" #n ")" ::: "memory")
#define PG8_WAIT_L(n) asm volatile("s_waitcnt lgkmcnt(" #n ")" ::: "memory")
#define PG8_BAR __builtin_amdgcn_s_barrier()
#define PG8_SCHED __builtin_amdgcn_sched_barrier(0)
    Unit cur, nxt; int ui = 0;
    if (!S.next(0, cur)) return;
    f32x4 acc[2][2][4][2];
#pragma unroll
    for (int a = 0; a < 2; ++a)
#pragma unroll
        for (int b = 0; b < 2; ++b)
#pragma unroll
            for (int m = 0; m < 4; ++m)
#pragma unroll
                for (int n = 0; n < 2; ++n) acc[a][b][m][n] = (f32x4){0.f, 0.f, 0.f, 0.f};
    bf16x8 At[4][2], B0[2][2], B1[2][2];
    const char* cA = (const char*)g.A + (size_t)cur.pm * tstep + (size_t)cur.k0 * kstep; const char* cB = (const char*)g.Bt + (size_t)cur.pn * tstep + (size_t)cur.k0 * kstep;
    S.a_ready(cur);
    if constexpr (SP2) {
        PG8_STAGE(PG8_SB(0, 0), cB, voffB); PG8_STAGE(PG8_SB(0, 1), cB + hstep, voffB); PG8_STAGE(PG8_SA(0, 0), cA, voffA); PG8_STAGE(PG8_SA(0, 1), cA + hstep, voffA);
        if (wr == 1) PG8_BAR;
        PG8_WAIT_V(2); PG8_BAR;
        PG8_STAGE(PG8_SB(1, 0), cB + kstep, voffB); PG8_STAGE(PG8_SA(1, 0), cA + kstep, voffA); PG8_STAGE(PG8_SB(1, 1), cB + hstep + kstep, voffB);
        PG8_WAIT_V(6); PG8_BAR;
    } else {
        PG8_STAGE(PG8_SB(0, 0), cB, voffB); PG8_STAGE(PG8_SA(0, 0), cA, voffA); PG8_STAGE(PG8_SB(0, 1), cB + hstep, voffB); PG8_STAGE(PG8_SA(0, 1), cA + hstep, voffA);
        if (wr == 1) PG8_BAR;
        PG8_WAIT_V(4); PG8_BAR;
        PG8_STAGE(PG8_SB(1, 0), cB + kstep, voffB); PG8_STAGE(PG8_SA(1, 0), cA + kstep, voffA); PG8_STAGE(PG8_SB(1, 1), cB + hstep + kstep, voffB);
        PG8_WAIT_V(6); PG8_BAR;
    }
    for (;;) {
        const bool has_next = S.next(ui + 1, nxt);
        const char* nA = has_next ? (const char*)g.A + (size_t)nxt.pm * tstep + (size_t)nxt.k0 * kstep : cA; const char* nB = has_next ? (const char*)g.Bt + (size_t)nxt.pn * tstep + (size_t)nxt.k0 * kstep : cB;
        const bool full = (cur.pm != 128); const int nt = (Sched::SPLIT && !full) ? 4 : K / BK;
        for (int t = 0; t < nt; t += 2) {
            const bool last = (t == nt - 2);
            const char* a1 = cA + (size_t)(t + 1) * kstep;
            const char* a2 = last ? nA : cA + (size_t)(t + 2) * kstep; const char* b2 = last ? nB : cB + (size_t)(t + 2) * kstep;
            const char* a3 = a2 + kstep; const char* b3 = b2 + kstep;
            if (last && has_next) S.a_ready(nxt);
            if constexpr (SP2) {
            PG8_LDB(B0, 0, 0); PG8_LDB(B1, 0, 1); PG8_SCHED; PG8_LDA(At, 0, 0); PG8_STAGE(PG8_SA(1, 1), a1 + hstep, voffA);
            PG8_WAIT_V(8); PG8_WAIT_L(0); PG8_BAR; PG8_MMA(0, 0, At, B0); PG8_MMA(0, 1, At, B1); PG8_BAR; PG8_SCHED;
            PG8_LDA(At, 0, 1); PG8_STAGE(PG8_SB(0, 0), b2, voffB); PG8_STAGE(PG8_SB(0, 1), b2 + hstep, voffB); PG8_STAGE(PG8_SA(0, 0), a2, voffA);
            PG8_WAIT_V(8); PG8_WAIT_L(0); PG8_BAR; if (full) { PG8_MMA(1, 0, At, B0); PG8_MMA(1, 1, At, B1); } PG8_BAR; PG8_SCHED;
            PG8_LDB(B0, 1, 0); PG8_LDB(B1, 1, 1); PG8_SCHED; PG8_LDA(At, 1, 0); PG8_STAGE(PG8_SA(0, 1), a2 + hstep, voffA);
            PG8_WAIT_V(8); PG8_WAIT_L(0); PG8_BAR; PG8_MMA(0, 0, At, B0); PG8_MMA(0, 1, At, B1); PG8_BAR; PG8_SCHED;
            PG8_LDA(At, 1, 1); PG8_STAGE(PG8_SB(1, 0), b3, voffB); PG8_STAGE(PG8_SB(1, 1), b3 + hstep, voffB); PG8_STAGE(PG8_SA(1, 0), a3, voffA);
            PG8_WAIT_V(8); PG8_WAIT_L(0); PG8_BAR; if (full) { PG8_MMA(1, 0, At, B0); PG8_MMA(1, 1, At, B1); } PG8_BAR; PG8_SCHED;
            } else {
            PG8_LDB(B0, 0, 0); PG8_SCHED; PG8_LDA(At, 0, 0); PG8_STAGE(PG8_SA(1, 1), a1 + hstep, voffA);
            PG8_WAIT_L(8); PG8_BAR; PG8_WAIT_L(0); PG8_MMA(0, 0, At, B0); PG8_BAR; PG8_SCHED;
            PG8_LDB(B1, 0, 1); PG8_STAGE(PG8_SB(0, 0), b2, voffB);
            PG8_BAR; PG8_WAIT_L(0); PG8_MMA(0, 1, At, B1); PG8_BAR;
            PG8_LDA(At, 0, 1); PG8_STAGE(PG8_SA(0, 0), a2, voffA);
            PG8_BAR; PG8_WAIT_L(0); PG8_MMA(1, 0, At, B0); PG8_BAR; PG8_SCHED;
            PG8_STAGE(PG8_SB(0, 1), b2 + hstep, voffB);
            PG8_WAIT_V(6); PG8_BAR; PG8_MMA(1, 1, At, B1); PG8_BAR;
            PG8_LDB(B0, 1, 0); PG8_SCHED; PG8_LDA(At, 1, 0); PG8_STAGE(PG8_SA(0, 1), a2 + hstep, voffA);
            PG8_WAIT_L(8); PG8_BAR; PG8_WAIT_L(0); PG8_MMA(0, 0, At, B0); PG8_BAR; PG8_SCHED;
            PG8_LDB(B1, 1, 1); PG8_STAGE(PG8_SB(1, 0), b3, voffB);
            PG8_BAR; PG8_WAIT_L(0); PG8_MMA(0, 1, At, B1); PG8_BAR;
            PG8_LDA(At, 1, 1); PG8_STAGE(PG8_SA(1, 0), a3, voffA);
            PG8_BAR; PG8_WAIT_L(0); PG8_MMA(1, 0, At, B0); PG8_BAR; PG8_SCHED;
            PG8_STAGE(PG8_SB(1, 1), b3 + hstep, voffB);
            PG8_WAIT_V(6); PG8_BAR; PG8_MMA(1, 1, At, B1); PG8_BAR;
            }
        }
        if constexpr (ALIGN_EPI) { if (wr == 0) PG8_BAR; }
        if constexpr (!Epi::AFTER_DRAIN) { E(acc, cur, wr, wc, fr, fq); S.done(cur); }
        if (!has_next) break;
#pragma unroll
        for (int a = 0; a < 2; ++a)
#pragma unroll
            for (int b = 0; b < 2; ++b)
#pragma unroll
                for (int m = 0; m < 4; ++m)
#pragma unroll
                    for (int n = 0; n < 2; ++n) acc[a][b][m][n] = (f32x4){0.f, 0.f, 0.f, 0.f};
        cur = nxt; cA = nA; cB = nB; ++ui;
        if constexpr (ALIGN_EPI) { if (wr == 1) PG8_BAR; }
    }
    PG8_WAIT_V(0);
    if constexpr (!ALIGN_EPI) { if (wr == 0) PG8_BAR; }
    PG8_BAR;
    if constexpr (Epi::AFTER_DRAIN) { E.fused(acc, cur, wr, wc, fr, fq, lds, wid, lane); S.done(cur); }
#undef PG8_SA
#undef PG8_SB
#undef PG8_STAGE
#undef PG8_LDA
#undef PG8_LDB
#undef PG8_MMA
#undef PG8_WAIT_V
#undef PG8_WAIT_L
#undef PG8_BAR
#undef PG8_SCHED
}
}
#ifndef PG8_SP2
#define PG8_SP2 true
#endif
#ifndef PG8_ALIGN
#define PG8_ALIGN true
#endif
#ifndef N_LAUNCH_PER_PHASE
#define N_LAUNCH_PER_PHASE 0
#endif

#define DI __device__ __forceinline__
#define LAS __attribute__((address_space(3)))
typedef unsigned short bf16_t;
typedef short bf16x8 __attribute__((ext_vector_type(8)));
typedef short s16x4 __attribute__((ext_vector_type(4)));
typedef float f32x4 __attribute__((ext_vector_type(4)));
typedef float f32x2 __attribute__((ext_vector_type(2)));
typedef float f32x16 __attribute__((ext_vector_type(16)));
typedef unsigned u32x4 __attribute__((ext_vector_type(4)));
typedef unsigned u32x2 __attribute__((ext_vector_type(2)));
typedef __bf16 bf16x2_t __attribute__((ext_vector_type(2)));

constexpr int TP = 32768, TS = 128, TT = TP + TS, MPAD = 33024;
constexpr int DM = 1024, FF = 2816, INW = 1280, NMOD = 9216, MODLD = 2 * NMOD;
constexpr int SEQ = 4096;
constexpr float EPS = 1e-6f, LOG2E = 1.4426950408889634f, C2 = 0.125f * 1.4426950408889634f;
constexpr int TBLD = 132;
constexpr size_t O_Y = 0, O_KP = 33685504, O_VP = 33947648, O_PP = 34209792, O_KS = 34332672, O_VS = 38526976, O_PS = 42721280, O_END = 44687360;
constexpr size_t MiB = 1u << 20;
constexpr size_t WS_XS = 1 * (1u << 20) + 512 * 1024;
constexpr size_t WS_BAR = 65536, WS_BAR_BYTES = 16384;
constexpr size_t WS_TB = 0, WS_CS = 1 * MiB, WS_MOD = 2 * MiB, WS_WADA = 12 * MiB, WS_L0 = 48 * MiB, LAYER_BYTES = 38 * MiB;
constexpr size_t LW_GU1 = 0, LW_D1 = 11 * MiB, LW_IN = 16 * MiB + MiB / 2, LW_OUT = 19 * MiB, LW_GU2 = 21 * MiB, LW_D2 = 32 * MiB, LW_POOL = 37 * MiB + MiB / 2;
constexpr size_t WS_X = 124 * MiB, WS_H = 253 * MiB, WS_ACT = 318 * MiB, WS_Z = WS_ACT, WS_MIX = WS_ACT + 96 * MiB, WS_END = 496 * MiB;
static_assert(WS_X + (size_t)MPAD * DM * 4 <= WS_H && WS_H + (size_t)MPAD * DM * 2 <= WS_ACT && WS_ACT + (size_t)MPAD * FF * 2 <= WS_END, "ws map");
static_assert(WS_Z + (size_t)MPAD * INW * 2 <= WS_MIX && WS_MIX + (size_t)MPAD * DM * 2 <= WS_END, "ws map 2");
static_assert(WS_MOD + (size_t)136 * MODLD * 4 <= WS_WADA && WS_WADA + (size_t)MODLD * DM * 2 <= WS_L0 && WS_L0 + 2 * LAYER_BYTES <= WS_X, "ws map 3");
constexpr int LDS_BYTES = 147456;
constexpr int NPH = 23;

struct Params { const float* in[23]; float* out; unsigned char* ws; int ph_lo, ph_hi; };

DI float bf2f(bf16_t b) { return __uint_as_float((unsigned)b << 16); }
DI unsigned pk2(float lo, float hi) { f32x2 v = {lo, hi}; bf16x2_t b = __builtin_convertvector(v, bf16x2_t); return __builtin_bit_cast(unsigned, b); }
DI float wave_sum(float v) {
#pragma unroll
    for (int o = 1; o < 64; o <<= 1) v += __shfl_xor(v, o);
    return v;
}
DI float wave_max(float v) {
#pragma unroll
    for (int o = 1; o < 64; o <<= 1) v = fmaxf(v, __shfl_xor(v, o));
    return v;
}
DI int crow(int r, int hi) { return (r & 3) + 8 * (r >> 2) + 4 * hi; }
DI f32x4 bf4_to_f4(const bf16_t* p) { const u32x2 v = *(const u32x2*)p; return (f32x4){__uint_as_float(v.x << 16), __uint_as_float(v.x & 0xffff0000u), __uint_as_float(v.y << 16), __uint_as_float(v.y & 0xffff0000u)}; }
#define MFMA32(a, b, c) __builtin_amdgcn_mfma_f32_32x32x16_bf16((a), (b), (c), 0, 0, 0)

struct EpiStoreBf16 {
    static constexpr bool PERM = true, AFTER_DRAIN = false;
    bf16_t* O; int ldc;
    DI void operator()(const pg8::f32x4 (&acc)[2][2][4][2], const pg8::Unit& u, int wr, int wc, int fr, int fq) const {
        const int row0 = u.pm * 256 + wr * 64 + fr, col0 = u.pn * 256 + wc * 32 + 8 * fq;
#pragma unroll
        for (int ai = 0; ai < 2; ++ai)
#pragma unroll
            for (int m = 0; m < 4; ++m) { bf16_t* rowp = O + (size_t)(row0 + ai * 128 + m * 16) * ldc + col0;
#pragma unroll
                for (int bj = 0; bj < 2; ++bj) { const f32x4 v0 = acc[ai][bj][m][0], v1 = acc[ai][bj][m][1];
                    u32x4 w; w.x = pk2(v0[0], v0[1]); w.y = pk2(v0[2], v0[3]); w.z = pk2(v1[0], v1[1]); w.w = pk2(v1[2], v1[3]);
                    *(u32x4*)(rowp + bj * 128) = w; } }
    }
};
DI float silu_mul(float g, float u) { return g * u * __builtin_amdgcn_rcpf(1.0f + __builtin_amdgcn_exp2f(-g * LOG2E)); }
struct EpiSwiGLU {
    static constexpr bool PERM = true, AFTER_DRAIN = false;
    bf16_t* O;
    DI void operator()(const pg8::f32x4 (&acc)[2][2][4][2], const pg8::Unit& u, int wr, int wc, int fr, int fq) const {
        const int row0 = u.pm * 256 + wr * 64 + fr, col0 = u.pn * 128 + wc * 32 + 8 * fq;
#pragma unroll
        for (int ai = 0; ai < 2; ++ai)
#pragma unroll
            for (int m = 0; m < 4; ++m) { bf16_t* rowp = O + (size_t)(row0 + ai * 128 + m * 16) * FF + col0;
                const f32x4 g0 = acc[ai][0][m][0], g1 = acc[ai][0][m][1], u0 = acc[ai][1][m][0], u1 = acc[ai][1][m][1];
                u32x4 w; w.x = pk2(silu_mul(g0[0], u0[0]), silu_mul(g0[1], u0[1])); w.y = pk2(silu_mul(g0[2], u0[2]), silu_mul(g0[3], u0[3]));
                w.z = pk2(silu_mul(g1[0], u1[0]), silu_mul(g1[1], u1[1])); w.w = pk2(silu_mul(g1[2], u1[2]), silu_mul(g1[3], u1[3]));
                *(u32x4*)rowp = w; }
    }
};
struct TailOrder {
    static constexpr bool SPLIT = false;
    pg8::StaticOrder base; int nmain, nN, G, c;
    DI void init(int N, int G_, int c_) { base.init(TP, N, G_, c_); nN = N / 256; nmain = (TP / 256) * nN; G = G_; c = c_; }
    DI bool next(int i, pg8::Unit& u) const {
        const int L = i * G + c;
        if (L < nmain) return base.next(i, u);
        const int s = L - nmain; if (s >= nN) return false;
        u.pm = TP / 256; u.pn = s; u.k0 = 0; return true;
    }
    DI void a_ready(const pg8::Unit&) const {}
    DI void done(const pg8::Unit&) const {}
};
struct SplitOrder {
    static constexpr bool SPLIT = true;
    pg8::StaticOrder base; int nmain, nN, nchunk, G, c;
    DI void init(int N, int K, int G_, int c_) { base.init(TP, N, G_, c_, K, -1); nN = N / 256; nmain = (TP / 256) * nN; nchunk = K / 256; G = G_; c = c_; }
    DI bool next(int i, pg8::Unit& u) const {
        const int L = i * G + c;
        if (L < nmain) return base.next(i, u);
        const int s = L - nmain; if (s >= nN * nchunk) return false;
        u.pm = TP / 256; u.pn = s % nN; u.k0 = (s / nN) * 4; return true;
    }
    DI void a_ready(const pg8::Unit&) const {}
    DI void done(const pg8::Unit&) const {}
};
struct EpiResid {
    static constexpr bool PERM = true, AFTER_DRAIN = false;
    const float* xin_f32; bf16_t* XB; float* PART; const float* gate; float coef;
    DI void operator()(const pg8::f32x4 (&acc)[2][2][4][2], const pg8::Unit& u, int wr, int wc, int fr, int fq) const {
        const int row0 = u.pm * 256 + wr * 64 + fr, col0 = u.pn * 256 + wc * 32 + 8 * fq;
        if (u.pm == TP / 256) {
#pragma unroll
            for (int m = 0; m < 4; ++m) { const int row = row0 + m * 16; const float* gp = gate + (size_t)(8 + row - TP) * MODLD; float* dst = PART + ((size_t)(u.k0 >> 2) * 128 + (row - TP)) * DM;
#pragma unroll
                for (int bj = 0; bj < 2; ++bj)
#pragma unroll
                    for (int n = 0; n < 2; ++n) { const int col = col0 + bj * 128 + n * 4; const f32x4 gv = *(const f32x4*)(gp + col); const f32x4 v = (gv * coef) * acc[0][bj][m][n];
                        *(f32x4*)(dst + col) = v; } }
            return;
        }
        const float* gp = gate + (size_t)(u.pm >> 4) * MODLD;
        f32x4 gv[2][2];
#pragma unroll
        for (int bj = 0; bj < 2; ++bj)
#pragma unroll
            for (int n = 0; n < 2; ++n) gv[bj][n] = *(const f32x4*)(gp + col0 + bj * 128 + n * 4) * coef;
        if (xin_f32) {
#pragma unroll
            for (int ai = 0; ai < 2; ++ai)
#pragma unroll
                for (int m = 0; m < 4; ++m) { const size_t ro = (size_t)(row0 + ai * 128 + m * 16) * DM + col0;
#pragma unroll
                    for (int bj = 0; bj < 2; ++bj) { const f32x4 x0 = *(const f32x4*)(xin_f32 + ro + bj * 128), x1 = *(const f32x4*)(xin_f32 + ro + bj * 128 + 4);
                        const f32x4 o0 = x0 + gv[bj][0] * acc[ai][bj][m][0], o1 = x1 + gv[bj][1] * acc[ai][bj][m][1];
                        u32x4 w; w.x = pk2(o0[0], o0[1]); w.y = pk2(o0[2], o0[3]); w.z = pk2(o1[0], o1[1]); w.w = pk2(o1[2], o1[3]);
                        *(u32x4*)(XB + ro + bj * 128) = w; } }
        } else {
#pragma unroll
            for (int ai = 0; ai < 2; ++ai) {
                u32x4 xr[4][2];
#pragma unroll
                for (int m = 0; m < 4; ++m)
#pragma unroll
                    for (int bj = 0; bj < 2; ++bj) xr[m][bj] = *(const u32x4*)(XB + (size_t)(row0 + ai * 128 + m * 16) * DM + col0 + bj * 128);
                asm volatile("" ::: "memory");
#pragma unroll
                for (int m = 0; m < 4; ++m)
#pragma unroll
                    for (int bj = 0; bj < 2; ++bj) { const u32x4 r = xr[m][bj];
                        const f32x4 x0 = {__uint_as_float(r.x << 16), __uint_as_float(r.x & 0xffff0000u), __uint_as_float(r.y << 16), __uint_as_float(r.y & 0xffff0000u)};
                        const f32x4 x1 = {__uint_as_float(r.z << 16), __uint_as_float(r.z & 0xffff0000u), __uint_as_float(r.w << 16), __uint_as_float(r.w & 0xffff0000u)};
                        const f32x4 o0 = x0 + gv[bj][0] * acc[ai][bj][m][0], o1 = x1 + gv[bj][1] * acc[ai][bj][m][1];
                        u32x4 w; w.x = pk2(o0[0], o0[1]); w.y = pk2(o0[2], o0[3]); w.z = pk2(o1[0], o1[1]); w.w = pk2(o1[2], o1[3]);
                        *(u32x4*)(XB + (size_t)(row0 + ai * 128 + m * 16) * DM + col0 + bj * 128) = w; }
                asm volatile("" ::: "memory");
            }
        }
    }
};
struct EpiMod {
    static constexpr bool PERM = false, AFTER_DRAIN = false;
    float* mod; const float* bias;
    DI void operator()(const pg8::f32x4 (&acc)[2][2][4][2], const pg8::Unit& u, int wr, int wc, int fr, int fq) const {
        const int row0 = u.pm * 256 + wr * 64 + fr, col0 = u.pn * 256 + wc * 32 + 4 * fq;
#pragma unroll
        for (int ai = 0; ai < 2; ++ai)
#pragma unroll
            for (int m = 0; m < 4; ++m) { const int row = row0 + ai * 128 + m * 16;
                if (row < 136) {
#pragma unroll
                    for (int bj = 0; bj < 2; ++bj)
#pragma unroll
                        for (int n = 0; n < 2; ++n) { const int col = col0 + bj * 128 + n * 16;
                            *(f32x4*)(mod + (size_t)row * MODLD + col) = acc[ai][bj][m][n] + *(const f32x4*)(bias + col); } } }
    }
};
typedef const __attribute__((address_space(4))) Params* KP;
DI void transpose_item(const float* W, int K, int N, bf16_t* WT, int mode, LAS float* scr, int item, int lane) {
    const int nblk = N / 32, kb = item / nblk, nb = item % nblk, k0 = 64 * kb, n0 = 32 * nb;
#pragma unroll 8
    for (int i = 0; i < 32; ++i) { const int kk = 2 * i + (lane >> 5); scr[kk * 33 + (lane & 31)] = W[(size_t)(k0 + kk) * N + n0 + (lane & 31)]; }
    asm volatile("s_waitcnt lgkmcnt(0)" ::: "memory");
    int rbase = n0;
    if (mode == 1) rbase = (n0 >> 7) * 256 + (n0 & 127);
    if (mode == 2) rbase = (n0 >> 7) * 256 + 128 + (n0 & 127);
    const int c = lane & 7;
#pragma unroll
    for (int j = 0; j < 4; ++j) { const int n = (lane >> 3) + 8 * j; const LAS float* s = scr + (8 * c) * 33 + n;
        u32x4 o; o.x = pk2(s[0 * 33], s[1 * 33]); o.y = pk2(s[2 * 33], s[3 * 33]); o.z = pk2(s[4 * 33], s[5 * 33]); o.w = pk2(s[6 * 33], s[7 * 33]);
        *(u32x4*)(WT + (size_t)(rbase + n) * K + k0 + 8 * c) = o; }
    asm volatile("s_waitcnt lgkmcnt(0)" ::: "memory");
}
constexpr int I_ADA = (DM / 64) * (NMOD / 32), I_FU = (DM / 64) * (FF / 32), I_FD = (FF / 64) * (DM / 32), I_IN = (DM / 64) * (INW / 32), I_OUT = (DM / 64) * (DM / 32), I_POOL = 4 * 8;
constexpr int IPL = I_ADA + 4 * I_FU + 2 * I_FD + I_IN + I_OUT + I_POOL;
DI int t5_bucket(int n) {
    if (n < 16) return n;
    int b = 16;
    b += (n >= 19); b += (n >= 21); b += (n >= 24); b += (n >= 27); b += (n >= 31); b += (n >= 35); b += (n >= 40); b += (n >= 46);
    b += (n >= 52); b += (n >= 59); b += (n >= 67); b += (n >= 77); b += (n >= 87); b += (n >= 99); b += (n >= 113);
    return b;
}
DI void convert_item(KP P, int l, int r, LAS float* scr, int lane) {
    unsigned char* wl = P->ws + WS_L0 + (size_t)l * LAYER_BYTES;
    const float* src; bf16_t* dst; int K, N, mode = 0;
    if (r < I_ADA) { src = P->in[7] + (size_t)l * DM * NMOD; K = DM; N = NMOD; dst = (bf16_t*)(P->ws + WS_WADA) + (size_t)l * NMOD * DM; }
    else if ((r -= I_ADA) < I_FU) { src = P->in[16] + (size_t)l * DM * FF; K = DM; N = FF; dst = (bf16_t*)(wl + LW_GU1); mode = 1; }
    else if ((r -= I_FU) < I_FU) { src = P->in[17] + (size_t)l * DM * FF; K = DM; N = FF; dst = (bf16_t*)(wl + LW_GU1); mode = 2; }
    else if ((r -= I_FU) < I_FD) { src = P->in[18] + (size_t)l * FF * DM; K = FF; N = DM; dst = (bf16_t*)(wl + LW_D1); }
    else if ((r -= I_FD) < I_IN) { src = P->in[10] + (size_t)l * DM * INW; K = DM; N = INW; dst = (bf16_t*)(wl + LW_IN); }
    else if ((r -= I_IN) < I_OUT) { src = P->in[11] + (size_t)l * DM * DM; K = DM; N = DM; dst = (bf16_t*)(wl + LW_OUT); }
    else if ((r -= I_OUT) < I_FU) { src = P->in[19] + (size_t)l * DM * FF; K = DM; N = FF; dst = (bf16_t*)(wl + LW_GU2); mode = 1; }
    else if ((r -= I_FU) < I_FU) { src = P->in[20] + (size_t)l * DM * FF; K = DM; N = FF; dst = (bf16_t*)(wl + LW_GU2); mode = 2; }
    else if ((r -= I_FU) < I_FD) { src = P->in[21] + (size_t)l * FF * DM; K = FF; N = DM; dst = (bf16_t*)(wl + LW_D2); }
    else { r -= I_FD; const int g = r >> 3; r &= 7; src = P->in[14] + (size_t)(l * 4 + g) * 16384; K = 128; N = 128; dst = (bf16_t*)(wl + LW_POOL) + (size_t)g * 16384; }
    transpose_item(src, K, N, dst, mode, scr, r, lane);
}
DI void prologue_rest(KP P, LAS unsigned char* lds, int w, int nw, int wid, int lane) {
    LAS float* scr = (LAS float*)(lds + wid * 8448);
    constexpr int REST = IPL - I_ADA;
    for (int it = w; it < 2 * REST; it += nw) { const int l = it / REST; convert_item(P, l, I_ADA + (it - l * REST), scr, lane); }
}
DI void prologue(KP P, LAS unsigned char* lds, int gw, int NGW, int gtid, int GT, int wid, int lane) {
    LAS float* scr = (LAS float*)(lds + wid * 8448);
    for (int it = gw; it < 2 * I_ADA; it += NGW) { const int l = it / I_ADA; convert_item(P, l, it - l * I_ADA, scr, lane); }
    bf16_t* CS = (bf16_t*)(P->ws + WS_CS);
    for (int idx = gtid; idx < 256 * DM; idx += GT) {
        const int row = idx >> 10; float v = 0.f;
        if (row < 8) v = P->in[2][idx]; else if (row < 136) v = P->in[3][idx - 8 * DM];
        const float s = v / (1.0f + __expf(-v));
        CS[idx] = (bf16_t)(pk2(row < 136 ? s : 0.f, 0.f) & 0xffffu);
    }
    float* TB = (float*)(P->ws + WS_TB);
    for (int idx = gtid; idx < 8 * TBLD; idx += GT) { const int h = idx / TBLD, d = idx % TBLD; const int dd = d < 128 ? d : 128;
        TB[idx] = P->in[13][t5_bucket(dd) * 8 + h] * LOG2E; }
}

template <bool FINAL>
DI void norm_phase(const float* xp, const float* xs, const float* gain, const float* modsh, bf16_t* H, float* Y, int gw, int NGW, int lane, float* xcopy = nullptr, int blk_lo = 0, int blk_hi = TT / 16, int r4_lo = 0, int r4_hi = 16, const float* part = nullptr, int nparts = 0) {
    for (int blk = blk_lo + gw; blk < blk_hi; blk += NGW) {
        const int row0 = blk * 16; const bool prompt = row0 < TP;
        f32x4 Gv[4], Sv[4];
        if (FINAL) {
#pragma unroll
            for (int j = 0; j < 4; ++j) { Gv[j] = ((const f32x4*)gain)[lane + 64 * j]; Sv[j] = (f32x4){0.f, 0.f, 0.f, 0.f}; }
        } else if (prompt) {
            const float* mp = modsh + (size_t)(row0 >> 12) * MODLD;
#pragma unroll
            for (int j = 0; j < 4; ++j) { Gv[j] = ((const f32x4*)gain)[lane + 64 * j] * (((const f32x4*)(mp + DM))[lane + 64 * j] + 1.0f); Sv[j] = ((const f32x4*)mp)[lane + 64 * j]; }
        }
#pragma unroll 1
        for (int r4 = r4_lo; r4 < r4_hi; r4 += 4) {
            f32x4 v[4][4]; float ss[4];
#pragma unroll
            for (int q = 0; q < 4; ++q) { const int row = row0 + r4 + q;
                const float* xr = row < TP ? xp + (size_t)row * DM : xs + (size_t)(row - TP) * DM;
#pragma unroll
                for (int j = 0; j < 4; ++j) v[q][j] = ((const f32x4*)xr)[lane + 64 * j]; }
            if (part) {
#pragma unroll 3
                for (int p = 0; p < nparts; ++p) {
#pragma unroll
                    for (int q = 0; q < 4; ++q) { const float* pr = part + ((size_t)p * 128 + (row0 + r4 + q - TP)) * DM;
#pragma unroll
                        for (int j = 0; j < 4; ++j) v[q][j] += ((const f32x4*)pr)[lane + 64 * j]; } }
            }
#pragma unroll
            for (int q = 0; q < 4; ++q) { float a = 0.f;
#pragma unroll
                for (int j = 0; j < 4; ++j) a += (v[q][j].x * v[q][j].x + v[q][j].y * v[q][j].y) + (v[q][j].z * v[q][j].z + v[q][j].w * v[q][j].w);
                ss[q] = a; }
#pragma unroll
            for (int o = 1; o < 64; o <<= 1) {
#pragma unroll
                for (int q = 0; q < 4; ++q) ss[q] += __shfl_xor(ss[q], o); }
#pragma unroll
            for (int q = 0; q < 4; ++q) { const int row = row0 + r4 + q;
                if (!FINAL && !prompt) {
                    const float* mp = modsh + (size_t)(8 + row - TP) * MODLD;
#pragma unroll
                    for (int j = 0; j < 4; ++j) { Gv[j] = ((const f32x4*)gain)[lane + 64 * j] * (((const f32x4*)(mp + DM))[lane + 64 * j] + 1.0f); Sv[j] = ((const f32x4*)mp)[lane + 64 * j]; }
                    if (xcopy) {
#pragma unroll
                        for (int j = 0; j < 4; ++j) ((f32x4*)(xcopy + (size_t)row * DM))[lane + 64 * j] = v[q][j]; }
                }
                const float rstd = 1.0f / sqrtf(ss[q] * (1.0f / DM) + EPS);
                if (FINAL) {
#pragma unroll
                    for (int j = 0; j < 4; ++j) ((f32x4*)(Y + (size_t)row * DM))[lane + 64 * j] = v[q][j] * rstd * Gv[j];
                } else {
#pragma unroll
                    for (int j = 0; j < 4; ++j) { const f32x4 h = v[q][j] * rstd * Gv[j] + Sv[j]; u32x2 w; w.x = pk2(h.x, h.y); w.y = pk2(h.z, h.w);
                        ((u32x2*)(H + (size_t)row * DM))[lane + 64 * j] = w; }
                }
            }
        }
    }
}

template <bool FINAL>
DI void norm_sample(const float* xs, const float* gain, const float* modsh, bf16_t* H, float* Y, int gw, int NGW, int lane, float* xcopy, const float* part, int nparts) {
    if ((gw & 63) != 0) return;
    const int ns = (NGW >> 6) > 0 ? (NGW >> 6) : 1;
    for (int k = gw >> 6; k < 32; k += ns) norm_phase<FINAL>(nullptr, xs, gain, modsh, H, Y, 0, 1 << 28, lane, xcopy, TP / 16 + (k >> 2), TP / 16 + (k >> 2) + 1, 4 * (k & 3), 4 * (k & 3) + 4, part, nparts);
}
template <bool FINAL>
DI void norm_phase_bf(const bf16_t* XB, const float* gain, const float* modsh, bf16_t* H, float* Y, int gw, int NGW, int lane) {
    for (int blk = gw; blk < TP / 16; blk += NGW) {
        const int row0 = blk * 16;
        f32x4 Gv[2][2], Sv[2][2];
        const float* mp = FINAL ? nullptr : modsh + (size_t)(row0 >> 12) * MODLD;
#pragma unroll
        for (int j = 0; j < 2; ++j)
#pragma unroll
            for (int h = 0; h < 2; ++h) { const int fi = 2 * lane + 128 * j + h;
                if (FINAL) { Gv[j][h] = ((const f32x4*)gain)[fi]; Sv[j][h] = (f32x4){0.f, 0.f, 0.f, 0.f}; }
                else { Gv[j][h] = ((const f32x4*)gain)[fi] * (((const f32x4*)(mp + DM))[fi] + 1.0f); Sv[j][h] = ((const f32x4*)mp)[fi]; } }
#pragma unroll 1
        for (int r8 = 0; r8 < 16; r8 += 8) {
            u32x4 raw[8][2]; float ss[8];
#pragma unroll
            for (int q = 0; q < 8; ++q)
#pragma unroll
                for (int j = 0; j < 2; ++j) raw[q][j] = *(const u32x4*)(XB + (size_t)(row0 + r8 + q) * DM + 8 * lane + 512 * j);
#pragma unroll
            for (int q = 0; q < 8; ++q) { float a = 0.f;
#pragma unroll
                for (int j = 0; j < 2; ++j)
#pragma unroll
                    for (int e = 0; e < 4; ++e) { const float lo = __uint_as_float(raw[q][j][e] << 16), hi = __uint_as_float(raw[q][j][e] & 0xffff0000u); a += lo * lo + hi * hi; }
                ss[q] = a; }
#pragma unroll
            for (int o = 1; o < 64; o <<= 1) {
#pragma unroll
                for (int q = 0; q < 8; ++q) ss[q] += __shfl_xor(ss[q], o); }
#pragma unroll
            for (int q = 0; q < 8; ++q) { const int row = row0 + r8 + q;
                const float rstd = 1.0f / sqrtf(ss[q] * (1.0f / DM) + EPS);
#pragma unroll
                for (int j = 0; j < 2; ++j) { const u32x4 r = raw[q][j];
                    const f32x4 x0 = {__uint_as_float(r.x << 16), __uint_as_float(r.x & 0xffff0000u), __uint_as_float(r.y << 16), __uint_as_float(r.y & 0xffff0000u)};
                    const f32x4 x1 = {__uint_as_float(r.z << 16), __uint_as_float(r.z & 0xffff0000u), __uint_as_float(r.w << 16), __uint_as_float(r.w & 0xffff0000u)};
                    const f32x4 h0 = x0 * rstd * Gv[j][0] + Sv[j][0], h1 = x1 * rstd * Gv[j][1] + Sv[j][1];
                    if (FINAL) { float* yp = Y + (size_t)row * DM + 8 * lane + 512 * j; *(f32x4*)yp = h0; *(f32x4*)(yp + 4) = h1; }
                    else { u32x4 w; w.x = pk2(h0[0], h0[1]); w.y = pk2(h0[2], h0[3]); w.z = pk2(h1[0], h1[1]); w.w = pk2(h1[2], h1[3]);
                        *(u32x4*)(H + (size_t)row * DM + 8 * lane + 512 * j) = w; }
                }
            }
        }
    }
}

constexpr int KS_LD = 72, VT_LD = 264;
constexpr int ATT_KS = 0, ATT_VT = 256 * KS_LD * 2, ATT_TB = ATT_VT + 64 * VT_LD * 2;
DI void attn_unit(LAS unsigned char* lds, const bf16_t* Z, bf16_t* MIX, const float* TB, const float* sinks_l, int b, int n, int kvh, int tid) {
    asm volatile("" : "+v"(tid));
    const int lane = tid & 63, wid = tid >> 6, r = lane & 31, hh = lane >> 5;
    LAS bf16_t* Ks = (LAS bf16_t*)(lds + ATT_KS); LAS bf16_t* Vt = (LAS bf16_t*)(lds + ATT_VT); LAS float* tb = (LAS float*)(lds + ATT_TB);
    const int base = b * SEQ + n * 128;
#pragma unroll
    for (int i = 0; i < 4; ++i) {
        const int c = tid + 512 * i, key = c >> 3, part = c & 7;
        u32x4 kv = {0u, 0u, 0u, 0u}, vv = {0u, 0u, 0u, 0u};
        if (n > 0 || key >= 128) { const bf16_t* zr = Z + (size_t)(base - 128 + key) * INW + kvh * 64 + part * 8; kv = *(const u32x4*)(zr + 512); vv = *(const u32x4*)(zr + 640); }
        *(LAS u32x4*)(Ks + key * KS_LD + part * 8) = kv;
        LAS bf16_t* vd = Vt + (part * 8) * VT_LD + (key ^ (part << 2));
        vd[0 * VT_LD] = (bf16_t)(vv.x & 0xffffu); vd[1 * VT_LD] = (bf16_t)(vv.x >> 16); vd[2 * VT_LD] = (bf16_t)(vv.y & 0xffffu); vd[3 * VT_LD] = (bf16_t)(vv.y >> 16);
        vd[4 * VT_LD] = (bf16_t)(vv.z & 0xffffu); vd[5 * VT_LD] = (bf16_t)(vv.z >> 16); vd[6 * VT_LD] = (bf16_t)(vv.w & 0xffffu); vd[7 * VT_LD] = (bf16_t)(vv.w >> 16);
    }
    for (int i = tid; i < 4 * TBLD; i += 512) tb[i] = TB[kvh * 4 * TBLD + i];
    const int hl = wid >> 1, h = kvh * 4 + hl;
    const float sink2 = sinks_l[h] * LOG2E;
    LAS const float* tbh = tb + hl * TBLD;
    bf16x8 qf[4];
    {   const bf16_t* qrow = Z + (size_t)(base + (wid & 1) * 64 + r) * INW + h * 64 + 8 * hh;
#pragma unroll
        for (int c = 0; c < 4; ++c) qf[c] = *(const bf16x8*)(qrow + 16 * c); }
    __syncthreads();
#pragma unroll 1
    for (int sub = 0; sub < 2; ++sub) {
        const int qoff = (wid & 1) * 64 + sub * 32, kt0 = qoff >> 5, q = qoff + r;
        f32x16 sc[5];
#pragma unroll
        for (int t = 0; t < 5; ++t) {
#pragma unroll
            for (int i = 0; i < 16; ++i) sc[t][i] = 0.f;
#pragma unroll
            for (int c = 0; c < 4; ++c) { const bf16x8 a = *(LAS const bf16x8*)(Ks + (32 * (kt0 + t) + r) * KS_LD + 16 * c + 8 * hh); sc[t] = MFMA32(a, qf[c], sc[t]); }
        }
        if (sub == 0) {
            const bf16_t* qrow = Z + (size_t)(base + q + 32) * INW + h * 64 + 8 * hh;
#pragma unroll
            for (int c = 0; c < 4; ++c) qf[c] = *(const bf16x8*)(qrow + 16 * c);
        }
        float m = -INFINITY;
        const int rel = r - 4 * hh;
#pragma unroll
        for (int t = 0; t < 5; ++t) {
            const bool dead = (n == 0) && (kt0 + t < 4);
#pragma unroll
            for (int i = 0; i < 16; ++i) {
                const int cc = (i & 3) + 8 * (i >> 2);
                const int dist = 128 - 32 * t + rel - cc;
                bool valid = !dead;
                if (t == 0) valid = valid && (dist <= 128);
                if (t == 4) valid = valid && (dist >= 0);
                const float bias = tbh[(t == 0 || t == 4) ? (valid ? dist : 0) : dist];
                const float val = valid ? sc[t][i] * C2 + bias : -INFINITY;
                sc[t][i] = val; m = fmaxf(m, val);
            }
        }
        m = fmaxf(m, __shfl_xor(m, 32)); m = fmaxf(m, sink2);
        float sum = 0.f;
#pragma unroll
        for (int t = 0; t < 5; ++t)
#pragma unroll
            for (int i = 0; i < 16; ++i) { const float p = __builtin_amdgcn_exp2f(sc[t][i] - m); sc[t][i] = p; sum += p; }
        sum += __shfl_xor(sum, 32); sum += __builtin_amdgcn_exp2f(sink2 - m);
        const float inv = 1.0f / sum;
        f32x16 o[2];
#pragma unroll
        for (int i = 0; i < 16; ++i) { o[0][i] = 0.f; o[1][i] = 0.f; }
#pragma unroll
        for (int t = 0; t < 5; ++t)
#pragma unroll
            for (int s = 0; s < 2; ++s) {
                u32x4 pw; pw.x = pk2(sc[t][8 * s + 0], sc[t][8 * s + 1]); pw.y = pk2(sc[t][8 * s + 2], sc[t][8 * s + 3]); pw.z = pk2(sc[t][8 * s + 4], sc[t][8 * s + 5]); pw.w = pk2(sc[t][8 * s + 6], sc[t][8 * s + 7]);
                const bf16x8 pb = __builtin_bit_cast(bf16x8, pw);
#pragma unroll
                for (int dt = 0; dt < 2; ++dt) {
                    const int dd = 32 * dt + r, sw = ((dd >> 3) & 7) << 2, ko = 32 * (kt0 + t) + 16 * s + 4 * hh;
                    LAS const bf16_t* vrow = Vt + dd * VT_LD;
                    const s16x4 lo = *(LAS const s16x4*)(vrow + (ko ^ sw)), hi = *(LAS const s16x4*)(vrow + ((ko + 8) ^ sw));
                    const bf16x8 a = __builtin_shufflevector(lo, hi, 0, 1, 2, 3, 4, 5, 6, 7);
                    o[dt] = MFMA32(a, pb, o[dt]);
                }
            }
        bf16_t* orow = MIX + (size_t)(base + q) * DM + h * 64 + 4 * hh;
#pragma unroll
        for (int dt = 0; dt < 2; ++dt)
#pragma unroll
            for (int g4 = 0; g4 < 4; ++g4) { u32x2 w; w.x = pk2(o[dt][4 * g4 + 0] * inv, o[dt][4 * g4 + 1] * inv); w.y = pk2(o[dt][4 * g4 + 2] * inv, o[dt][4 * g4 + 3] * inv);
                *(u32x2*)(orow + 32 * dt + 8 * g4) = w; }
    }
    __syncthreads();
}

DI void sattn_task(LAS float* wl, const bf16_t* Z, const float* ck, const float* cv, bf16_t* MIX, const float* TB, const float* sinks_l, int s, int kvh, int lane) {
    asm volatile("" : "+v"(lane));
    const bf16_t* zrow = Z + (size_t)(TP + s) * INW;
#pragma unroll
    for (int hl = 0; hl < 4; ++hl) wl[hl * 64 + lane] = bf2f(zrow[(kvh * 4 + hl) * 64 + lane]) * C2;
    const float kn = bf2f(zrow[512 + kvh * 64 + lane]);
    asm volatile("s_waitcnt lgkmcnt(0)" ::: "memory");
    float sc[4][2];
#pragma unroll
    for (int kk = 0; kk < 2; ++kk) {
        const int j = lane + 64 * kk;
        const float* krow = ck + ((size_t)(s * 128 + j) * 2 + kvh) * 64;
        float a[4] = {0.f, 0.f, 0.f, 0.f};
#pragma unroll 8
        for (int d4 = 0; d4 < 16; ++d4) { const f32x4 kv = *(const f32x4*)(krow + 4 * d4);
#pragma unroll
            for (int hl = 0; hl < 4; ++hl) { const f32x4 qv = *(LAS const f32x4*)(wl + hl * 64 + 4 * d4); a[hl] += (kv.x * qv.x + kv.y * qv.y) + (kv.z * qv.z + kv.w * qv.w); } }
#pragma unroll
        for (int hl = 0; hl < 4; ++hl) sc[hl][kk] = a[hl] + TB[(kvh * 4 + hl) * TBLD + (128 - j)];
    }
    float pn[4];
#pragma unroll
    for (int hl = 0; hl < 4; ++hl) {
        const float sink2 = sinks_l[kvh * 4 + hl] * LOG2E;
        const float snew = wave_sum(kn * wl[hl * 64 + lane]) + TB[(kvh * 4 + hl) * TBLD + 0];
        float m = wave_max(fmaxf(sc[hl][0], sc[hl][1])); m = fmaxf(m, fmaxf(snew, sink2));
        const float p0 = __builtin_amdgcn_exp2f(sc[hl][0] - m), p1 = __builtin_amdgcn_exp2f(sc[hl][1] - m), pnw = __builtin_amdgcn_exp2f(snew - m);
        const float sum = wave_sum(p0 + p1) + pnw + __builtin_amdgcn_exp2f(sink2 - m);
        const float inv = 1.0f / sum;
        wl[256 + hl * TBLD + lane] = p0 * inv; wl[256 + hl * TBLD + 64 + lane] = p1 * inv; pn[hl] = pnw * inv;
    }
    asm volatile("s_waitcnt lgkmcnt(0)" ::: "memory");
    const int jg = lane >> 4, d4 = lane & 15;
    f32x4 o[4];
#pragma unroll
    for (int hl = 0; hl < 4; ++hl) o[hl] = (f32x4){0.f, 0.f, 0.f, 0.f};
    const float* vb = cv + ((size_t)(s * 128 + jg) * 2 + kvh) * 64 + 4 * d4;
#pragma unroll 8
    for (int i = 0; i < 32; ++i) { const f32x4 vv = *(const f32x4*)(vb + (size_t)i * 512);
#pragma unroll
        for (int hl = 0; hl < 4; ++hl) o[hl] += vv * wl[256 + hl * TBLD + 4 * i + jg]; }
    const f32x4 vn4 = bf4_to_f4(zrow + 640 + kvh * 64 + 4 * d4);
#pragma unroll
    for (int hl = 0; hl < 4; ++hl) {
#pragma unroll
        for (int e = 0; e < 4; ++e) { float v = o[hl][e]; v += __shfl_xor(v, 16); v += __shfl_xor(v, 32); o[hl][e] = v + pn[hl] * vn4[e]; }
        if (jg == 0) { u32x2 w; w.x = pk2(o[hl][0], o[hl][1]); w.y = pk2(o[hl][2], o[hl][3]); *(u32x2*)(MIX + (size_t)(TP + s) * DM + (kvh * 4 + hl) * 64 + 4 * d4) = w; }
    }
    asm volatile("s_waitcnt lgkmcnt(0)" ::: "memory");
}

constexpr int PU_LD = 136;
constexpr int POOL_U = 0, POOL_P = 144 * PU_LD * 2, POOL_O = POOL_P + 128 * PU_LD * 2;
DI void pool_unit(LAS unsigned char* lds, const bf16_t* Z, const bf16_t* PWT, const float* pscale_l, bf16_t* MIX, int ub, int tid) {
    asm volatile("" : "+v"(tid));
    const int lane = tid & 63, wid = tid >> 6, r = lane & 31, hh = lane >> 5;
    LAS bf16_t* Ug = (LAS bf16_t*)(lds + POOL_U); LAS bf16_t* Pg = (LAS bf16_t*)(lds + POOL_P); LAS bf16_t* Og = (LAS bf16_t*)(lds + POOL_O);
    const int b = ub >> 5, n = ub & 31;
    const bf16_t* zb = Z + (size_t)(b * SEQ + n * 128 - 15) * INW + 768;
    bf16_t* ob = MIX + (size_t)(b * SEQ + n * 128) * DM + 512;
    u32x4 ureg[5];
#define POOL_LOADU(gg) do { _Pragma("unroll") for (int i_ = 0; i_ < 5; ++i_) { const int c_ = tid + 512 * i_, row_ = c_ >> 4, part_ = c_ & 15; \
        u32x4 v_ = {0u, 0u, 0u, 0u}; if (c_ < 143 * 16 && n * 128 - 15 + row_ >= 0) v_ = *(const u32x4*)(zb + (size_t)row_ * INW + (gg) * 128 + part_ * 8); ureg[i_] = v_; } } while (0)
    POOL_LOADU(0);
    const int mt = wid >> 1, nt0 = (wid & 1) * 2;
#pragma unroll 1
    for (int g = 0; g < 4; ++g) {
        const int w = 2 << g;
        bf16x8 bfr[8][2];
#pragma unroll
        for (int ks = 0; ks < 8; ++ks)
#pragma unroll
            for (int qq = 0; qq < 2; ++qq) bfr[ks][qq] = *(const bf16x8*)(PWT + (size_t)g * 16384 + (32 * (nt0 + qq) + r) * 128 + 16 * ks + 8 * hh);
#pragma unroll
        for (int i = 0; i < 5; ++i) { const int c = tid + 512 * i; if (c < 143 * 16) *(LAS u32x4*)(Ug + (c >> 4) * PU_LD + (c & 15) * 8) = ureg[i]; }
        __syncthreads();
        if (g < 3) POOL_LOADU(g + 1);
        {   const int c2 = tid & 63, t0 = wid * 16;
            float a0 = 0.f, a1 = 0.f;
            for (int s = 0; s < w; ++s) { const unsigned uv = *(LAS const unsigned*)(Ug + (t0 + 15 - s) * PU_LD + 2 * c2); a0 += __uint_as_float(uv << 16); a1 += __uint_as_float(uv & 0xffff0000u); }
            for (int t = t0; t < t0 + 16; ++t) {
                const unsigned uv = *(LAS const unsigned*)(Ug + (t + 15) * PU_LD + 2 * c2);
                const float u0 = __uint_as_float(uv << 16), u1 = __uint_as_float(uv & 0xffff0000u);
                const int pos1 = n * 128 + t + 1; const float ic = 1.0f / (float)(pos1 < w ? pos1 : w);
                *(LAS unsigned*)(Pg + t * PU_LD + 2 * c2) = pk2(a0 * ic - u0, a1 * ic - u1);
                if (t + 1 < t0 + 16) {
                    const unsigned ua = *(LAS const unsigned*)(Ug + (t + 16) * PU_LD + 2 * c2), ud = *(LAS const unsigned*)(Ug + (t + 16 - w) * PU_LD + 2 * c2);
                    a0 += __uint_as_float(ua << 16) - __uint_as_float(ud << 16); a1 += __uint_as_float(ua & 0xffff0000u) - __uint_as_float(ud & 0xffff0000u);
                }
            }
        }
        __syncthreads();
        {   f32x16 acc[2];
#pragma unroll
            for (int i = 0; i < 16; ++i) { acc[0][i] = 0.f; acc[1][i] = 0.f; }
#pragma unroll
            for (int ks = 0; ks < 8; ++ks) {
                const bf16x8 a = *(LAS const bf16x8*)(Pg + (32 * mt + r) * PU_LD + 16 * ks + 8 * hh);
#pragma unroll
                for (int qq = 0; qq < 2; ++qq) acc[qq] = MFMA32(a, bfr[ks][qq], acc[qq]);
            }
#pragma unroll
            for (int qq = 0; qq < 2; ++qq) { const int cl = 32 * (nt0 + qq) + r; const float ps = pscale_l[g * 128 + cl];
#pragma unroll
                for (int i = 0; i < 16; ++i) Og[(32 * mt + crow(i, hh)) * PU_LD + cl] = (bf16_t)(pk2(acc[qq][i] * ps, 0.f) & 0xffffu); }
        }
        __syncthreads();
#pragma unroll
        for (int i = 0; i < 4; ++i) { const int c = tid + 512 * i, row = c >> 4, part = c & 15;
            *(u32x4*)(ob + (size_t)row * DM + g * 128 + part * 8) = *(LAS const u32x4*)(Og + row * PU_LD + part * 8); }
    }
#undef POOL_LOADU
}
DI void pool_unit_sample(LAS unsigned char* lds, const bf16_t* Z, const float* sp_l, const bf16_t* PWT, const float* pscale_l, bf16_t* MIX, int k, int tid) {
    asm volatile("" : "+v"(tid));
    const int lane = tid & 63, wid = tid >> 6, r = lane & 31, hh = lane >> 5;
    LAS bf16_t* Pg = (LAS bf16_t*)(lds + POOL_P);
    const int g = k >> 2, s0 = (k & 3) * 32, w = 2 << g;
    bf16x8 bfr[8][2];
    if (wid < 2) {
#pragma unroll
        for (int ks = 0; ks < 8; ++ks)
#pragma unroll
            for (int qq = 0; qq < 2; ++qq) bfr[ks][qq] = *(const bf16x8*)(PWT + (size_t)g * 16384 + (32 * (wid * 2 + qq) + r) * 128 + 16 * ks + 8 * hh);
    }
#pragma unroll 2
    for (int idx = tid; idx < 32 * 64; idx += 512) { const int sl = idx >> 6, c2 = idx & 63, s = s0 + sl;
        const unsigned uv = *(const unsigned*)(Z + (size_t)(TP + s) * INW + 768 + g * 128 + 2 * c2);
        const float u0 = __uint_as_float(uv << 16), u1 = __uint_as_float(uv & 0xffff0000u);
        float a0 = u0, a1 = u1;
#pragma unroll
        for (int i = 0; i < 15; ++i) { if (i >= 16 - w) { const f32x2 sv = *(const f32x2*)(sp_l + ((size_t)s * 15 + i) * 512 + g * 128 + 2 * c2); a0 += sv.x; a1 += sv.y; } }
        const float ic = 1.0f / (float)w;
        *(LAS unsigned*)(Pg + sl * PU_LD + 2 * c2) = pk2(a0 * ic - u0, a1 * ic - u1); }
    __syncthreads();
    if (wid < 2) {
        f32x16 acc[2];
#pragma unroll
        for (int i = 0; i < 16; ++i) { acc[0][i] = 0.f; acc[1][i] = 0.f; }
#pragma unroll
        for (int ks = 0; ks < 8; ++ks) {
            const bf16x8 a = *(LAS const bf16x8*)(Pg + r * PU_LD + 16 * ks + 8 * hh);
#pragma unroll
            for (int qq = 0; qq < 2; ++qq) acc[qq] = MFMA32(a, bfr[ks][qq], acc[qq]);
        }
#pragma unroll
        for (int qq = 0; qq < 2; ++qq) { const int col = g * 128 + 32 * (wid * 2 + qq) + r; const float ps = pscale_l[col];
#pragma unroll
            for (int i = 0; i < 16; ++i) MIX[(size_t)(TP + s0 + crow(i, hh)) * DM + 512 + col] = (bf16_t)(pk2(acc[qq][i] * ps, 0.f) & 0xffffu); }
    }
    __syncthreads();
}

DI void states_copy(KP P, const bf16_t* Z, int l, int gtid, int GT) {
    float* out = P->out;
    for (int idx = gtid; idx < 8 * 128 * 32; idx += GT) { const int c4 = idx & 31, j = (idx >> 5) & 127, b = idx >> 12;
        const bf16_t* zr = Z + (size_t)(b * SEQ + SEQ - 128 + j) * INW + c4 * 4;
        *(f32x4*)(out + O_KP + ((size_t)(l * 8 + b) * 128 + j) * 128 + c4 * 4) = bf4_to_f4(zr + 512);
        *(f32x4*)(out + O_VP + ((size_t)(l * 8 + b) * 128 + j) * 128 + c4 * 4) = bf4_to_f4(zr + 640); }
    for (int idx = gtid; idx < 8 * 15 * 128; idx += GT) { const int c4 = idx & 127, bi = idx >> 7, i = bi % 15, b = bi / 15;
        *(f32x4*)(out + O_PP + ((size_t)(l * 8 + b) * 15 + i) * 512 + c4 * 4) = bf4_to_f4(Z + (size_t)(b * SEQ + SEQ - 15 + i) * INW + 768 + c4 * 4); }
    for (int idx = gtid; idx < 128 * 32; idx += GT) { const int c4 = idx & 31, s = idx >> 5;
        const bf16_t* zr = Z + (size_t)(TP + s) * INW + c4 * 4;
        *(f32x4*)(out + O_KS + ((size_t)(l * 128 + s) * 128 + 127) * 128 + c4 * 4) = bf4_to_f4(zr + 512);
        *(f32x4*)(out + O_VS + ((size_t)(l * 128 + s) * 128 + 127) * 128 + c4 * 4) = bf4_to_f4(zr + 640); }
    for (int idx = gtid; idx < 128 * 128; idx += GT) { const int c4 = idx & 127, s = idx >> 7;
        *(f32x4*)(out + O_PS + ((size_t)(l * 128 + s) * 15 + 14) * 512 + c4 * 4) = bf4_to_f4(Z + (size_t)(TP + s) * INW + 768 + c4 * 4); }
}
DI void states_shift(KP P, int t, int NT) {
    float* out = P->out; const float* ck = P->in[4]; const float* cv = P->in[5]; const float* sp = P->in[6];
#pragma unroll 4
    for (int idx = t; idx < 256 * 127 * 32; idx += NT) { const int ls = idx / (127 * 32), r = idx - ls * (127 * 32);
        const size_t so = (size_t)ls * 16384 + 128 + (size_t)r * 4, dd = (size_t)ls * 16384 + (size_t)r * 4;
        const f32x4 a = *(const f32x4*)(ck + so), b = *(const f32x4*)(cv + so);
        *(f32x4*)(out + O_KS + dd) = a; *(f32x4*)(out + O_VS + dd) = b; }
#pragma unroll 4
    for (int idx = t; idx < 256 * 14 * 128; idx += NT) { const int ls = idx / (14 * 128), r = idx - ls * (14 * 128);
        *(f32x4*)(out + O_PS + (size_t)ls * 7680 + (size_t)r * 4) = *(const f32x4*)(sp + (size_t)ls * 7680 + 512 + (size_t)r * 4); }
}

#define XB_TMO      128
#define XB_XCNT(j)  (256  + 64 * (j))
#define XB_XSUB(j)  (1280 + 64 * (j))
#define XB_XGEN(j)  (2304 + 64 * (j))
#define XB_TOP      3328
#define XB_TOPGEN   3392
#define XCD_BAR_WORDS 3456
#define XB_SPIN_CAP (1u << 18)

__device__ __forceinline__ unsigned xb_ld(unsigned* p)              { return __hip_atomic_load(p, __ATOMIC_RELAXED, __HIP_MEMORY_SCOPE_AGENT); }
__device__ __forceinline__ unsigned xb_add(unsigned* p, unsigned v) { return __hip_atomic_fetch_add(p, v, __ATOMIC_RELAXED, __HIP_MEMORY_SCOPE_AGENT); }
__device__ __forceinline__ unsigned xb_xcc_id() { return (unsigned)__builtin_amdgcn_s_getreg((3 << 11) | 20) & 0xFu; }
#define XB_SPIN(cond, bar) do { unsigned _sp = 0; while (cond) { __builtin_amdgcn_s_sleep(1); \
    if ((++_sp & 255u) == 0u) { if (xb_ld(&(bar)[XB_TMO])) break; if (_sp > XB_SPIN_CAP) { atomicAdd(&(bar)[XB_TMO], 1u); break; } } } } while (0)

struct XcdBarrier {
    unsigned* bar; unsigned x;
    volatile LAS unsigned* st;
};

__device__ __forceinline__ XcdBarrier xcd_barrier_post(unsigned* bar, volatile LAS unsigned* st) {
    XcdBarrier b; b.bar = bar; b.x = xb_xcc_id(); b.st = st;
    if (threadIdx.x == 0) (void)xb_add(&bar[XB_XCNT(b.x)], 1u);
    return b;
}
__device__ __forceinline__ void xcd_barrier_complete(unsigned* bar, unsigned x, unsigned& nloc, unsigned& nx) {
    const unsigned G = gridDim.x * gridDim.y * gridDim.z;
    unsigned sum, cnt, mine, sp = 0u;
    for (;;) {
        sum = 0u; cnt = 0u; mine = 0u;
#pragma unroll
        for (unsigned j = 0; j < 16; ++j) { const unsigned c = xb_ld(&bar[XB_XCNT(j)]); sum += c; cnt += (c > 0u) ? 1u : 0u; mine = (j == x) ? c : mine; }
        if (sum == G) break;
        __builtin_amdgcn_s_sleep(1);
        if ((++sp & 255u) == 0u) { if (xb_ld(&bar[XB_TMO])) break; if (sp > XB_SPIN_CAP) { atomicAdd(&bar[XB_TMO], 1u); break; } }
    }
    nloc = mine > 0u ? mine : 1u; nx = cnt > 0u ? cnt : 1u;
}

__device__ __forceinline__ void xcd_barrier(const XcdBarrier& b) {
    asm volatile("s_waitcnt vmcnt(0)" ::: "memory");
    __syncthreads();
    if (threadIdx.x == 0) {
        unsigned* bar = b.bar;
        __builtin_amdgcn_s_waitcnt(0);
        unsigned nloc = b.st[0], nx = b.st[1];
        if (nloc == 0u) { xcd_barrier_complete(bar, b.x, nloc, nx); b.st[0] = nloc; b.st[1] = nx; }
        const unsigned old = xb_add(&bar[XB_XSUB(b.x)], 1u);
        const unsigned gen = old / nloc;
        if (old + 1u == (gen + 1u) * nloc) {
            __builtin_amdgcn_fence(__ATOMIC_RELEASE, "agent");
            asm volatile("s_waitcnt vmcnt(0)" ::: "memory");
            const unsigned og = xb_add(&bar[XB_TOP], 1u);
            const unsigned tg = og / nx;
            if (og + 1u == (tg + 1u) * nx) xb_add(&bar[XB_TOPGEN], 1u);
            else XB_SPIN(xb_ld(&bar[XB_TOPGEN]) == tg, bar);
            __builtin_amdgcn_fence(__ATOMIC_ACQUIRE, "agent");
            xb_add(&bar[XB_XGEN(b.x)], 1u);
            asm volatile("s_waitcnt vmcnt(0)" ::: "memory");
        } else {
            XB_SPIN(xb_ld(&bar[XB_XGEN(b.x)]) == gen, bar);
            __builtin_amdgcn_fence(__ATOMIC_ACQUIRE, "agent");
            asm volatile("s_waitcnt vmcnt(0)" ::: "memory");
        }
    }
    __syncthreads();
}
DI KP kargs() { unsigned long long v = (unsigned long long)__builtin_amdgcn_kernarg_segment_ptr(); asm volatile("" : "+s"(v)); return (KP)v; }
#define PH_VARS KP Pk = kargs(); int tid = threadIdx.x; asm volatile("" : "+v"(tid)); const int lane = tid & 63, wid = __builtin_amdgcn_readfirstlane(tid >> 6); \
    const int G = gridDim.x, bx = blockIdx.x; const int gw = bx * 8 + wid, NGW = G * 8, gtid = bx * 512 + tid, GT = G * 512; unsigned char* ws = Pk->ws; (void)lane; (void)gw; (void)NGW; (void)gtid; (void)GT; (void)ws;
__global__ void __launch_bounds__(512, 2) fwd(Params Pdummy) {
    extern __shared__ __attribute__((aligned(16))) unsigned char lds_g[];
    LAS unsigned char* lds = (LAS unsigned char*)lds_g;
    cg::grid_group grid = cg::this_grid();
    int lo, hi; unsigned* barw; { KP Pk = kargs(); lo = Pk->ph_lo; hi = Pk->ph_hi; barw = (unsigned*)(Pk->ws + WS_BAR); }
    if (hi > 1000) grid.sync();
    if (threadIdx.x < 2) ((volatile LAS unsigned*)(lds + 131072))[threadIdx.x] = 0u;
    __syncthreads();
    XcdBarrier xb; xb.bar = barw; xb.x = 0; xb.st = nullptr;
    if (hi - lo > 1) xb = xcd_barrier_post(barw, (volatile LAS unsigned*)(lds + 131072));
#ifndef PROBE_REP
#define PROBE_REP -1
#endif
#ifndef PROBE_N
#define PROBE_N 0
#endif
#ifndef PROBE_MIX
#define PROBE_MIX 0
#endif
#ifndef STAG_TICKS
#define STAG_TICKS 0
#endif
#define STAGGER() do { if (STAG_TICKS > 0) { const unsigned long long t0_ = __builtin_amdgcn_s_memrealtime(); const unsigned long long d_ = (unsigned long long)((bx >> 3) & 3) * STAG_TICKS; while (__builtin_amdgcn_s_memrealtime() - t0_ < d_) __builtin_amdgcn_s_sleep(8); } } while (0)
#ifndef PROBE_SYNC
#define PROBE_SYNC 0
#endif
#define REPS(k) for (int rep_ = 0; rep_ < ((k) == PROBE_REP ? 1 + PROBE_N : 1); ++rep_)
#define IN(k) (lo <= (k) && (k) < hi)
#define SEAM(k) do { if (IN(k) && IN((k) + 1)) xcd_barrier(xb); } while (0)
    const bool merged = IN(0) && IN(1) && (int)gridDim.x > MODLD / 256;
    if (IN(0)) { PH_VARS
        prologue(Pk, lds, gw, NGW, gtid, GT, wid, lane);
        if (merged) {
            unsigned* flag = (unsigned*)(ws + WS_BAR) + 3840;
            asm volatile("s_waitcnt vmcnt(0)" ::: "memory"); __syncthreads();
            if (tid == 0) { __builtin_amdgcn_fence(__ATOMIC_RELEASE, "agent"); asm volatile("s_waitcnt vmcnt(0)" ::: "memory"); __hip_atomic_fetch_add(flag, 1u, __ATOMIC_RELAXED, __HIP_MEMORY_SCOPE_AGENT); }
            if (bx < MODLD / 256) {
                if (wid == 0) { unsigned sp = 0;
                    while ((unsigned)__builtin_amdgcn_readfirstlane(__hip_atomic_load(flag, __ATOMIC_RELAXED, __HIP_MEMORY_SCOPE_AGENT)) < (unsigned)G) { __builtin_amdgcn_s_sleep(2); if (++sp > (1u << 22)) break; }
                    __builtin_amdgcn_fence(__ATOMIC_ACQUIRE, "agent"); asm volatile("s_waitcnt vmcnt(0)" ::: "memory"); }
                __syncthreads();
                pg8::Gemm g{(const bf16_t*)(ws + WS_CS), (const bf16_t*)(ws + WS_WADA), 256, MODLD, DM}; pg8::StaticOrder S; S.init(256, MODLD, G, bx);
                EpiMod E{(float*)(ws + WS_MOD), Pk->in[8]};
                pg8::gemm_phase<EpiMod, pg8::StaticOrder, PG8_ALIGN, PG8_SP2>(lds, g, S, E, tid);
            } else {
                prologue_rest(Pk, lds, (bx - MODLD / 256) * 8 + wid, (G - MODLD / 256) * 8, wid, lane);
            }
        } else prologue_rest(Pk, lds, gw, NGW, wid, lane);
    }
    SEAM(0);
    for (int i_ = 0; i_ < PROBE_SYNC; ++i_) xcd_barrier(xb);
    if (IN(1) && !merged) { PH_VARS
        pg8::Gemm g{(const bf16_t*)(ws + WS_CS), (const bf16_t*)(ws + WS_WADA), 256, MODLD, DM}; pg8::StaticOrder S; S.init(256, MODLD, G, bx);
        EpiMod E{(float*)(ws + WS_MOD), Pk->in[8]};
        pg8::gemm_phase<EpiMod, pg8::StaticOrder, PG8_ALIGN, PG8_SP2>(lds, g, S, E, tid);
        states_shift(Pk, gtid, GT);
    }
    if (!merged) SEAM(1);
#pragma unroll 1
    for (int l = 0; l < 2; ++l) {
        const int pb = 2 + 10 * l;
#define LAYER_VARS unsigned char* wl = ws + WS_L0 + (size_t)l * LAYER_BYTES; bf16_t* XB = (bf16_t*)(ws + WS_X); float* XS = (float*)(ws + WS_XS); float* XSv = XS - (size_t)TP * DM; float* PART = (float*)(ws + WS_WADA); bf16_t* H = (bf16_t*)(ws + WS_H); bf16_t* ACT = (bf16_t*)(ws + WS_ACT); bf16_t* Z = (bf16_t*)(ws + WS_Z); bf16_t* MIX = (bf16_t*)(ws + WS_MIX); \
        const float* modl = (const float*)(ws + WS_MOD) + (size_t)l * NMOD; const float* gain_l = Pk->in[9] + (size_t)l * 3 * DM; \
        (void)wl; (void)XB; (void)XS; (void)XSv; (void)PART; (void)H; (void)ACT; (void)Z; (void)MIX; (void)modl; (void)gain_l;
        if (IN(pb + 0)) REPS(pb + 0) { PH_VARS LAYER_VARS
            if (l == 0) { norm_phase<false>(Pk->in[0], nullptr, gain_l, modl, H, nullptr, gw, NGW, lane, nullptr, 0, TP / 16); norm_sample<false>(Pk->in[1], gain_l, modl, H, nullptr, gw, NGW, lane, XSv, nullptr, 0); }
            else { norm_phase_bf<false>(XB, gain_l, modl, H, nullptr, gw, NGW, lane); norm_sample<false>(XS, gain_l, modl, H, nullptr, gw, NGW, lane, XSv, PART, FF / 256); } }
        SEAM(pb + 0);
        if (IN(pb + 1)) REPS(pb + 1) { PH_VARS LAYER_VARS
            pg8::Gemm g{H, (const bf16_t*)(wl + LW_GU1), MPAD, 2 * FF, DM}; TailOrder S; S.init(2 * FF, G, bx);
            EpiSwiGLU E{ACT};
            pg8::gemm_phase<EpiSwiGLU, TailOrder, PG8_ALIGN, PG8_SP2>(lds, g, S, E, tid);
        }
        SEAM(pb + 1);
        if (IN(pb + 2)) REPS(pb + 2) { PH_VARS LAYER_VARS
            pg8::Gemm g{ACT, (const bf16_t*)(wl + LW_D1), MPAD, DM, FF}; SplitOrder S; S.init(DM, FF, G, bx);
            EpiResid E{l == 0 ? Pk->in[0] : nullptr, XB, PART, modl + 2 * DM, 0.5f};
            STAGGER(); pg8::gemm_phase<EpiResid, SplitOrder, PG8_ALIGN, PG8_SP2>(lds, g, S, E, tid);
        }
        SEAM(pb + 2);
        if (IN(pb + 3)) REPS(pb + 3) { PH_VARS LAYER_VARS norm_phase_bf<false>(XB, gain_l + DM, modl + 3 * DM, H, nullptr, gw, NGW, lane); norm_sample<false>(XS, gain_l + DM, modl + 3 * DM, H, nullptr, gw, NGW, lane, XSv, PART, FF / 256); }
        SEAM(pb + 3);
        if (IN(pb + 4)) REPS(pb + 4) { PH_VARS LAYER_VARS
            pg8::Gemm g{H, (const bf16_t*)(wl + LW_IN), MPAD, INW, DM}; TailOrder S; S.init(INW, G, bx);
            EpiStoreBf16 E{Z, INW};
            pg8::gemm_phase<EpiStoreBf16, TailOrder, PG8_ALIGN, PG8_SP2>(lds, g, S, E, tid);
            if (l == 0 && merged) {
                constexpr int NB3 = (TP / 256 * (INW / 256) + INW / 256) - 512;
                if (G <= NB3 + 16) states_shift(Pk, gtid, GT); else if (bx >= NB3) states_shift(Pk, (bx - NB3) * 512 + tid, (G - NB3) * 512);
            }
        }
        SEAM(pb + 4);
        if (IN(pb + 5)) REPS(pb + 5) { PH_VARS LAYER_VARS
            const float* TB = (const float*)(ws + WS_TB);
            const float* sinks_l = Pk->in[12] + l * 8;
            const float* ck = Pk->in[4] + (size_t)l * 128 * 128 * 128; const float* cv = Pk->in[5] + (size_t)l * 128 * 128 * 128; const float* sp = Pk->in[6] + (size_t)l * 128 * 15 * 512;
            for (int id = bx; id < 816; id += G) {
                if (id < 512) { for (int rp = 0; rp < (PROBE_MIX == 1 ? 2 : 1); ++rp) { const int kvh = id & 1, bn = id >> 1; attn_unit(lds, Z, MIX, TB, sinks_l, bn >> 5, bn & 31, kvh, tid); } }
                else if (id < 784) { for (int rp = 0; rp < (PROBE_MIX == 2 ? 2 : 1); ++rp) { if (id < 768) pool_unit(lds, Z, (const bf16_t*)(wl + LW_POOL), Pk->in[15] + l * 512, MIX, id - 512, tid); else pool_unit_sample(lds, Z, sp, (const bf16_t*)(wl + LW_POOL), Pk->in[15] + l * 512, MIX, id - 768, tid); } }
                else { for (int rp = 0; rp < (PROBE_MIX == 3 ? 2 : 1); ++rp) { const int task = (id - 784) * 8 + wid; sattn_task((LAS float*)(lds + wid * 4096), Z, ck, cv, MIX, TB, sinks_l, task >> 1, task & 1, lane); __syncthreads(); } }
            }
            for (int rp = 0; rp < (PROBE_MIX == 4 ? 2 : 1); ++rp) states_copy(Pk, Z, l, gtid, GT);
        }
        SEAM(pb + 5);
        if (IN(pb + 6)) REPS(pb + 6) { PH_VARS LAYER_VARS
            pg8::Gemm g{MIX, (const bf16_t*)(wl + LW_OUT), MPAD, DM, DM}; SplitOrder S; S.init(DM, DM, G, bx);
            EpiResid E{nullptr, XB, PART, modl + 5 * DM, 1.0f};
            STAGGER(); pg8::gemm_phase<EpiResid, SplitOrder, PG8_ALIGN, PG8_SP2>(lds, g, S, E, tid);
        }
        SEAM(pb + 6);
        if (IN(pb + 7)) REPS(pb + 7) { PH_VARS LAYER_VARS norm_phase_bf<false>(XB, gain_l + 2 * DM, modl + 6 * DM, H, nullptr, gw, NGW, lane); norm_sample<false>(XS, gain_l + 2 * DM, modl + 6 * DM, H, nullptr, gw, NGW, lane, XSv, PART, DM / 256); }
        SEAM(pb + 7);
        if (IN(pb + 8)) REPS(pb + 8) { PH_VARS LAYER_VARS
            pg8::Gemm g{H, (const bf16_t*)(wl + LW_GU2), MPAD, 2 * FF, DM}; TailOrder S; S.init(2 * FF, G, bx);
            EpiSwiGLU E{ACT};
            pg8::gemm_phase<EpiSwiGLU, TailOrder, PG8_ALIGN, PG8_SP2>(lds, g, S, E, tid);
        }
        SEAM(pb + 8);
        if (IN(pb + 9)) REPS(pb + 9) { PH_VARS LAYER_VARS
            pg8::Gemm g{ACT, (const bf16_t*)(wl + LW_D2), MPAD, DM, FF}; SplitOrder S; S.init(DM, FF, G, bx);
            EpiResid E{nullptr, XB, PART, modl + 8 * DM, 0.5f};
            STAGGER(); pg8::gemm_phase<EpiResid, SplitOrder, PG8_ALIGN, PG8_SP2>(lds, g, S, E, tid);
        }
        SEAM(pb + 9);
    }
    if (IN(22)) REPS(22) { PH_VARS norm_phase_bf<true>((const bf16_t*)(ws + WS_X), Pk->in[22], nullptr, nullptr, Pk->out, gw, NGW, lane); norm_sample<true>((const float*)(ws + WS_XS), Pk->in[22], nullptr, nullptr, Pk->out, gw, NGW, lane, nullptr, (const float*)(ws + WS_WADA), FF / 256); }
#undef IN
#undef SEAM
}

extern "C" void kernel_launch(void* const* d_in, const int* in_sizes, int n_in, void* d_out, int out_size, void* d_ws, size_t ws_size, hipStream_t stream) {
    static int grid = 0;
    if (grid == 0) {
        if (n_in != 23 || (size_t)out_size != O_END || ws_size < WS_END) { fprintf(stderr, "kernel_launch: unexpected sizes n_in %d out %d ws %zu\n", n_in, out_size, ws_size); grid = -1; return; }
        int dev = 0, cus = 0, per_cu = 0;
        (void)hipGetDevice(&dev); (void)hipDeviceGetAttribute(&cus, hipDeviceAttributeMultiprocessorCount, dev);
        if (hipFuncSetAttribute((const void*)fwd, hipFuncAttributeMaxDynamicSharedMemorySize, LDS_BYTES) != hipSuccess) { fprintf(stderr, "kernel_launch: hipFuncSetAttribute failed\n"); grid = -1; return; }
        if (hipOccupancyMaxActiveBlocksPerMultiprocessor(&per_cu, (const void*)fwd, 512, LDS_BYTES) != hipSuccess || per_cu < 1) { fprintf(stderr, "kernel_launch: occupancy query says %d\n", per_cu); per_cu = 1; }
        (void)hipGetLastError();
        grid = cus * per_cu;
    }
    if (grid < 0) return;
    Params p{};
    for (int i = 0; i < 23; ++i) p.in[i] = (const float*)d_in[i];
    p.out = (float*)d_out; p.ws = (unsigned char*)d_ws;
#if N_LAUNCH_PER_PHASE
    for (int ph = 0; ph < NPH; ++ph) { p.ph_lo = ph; p.ph_hi = ph + 1; hipLaunchKernelGGL(fwd, dim3(grid), dim3(512), LDS_BYTES, stream, p); }
#else
    p.ph_lo = 0; p.ph_hi = NPH;
    if (hipMemsetAsync((char*)d_ws + WS_BAR, 0, WS_BAR_BYTES, stream) != hipSuccess) { fprintf(stderr, "kernel_launch: memset failed\n"); return; }
    void* args[] = {&p};
    hipError_t e = hipLaunchCooperativeKernel((const void*)fwd, dim3(grid), dim3(512), args, LDS_BYTES, stream);
    if (e != hipSuccess) fprintf(stderr, "kernel_launch: cooperative launch failed: %s (grid %d)\n", hipGetErrorString(e), grid);
#endif
}
```

```cpp
#define STAG_TICKS 0
#include <hip/hip_runtime.h>
#include <hip/hip_cooperative_groups.h>
#include <cstdio>
#include <cstdint>
namespace cg = cooperative_groups;
namespace pg8 {
#define PG8_LAS __attribute__((address_space(3)))
typedef unsigned short bf16_t;
typedef short bf16x8 __attribute__((ext_vector_type(8)));
typedef float f32x4 __attribute__((ext_vector_type(4)));
typedef unsigned u32x4 __attribute__((ext_vector_type(4)));
constexpr int BM = 256, BK = 64, HALF = 128, HTB = HALF * BK * 2  , STAGE_BYTES = 8 * HTB, NXCD = 8, WGM = 8;

__host__ __device__ __forceinline__ int lds_byte(int r, int c) { const int st = (r >> 4) * 2 + (c >> 5), rr = r & 15, cc = c & 31, ob = rr * 64 + cc * 2; return st * 1024 + (ob ^ (((ob >> 9) & 1) << 5)); }
__host__ __device__ __forceinline__ void stage_rc(int b, int& R, int& C) { const int st = b / 1024, sb = b % 1024, swz = sb ^ (((sb >> 9) & 1) << 5); R = (st >> 1) * 16 + swz / 64; C = (st & 1) * 32 + (swz % 64) / 2; }
__host__ __device__ __forceinline__ int perm32(int rho) { const int n = rho >> 4, i = rho & 15; return 8 * (i >> 2) + 4 * n + (i & 3); }

struct Unit { int pm, pn, k0; };
struct Gemm { const bf16_t* A; const bf16_t* Bt; int M, N, K; };

struct StaticOrder {
    static constexpr bool SPLIT = false;
    int nM, nN, nwg, G, c;
    __host__ __device__ void init(int M, int N, int G_, int c_, int K_ = 1024, int half_pm_ = -1) { nM = M / BM; nN = N / BM; nwg = nM * nN; G = G_; c = c_; (void)K_; (void)half_pm_; }
    __host__ __device__ bool next(int i, Unit& u) const {
        const long L = (long)i * G + c; if (L >= nwg) return false;
        int wgid = (int)L; { const int q = nwg / NXCD, r = nwg % NXCD, xcd = wgid % NXCD, off = wgid / NXCD; wgid = (xcd < r ? xcd * (q + 1) : r * (q + 1) + (xcd - r) * q) + off; }
        const int nig = WGM * nN, gid = wgid / nig, fm = gid * WGM, gsz = (nM - fm) < WGM ? (nM - fm) : WGM;
        u.pm = fm + ((wgid % nig) % gsz); u.pn = (wgid % nig) / gsz; u.k0 = 0; return true;
    }
    __device__ __forceinline__ void a_ready(const Unit&) const {}
    __device__ __forceinline__ void done(const Unit&) const {}
};

__device__ __forceinline__ unsigned cvt_pk_bf16(float lo, float hi) { unsigned r; asm volatile("v_cvt_pk_bf16_f32 %0, %1, %2" : "=v"(r) : "v"(lo), "v"(hi)); return r; }
typedef float f32x2 __attribute__((ext_vector_type(2)));
template <class Epi, class Sched, bool ALIGN_EPI = false, bool SP2 = false>
__device__ __forceinline__ void gemm_phase(PG8_LAS unsigned char* lds, const Gemm g, const Sched& S, const Epi& E, const int tid_in) {
    const int tid = tid_in, wid = __builtin_amdgcn_readfirstlane(tid >> 6), lane = tid & 63, wr = wid >> 2, wc = wid & 3, fr = lane & 15, fq = lane >> 4;
    const int K = g.K;
    unsigned voffA[2], voffB[2];
#pragma unroll
    for (int i = 0; i < 2; ++i) { int R, C; stage_rc(tid * 16 + i * 8192, R, C); const int Rb = Epi::PERM ? ((R & ~31) + perm32(R & 31)) : R;
        voffA[i] = (unsigned)(R * K + C) * 2u; voffB[i] = (unsigned)(Rb * K + C) * 2u; }
    const size_t kstep = (size_t)(BK * 2);
    const size_t hstep = (size_t)HALF * K * 2;
    const size_t tstep = 2 * hstep;
    const unsigned ldsw = (unsigned)wid * 1024u;
    const int aoff = lds_byte(wr * 64 + fr, fq * 8), boff = lds_byte(wc * 32 + fr, fq * 8);
#define PG8_SA(b, h) (((b) * 2 + (h)) * HTB)
#define PG8_SB(b, h) ((4 + (b) * 2 + (h)) * HTB)
#define PG8_STAGE(bufoff, gbase, voff) do { _Pragma("unroll") for (int _i = 0; _i < 2; ++_i) \
        __builtin_amdgcn_global_load_lds((const unsigned*)((const char*)(gbase) + (voff)[_i]), (PG8_LAS unsigned*)(lds + (bufoff) + ldsw + _i * 8192), 16, 0, 0); } while (0)
#define PG8_LDA(dst, b, h) do { _Pragma("unroll") for (int m = 0; m < 4; ++m) _Pragma("unroll") for (int k = 0; k < 2; ++k) dst[m][k] = *(const PG8_LAS bf16x8*)(lds + PG8_SA(b, h) + aoff + m * 2048 + k * 1024); } while (0)
#define PG8_LDB(dst, b, h) do { _Pragma("unroll") for (int n = 0; n < 2; ++n) _Pragma("unroll") for (int k = 0; k < 2; ++k) dst[n][k] = *(const PG8_LAS bf16x8*)(lds + PG8_SB(b, h) + boff + n * 2048 + k * 1024); } while (0)
#define PG8_MMA(ai, bj, At, Bt) do { __builtin_amdgcn_s_setprio(1); _Pragma("unroll") for (int m = 0; m < 4; ++m) _Pragma("unroll") for (int n = 0; n < 2; ++n) _Pragma("unroll") for (int k = 0; k < 2; ++k) \
        acc[ai][bj][m][n] = __builtin_amdgcn_mfma_f32_16x16x32_bf16(Bt[n][k], At[m][k], acc[ai][bj][m][n], 0, 0, 0); __builtin_amdgcn_s_setprio(0); } while (0)
#define PG8_WAIT_V(n) asm volatile("s_waitcnt vmcnt(" #n ")" ::: "memory")
#define PG8_WAIT_L(n) asm volatile("s_waitcnt lgkmcnt(" #n ")" ::: "memory")
#define PG8_BAR __builtin_amdgcn_s_barrier()
#define PG8_SCHED __builtin_amdgcn_sched_barrier(0)
    Unit cur, nxt; int ui = 0;
    if (!S.next(0, cur)) return;
    f32x4 acc[2][2][4][2];
#pragma unroll
    for (int a = 0; a < 2; ++a)
#pragma unroll
        for (int b = 0; b < 2; ++b)
#pragma unroll
            for (int m = 0; m < 4; ++m)
#pragma unroll
                for (int n = 0; n < 2; ++n) acc[a][b][m][n] = (f32x4){0.f, 0.f, 0.f, 0.f};
    bf16x8 At[4][2], B0[2][2], B1[2][2];
    const char* cA = (const char*)g.A + (size_t)cur.pm * tstep + (size_t)cur.k0 * kstep; const char* cB = (const char*)g.Bt + (size_t)cur.pn * tstep + (size_t)cur.k0 * kstep;
    S.a_ready(cur);
    if constexpr (SP2) {
        PG8_STAGE(PG8_SB(0, 0), cB, voffB); PG8_STAGE(PG8_SB(0, 1), cB + hstep, voffB); PG8_STAGE(PG8_SA(0, 0), cA, voffA); PG8_STAGE(PG8_SA(0, 1), cA + hstep, voffA);
        if (wr == 1) PG8_BAR;
        PG8_WAIT_V(2); PG8_BAR;
        PG8_STAGE(PG8_SB(1, 0), cB + kstep, voffB); PG8_STAGE(PG8_SA(1, 0), cA + kstep, voffA); PG8_STAGE(PG8_SB(1, 1), cB + hstep + kstep, voffB);
        PG8_WAIT_V(6); PG8_BAR;
    } else {
        PG8_STAGE(PG8_SB(0, 0), cB, voffB); PG8_STAGE(PG8_SA(0, 0), cA, voffA); PG8_STAGE(PG8_SB(0, 1), cB + hstep, voffB); PG8_STAGE(PG8_SA(0, 1), cA + hstep, voffA);
        if (wr == 1) PG8_BAR;
        PG8_WAIT_V(4); PG8_BAR;
        PG8_STAGE(PG8_SB(1, 0), cB + kstep, voffB); PG8_STAGE(PG8_SA(1, 0), cA + kstep, voffA); PG8_STAGE(PG8_SB(1, 1), cB + hstep + kstep, voffB);
        PG8_WAIT_V(6); PG8_BAR;
    }
    for (;;) {
        const bool has_next = S.next(ui + 1, nxt);
        const char* nA = has_next ? (const char*)g.A + (size_t)nxt.pm * tstep + (size_t)nxt.k0 * kstep : cA; const char* nB = has_next ? (const char*)g.Bt + (size_t)nxt.pn * tstep + (size_t)nxt.k0 * kstep : cB;
        const bool full = (cur.pm != 128); const int nt = (Sched::SPLIT && !full) ? 4 : K / BK;
        for (int t = 0; t < nt; t += 2) {
            const bool last = (t == nt - 2);
            const char* a1 = cA + (size_t)(t + 1) * kstep;
            const char* a2 = last ? nA : cA + (size_t)(t + 2) * kstep; const char* b2 = last ? nB : cB + (size_t)(t + 2) * kstep;
            const char* a3 = a2 + kstep; const char* b3 = b2 + kstep;
            if (last && has_next) S.a_ready(nxt);
            if constexpr (SP2) {
            PG8_LDB(B0, 0, 0); PG8_LDB(B1, 0, 1); PG8_SCHED; PG8_LDA(At, 0, 0); PG8_STAGE(PG8_SA(1, 1), a1 + hstep, voffA);
            PG8_WAIT_V(8); PG8_WAIT_L(0); PG8_BAR; PG8_MMA(0, 0, At, B0); PG8_MMA(0, 1, At, B1); PG8_BAR; PG8_SCHED;
            PG8_LDA(At, 0, 1); PG8_STAGE(PG8_SB(0, 0), b2, voffB); PG8_STAGE(PG8_SB(0, 1), b2 + hstep, voffB); PG8_STAGE(PG8_SA(0, 0), a2, voffA);
            PG8_WAIT_V(8); PG8_WAIT_L(0); PG8_BAR; if (full) { PG8_MMA(1, 0, At, B0); PG8_MMA(1, 1, At, B1); } PG8_BAR; PG8_SCHED;
            PG8_LDB(B0, 1, 0); PG8_LDB(B1, 1, 1); PG8_SCHED; PG8_LDA(At, 1, 0); PG8_STAGE(PG8_SA(0, 1), a2 + hstep, voffA);
            PG8_WAIT_V(8); PG8_WAIT_L(0); PG8_BAR; PG8_MMA(0, 0, At, B0); PG8_MMA(0, 1, At, B1); PG8_BAR; PG8_SCHED;
            PG8_LDA(At, 1, 1); PG8_STAGE(PG8_SB(1, 0), b3, voffB); PG8_STAGE(PG8_SB(1, 1), b3 + hstep, voffB); PG8_STAGE(PG8_SA(1, 0), a3, voffA);
            PG8_WAIT_V(8); PG8_WAIT_L(0); PG8_BAR; if (full) { PG8_MMA(1, 0, At, B0); PG8_MMA(1, 1, At, B1); } PG8_BAR; PG8_SCHED;
            } else {
            PG8_LDB(B0, 0, 0); PG8_SCHED; PG8_LDA(At, 0, 0); PG8_STAGE(PG8_SA(1, 1), a1 + hstep, voffA);
            PG8_WAIT_L(8); PG8_BAR; PG8_WAIT_L(0); PG8_MMA(0, 0, At, B0); PG8_BAR; PG8_SCHED;
            PG8_LDB(B1, 0, 1); PG8_STAGE(PG8_SB(0, 0), b2, voffB);
            PG8_BAR; PG8_WAIT_L(0); PG8_MMA(0, 1, At, B1); PG8_BAR;
            PG8_LDA(At, 0, 1); PG8_STAGE(PG8_SA(0, 0), a2, voffA);
            PG8_BAR; PG8_WAIT_L(0); PG8_MMA(1, 0, At, B0); PG8_BAR; PG8_SCHED;
            PG8_STAGE(PG8_SB(0, 1), b2 + hstep, voffB);
            PG8_WAIT_V(6); PG8_BAR; PG8_MMA(1, 1, At, B1); PG8_BAR;
            PG8_LDB(B0, 1, 0); PG8_SCHED; PG8_LDA(At, 1, 0); PG8_STAGE(PG8_SA(0, 1), a2 + hstep, voffA);
            PG8_WAIT_L(8); PG8_BAR; PG8_WAIT_L(0); PG8_MMA(0, 0, At, B0); PG8_BAR; PG8_SCHED;
            PG8_LDB(B1, 1, 1); PG8_STAGE(PG8_SB(1, 0), b3, voffB);
            PG8_BAR; PG8_WAIT_L(0); PG8_MMA(0, 1, At, B1); PG8_BAR;
            PG8_LDA(At, 1, 1); PG8_STAGE(PG8_SA(1, 0), a3, voffA);
            PG8_BAR; PG8_WAIT_L(0); PG8_MMA(1, 0, At, B0); PG8_BAR; PG8_SCHED;
            PG8_STAGE(PG8_SB(1, 1), b3 + hstep, voffB);
            PG8_WAIT_V(6); PG8_BAR; PG8_MMA(1, 1, At, B1); PG8_BAR;
            }
        }
        if constexpr (ALIGN_EPI) { if (wr == 0) PG8_BAR; }
        if constexpr (!Epi::AFTER_DRAIN) { E(acc, cur, wr, wc, fr, fq); S.done(cur); }
        if (!has_next) break;
#pragma unroll
        for (int a = 0; a < 2; ++a)
#pragma unroll
            for (int b = 0; b < 2; ++b)
#pragma unroll
                for (int m = 0; m < 4; ++m)
#pragma unroll
                    for (int n = 0; n < 2; ++n) acc[a][b][m][n] = (f32x4){0.f, 0.f, 0.f, 0.f};
        cur = nxt; cA = nA; cB = nB; ++ui;
        if constexpr (ALIGN_EPI) { if (wr == 1) PG8_BAR; }
    }
    PG8_WAIT_V(0);
    if constexpr (!ALIGN_EPI) { if (wr == 0) PG8_BAR; }
    PG8_BAR;
    if constexpr (Epi::AFTER_DRAIN) { E.fused(acc, cur, wr, wc, fr, fq, lds, wid, lane); S.done(cur); }
#undef PG8_SA
#undef PG8_SB
#undef PG8_STAGE
#undef PG8_LDA
#undef PG8_LDB
#undef PG8_MMA
#undef PG8_WAIT_V
#undef PG8_WAIT_L
#undef PG8_BAR
#undef PG8_SCHED
}
}
#ifndef PG8_SP2
#define PG8_SP2 true
#endif
#ifndef PG8_ALIGN
#define PG8_ALIGN true
#endif
#ifndef N_LAUNCH_PER_PHASE
#define N_LAUNCH_PER_PHASE 0
#endif

#define DI __device__ __forceinline__
#define LAS __attribute__((address_space(3)))
typedef unsigned short bf16_t;
typedef short bf16x8 __attribute__((ext_vector_type(8)));
typedef short s16x4 __attribute__((ext_vector_type(4)));
typedef float f32x4 __attribute__((ext_vector_type(4)));
typedef float f32x2 __attribute__((ext_vector_type(2)));
typedef float f32x16 __attribute__((ext_vector_type(16)));
typedef unsigned u32x4 __attribute__((ext_vector_type(4)));
typedef unsigned u32x2 __attribute__((ext_vector_type(2)));
typedef __bf16 bf16x2_t __attribute__((ext_vector_type(2)));

constexpr int TP = 32768, TS = 128, TT = TP + TS, MPAD = 33024;
constexpr int DM = 1024, FF = 2816, INW = 1280, NMOD = 9216, MODLD = 2 * NMOD;
constexpr int SEQ = 4096;
constexpr float EPS = 1e-6f, LOG2E = 1.4426950408889634f, C2 = 0.125f * 1.4426950408889634f;
constexpr int TBLD = 132;
constexpr size_t O_Y = 0, O_KP = 33685504, O_VP = 33947648, O_PP = 34209792, O_KS = 34332672, O_VS = 38526976, O_PS = 42721280, O_END = 44687360;
constexpr size_t MiB = 1u << 20;
constexpr size_t WS_XS = 1 * (1u << 20) + 512 * 1024;
constexpr size_t WS_BAR = 65536, WS_BAR_BYTES = 16384;
constexpr size_t WS_TB = 0, WS_CS = 1 * MiB, WS_MOD = 2 * MiB, WS_WADA = 12 * MiB, WS_L0 = 48 * MiB, LAYER_BYTES = 38 * MiB;
constexpr size_t LW_GU1 = 0, LW_D1 = 11 * MiB, LW_IN = 16 * MiB + MiB / 2, LW_OUT = 19 * MiB, LW_GU2 = 21 * MiB, LW_D2 = 32 * MiB, LW_POOL = 37 * MiB + MiB / 2;
constexpr size_t WS_X = 124 * MiB, WS_H = 253 * MiB, WS_ACT = 318 * MiB, WS_Z = WS_ACT, WS_MIX = WS_ACT + 96 * MiB, WS_END = 496 * MiB;
static_assert(WS_X + (size_t)MPAD * DM * 4 <= WS_H && WS_H + (size_t)MPAD * DM * 2 <= WS_ACT && WS_ACT + (size_t)MPAD * FF * 2 <= WS_END, "ws map");
static_assert(WS_Z + (size_t)MPAD * INW * 2 <= WS_MIX && WS_MIX + (size_t)MPAD * DM * 2 <= WS_END, "ws map 2");
static_assert(WS_MOD + (size_t)136 * MODLD * 4 <= WS_WADA && WS_WADA + (size_t)MODLD * DM * 2 <= WS_L0 && WS_L0 + 2 * LAYER_BYTES <= WS_X, "ws map 3");
constexpr int LDS_BYTES = 147456;
constexpr int NPH = 23;

struct Params { const float* in[23]; float* out; unsigned char* ws; int ph_lo, ph_hi; };

DI float bf2f(bf16_t b) { return __uint_as_float((unsigned)b << 16); }
DI unsigned pk2(float lo, float hi) { f32x2 v = {lo, hi}; bf16x2_t b = __builtin_convertvector(v, bf16x2_t); return __builtin_bit_cast(unsigned, b); }
DI float wave_sum(float v) {
#pragma unroll
    for (int o = 1; o < 64; o <<= 1) v += __shfl_xor(v, o);
    return v;
}
DI float wave_max(float v) {
#pragma unroll
    for (int o = 1; o < 64; o <<= 1) v = fmaxf(v, __shfl_xor(v, o));
    return v;
}
DI int crow(int r, int hi) { return (r & 3) + 8 * (r >> 2) + 4 * hi; }
DI f32x4 bf4_to_f4(const bf16_t* p) { const u32x2 v = *(const u32x2*)p; return (f32x4){__uint_as_float(v.x << 16), __uint_as_float(v.x & 0xffff0000u), __uint_as_float(v.y << 16), __uint_as_float(v.y & 0xffff0000u)}; }
#define MFMA32(a, b, c) __builtin_amdgcn_mfma_f32_32x32x16_bf16((a), (b), (c), 0, 0, 0)

struct EpiStoreBf16 {
    static constexpr bool PERM = true, AFTER_DRAIN = false;
    bf16_t* O; int ldc;
    DI void operator()(const pg8::f32x4 (&acc)[2][2][4][2], const pg8::Unit& u, int wr, int wc, int fr, int fq) const {
        const int row0 = u.pm * 256 + wr * 64 + fr, col0 = u.pn * 256 + wc * 32 + 8 * fq;
#pragma unroll
        for (int ai = 0; ai < 2; ++ai)
#pragma unroll
            for (int m = 0; m < 4; ++m) { bf16_t* rowp = O + (size_t)(row0 + ai * 128 + m * 16) * ldc + col0;
#pragma unroll
                for (int bj = 0; bj < 2; ++bj) { const f32x4 v0 = acc[ai][bj][m][0], v1 = acc[ai][bj][m][1];
                    u32x4 w; w.x = pk2(v0[0], v0[1]); w.y = pk2(v0[2], v0[3]); w.z = pk2(v1[0], v1[1]); w.w = pk2(v1[2], v1[3]);
                    *(u32x4*)(rowp + bj * 128) = w; } }
    }
};
DI float silu_mul(float g, float u) { return g * u * __builtin_amdgcn_rcpf(1.0f + __builtin_amdgcn_exp2f(-g * LOG2E)); }
struct EpiSwiGLU {
    static constexpr bool PERM = true, AFTER_DRAIN = false;
    bf16_t* O;
    DI void operator()(const pg8::f32x4 (&acc)[2][2][4][2], const pg8::Unit& u, int wr, int wc, int fr, int fq) const {
        const int row0 = u.pm * 256 + wr * 64 + fr, col0 = u.pn * 128 + wc * 32 + 8 * fq;
#pragma unroll
        for (int ai = 0; ai < 2; ++ai)
#pragma unroll
            for (int m = 0; m < 4; ++m) { bf16_t* rowp = O + (size_t)(row0 + ai * 128 + m * 16) * FF + col0;
                const f32x4 g0 = acc[ai][0][m][0], g1 = acc[ai][0][m][1], u0 = acc[ai][1][m][0], u1 = acc[ai][1][m][1];
                u32x4 w; w.x = pk2(silu_mul(g0[0], u0[0]), silu_mul(g0[1], u0[1])); w.y = pk2(silu_mul(g0[2], u0[2]), silu_mul(g0[3], u0[3]));
                w.z = pk2(silu_mul(g1[0], u1[0]), silu_mul(g1[1], u1[1])); w.w = pk2(silu_mul(g1[2], u1[2]), silu_mul(g1[3], u1[3]));
                *(u32x4*)rowp = w; }
    }
};
struct TailOrder {
    static constexpr bool SPLIT = false;
    pg8::StaticOrder base; int nmain, nN, G, c;
    DI void init(int N, int G_, int c_) { base.init(TP, N, G_, c_); nN = N / 256; nmain = (TP / 256) * nN; G = G_; c = c_; }
    DI bool next(int i, pg8::Unit& u) const {
        const int L = i * G + c;
        if (L < nmain) return base.next(i, u);
        const int s = L - nmain; if (s >= nN) return false;
        u.pm = TP / 256; u.pn = s; u.k0 = 0; return true;
    }
    DI void a_ready(const pg8::Unit&) const {}
    DI void done(const pg8::Unit&) const {}
};
struct SplitOrder {
    static constexpr bool SPLIT = true;
    pg8::StaticOrder base; int nmain, nN, nchunk, G, c;
    DI void init(int N, int K, int G_, int c_) { base.init(TP, N, G_, c_, K, -1); nN = N / 256; nmain = (TP / 256) * nN; nchunk = K / 256; G = G_; c = c_; }
    DI bool next(int i, pg8::Unit& u) const {
        const int L = i * G + c;
        if (L < nmain) return base.next(i, u);
        const int s = L - nmain; if (s >= nN * nchunk) return false;
        u.pm = TP / 256; u.pn = s % nN; u.k0 = (s / nN) * 4; return true;
    }
    DI void a_ready(const pg8::Unit&) const {}
    DI void done(const pg8::Unit&) const {}
};
struct EpiResid {
    static constexpr bool PERM = true, AFTER_DRAIN = false;
    const float* xin_f32; bf16_t* XB; float* PART; const float* gate; float coef;
    DI void operator()(const pg8::f32x4 (&acc)[2][2][4][2], const pg8::Unit& u, int wr, int wc, int fr, int fq) const {
        const int row0 = u.pm * 256 + wr * 64 + fr, col0 = u.pn * 256 + wc * 32 + 8 * fq;
        if (u.pm == TP / 256) {
#pragma unroll
            for (int m = 0; m < 4; ++m) { const int row = row0 + m * 16; const float* gp = gate + (size_t)(8 + row - TP) * MODLD; float* dst = PART + ((size_t)(u.k0 >> 2) * 128 + (row - TP)) * DM;
#pragma unroll
                for (int bj = 0; bj < 2; ++bj)
#pragma unroll
                    for (int n = 0; n < 2; ++n) { const int col = col0 + bj * 128 + n * 4; const f32x4 gv = *(const f32x4*)(gp + col); const f32x4 v = (gv * coef) * acc[0][bj][m][n];
                        *(f32x4*)(dst + col) = v; } }
            return;
        }
        const float* gp = gate + (size_t)(u.pm >> 4) * MODLD;
        f32x4 gv[2][2];
#pragma unroll
        for (int bj = 0; bj < 2; ++bj)
#pragma unroll
            for (int n = 0; n < 2; ++n) gv[bj][n] = *(const f32x4*)(gp + col0 + bj * 128 + n * 4) * coef;
        if (xin_f32) {
#pragma unroll
            for (int ai = 0; ai < 2; ++ai)
#pragma unroll
                for (int m = 0; m < 4; ++m) { const size_t ro = (size_t)(row0 + ai * 128 + m * 16) * DM + col0;
#pragma unroll
                    for (int bj = 0; bj < 2; ++bj) { const f32x4 x0 = *(const f32x4*)(xin_f32 + ro + bj * 128), x1 = *(const f32x4*)(xin_f32 + ro + bj * 128 + 4);
                        const f32x4 o0 = x0 + gv[bj][0] * acc[ai][bj][m][0], o1 = x1 + gv[bj][1] * acc[ai][bj][m][1];
                        u32x4 w; w.x = pk2(o0[0], o0[1]); w.y = pk2(o0[2], o0[3]); w.z = pk2(o1[0], o1[1]); w.w = pk2(o1[2], o1[3]);
                        *(u32x4*)(XB + ro + bj * 128) = w; } }
        } else {
#pragma unroll
            for (int ai = 0; ai < 2; ++ai) {
                u32x4 xr[4][2];
#pragma unroll
                for (int m = 0; m < 4; ++m)
#pragma unroll
                    for (int bj = 0; bj < 2; ++bj) xr[m][bj] = *(const u32x4*)(XB + (size_t)(row0 + ai * 128 + m * 16) * DM + col0 + bj * 128);
                asm volatile("" ::: "memory");
#pragma unroll
                for (int m = 0; m < 4; ++m)
#pragma unroll
                    for (int bj = 0; bj < 2; ++bj) { const u32x4 r = xr[m][bj];
                        const f32x4 x0 = {__uint_as_float(r.x << 16), __uint_as_float(r.x & 0xffff0000u), __uint_as_float(r.y << 16), __uint_as_float(r.y & 0xffff0000u)};
                        const f32x4 x1 = {__uint_as_float(r.z << 16), __uint_as_float(r.z & 0xffff0000u), __uint_as_float(r.w << 16), __uint_as_float(r.w & 0xffff0000u)};
                        const f32x4 o0 = x0 + gv[bj][0] * acc[ai][bj][m][0], o1 = x1 + gv[bj][1] * acc[ai][bj][m][1];
                        u32x4 w; w.x = pk2(o0[0], o0[1]); w.y = pk2(o0[2], o0[3]); w.z = pk2(o1[0], o1[1]); w.w = pk2(o1[2], o1[3]);
                        *(u32x4*)(XB + (size_t)(row0 + ai * 128 + m * 16) * DM + col0 + bj * 128) = w; }
                asm volatile("" ::: "memory");
            }
        }
    }
};
struct EpiMod {
    static constexpr bool PERM = false, AFTER_DRAIN = false;
    float* mod; const float* bias;
    DI void operator()(const pg8::f32x4 (&acc)[2][2][4][2], const pg8::Unit& u, int wr, int wc, int fr, int fq) const {
        const int row0 = u.pm * 256 + wr * 64 + fr, col0 = u.pn * 256 + wc * 32 + 4 * fq;
#pragma unroll
        for (int ai = 0; ai < 2; ++ai)
#pragma unroll
            for (int m = 0; m < 4; ++m) { const int row = row0 + ai * 128 + m * 16;
                if (row < 136) {
#pragma unroll
                    for (int bj = 0; bj < 2; ++bj)
#pragma unroll
                        for (int n = 0; n < 2; ++n) { const int col = col0 + bj * 128 + n * 16;
                            *(f32x4*)(mod + (size_t)row * MODLD + col) = acc[ai][bj][m][n] + *(const f32x4*)(bias + col); } } }
    }
};
typedef const __attribute__((address_space(4))) Params* KP;
DI void transpose_item(const float* W, int K, int N, bf16_t* WT, int mode, LAS float* scr, int item, int lane) {
    const int nblk = N / 32, kb = item / nblk, nb = item % nblk, k0 = 64 * kb, n0 = 32 * nb;
#pragma unroll 8
    for (int i = 0; i < 32; ++i) { const int kk = 2 * i + (lane >> 5); scr[kk * 33 + (lane & 31)] = W[(size_t)(k0 + kk) * N + n0 + (lane & 31)]; }
    asm volatile("s_waitcnt lgkmcnt(0)" ::: "memory");
    int rbase = n0;
    if (mode == 1) rbase = (n0 >> 7) * 256 + (n0 & 127);
    if (mode == 2) rbase = (n0 >> 7) * 256 + 128 + (n0 & 127);
    const int c = lane & 7;
#pragma unroll
    for (int j = 0; j < 4; ++j) { const int n = (lane >> 3) + 8 * j; const LAS float* s = scr + (8 * c) * 33 + n;
        u32x4 o; o.x = pk2(s[0 * 33], s[1 * 33]); o.y = pk2(s[2 * 33], s[3 * 33]); o.z = pk2(s[4 * 33], s[5 * 33]); o.w = pk2(s[6 * 33], s[7 * 33]);
        *(u32x4*)(WT + (size_t)(rbase + n) * K + k0 + 8 * c) = o; }
    asm volatile("s_waitcnt lgkmcnt(0)" ::: "memory");
}
constexpr int I_ADA = (DM / 64) * (NMOD / 32), I_FU = (DM / 64) * (FF / 32), I_FD = (FF / 64) * (DM / 32), I_IN = (DM / 64) * (INW / 32), I_OUT = (DM / 64) * (DM / 32), I_POOL = 4 * 8;
constexpr int IPL = I_ADA + 4 * I_FU + 2 * I_FD + I_IN + I_OUT + I_POOL;
DI int t5_bucket(int n) {
    if (n < 16) return n;
    int b = 16;
    b += (n >= 19); b += (n >= 21); b += (n >= 24); b += (n >= 27); b += (n >= 31); b += (n >= 35); b += (n >= 40); b += (n >= 46);
    b += (n >= 52); b += (n >= 59); b += (n >= 67); b += (n >= 77); b += (n >= 87); b += (n >= 99); b += (n >= 113);
    return b;
}
DI void convert_item(KP P, int l, int r, LAS float* scr, int lane) {
    unsigned char* wl = P->ws + WS_L0 + (size_t)l * LAYER_BYTES;
    const float* src; bf16_t* dst; int K, N, mode = 0;
    if (r < I_ADA) { src = P->in[7] + (size_t)l * DM * NMOD; K = DM; N = NMOD; dst = (bf16_t*)(P->ws + WS_WADA) + (size_t)l * NMOD * DM; }
    else if ((r -= I_ADA) < I_FU) { src = P->in[16] + (size_t)l * DM * FF; K = DM; N = FF; dst = (bf16_t*)(wl + LW_GU1); mode = 1; }
    else if ((r -= I_FU) < I_FU) { src = P->in[17] + (size_t)l * DM * FF; K = DM; N = FF; dst = (bf16_t*)(wl + LW_GU1); mode = 2; }
    else if ((r -= I_FU) < I_FD) { src = P->in[18] + (size_t)l * FF * DM; K = FF; N = DM; dst = (bf16_t*)(wl + LW_D1); }
    else if ((r -= I_FD) < I_IN) { src = P->in[10] + (size_t)l * DM * INW; K = DM; N = INW; dst = (bf16_t*)(wl + LW_IN); }
    else if ((r -= I_IN) < I_OUT) { src = P->in[11] + (size_t)l * DM * DM; K = DM; N = DM; dst = (bf16_t*)(wl + LW_OUT); }
    else if ((r -= I_OUT) < I_FU) { src = P->in[19] + (size_t)l * DM * FF; K = DM; N = FF; dst = (bf16_t*)(wl + LW_GU2); mode = 1; }
    else if ((r -= I_FU) < I_FU) { src = P->in[20] + (size_t)l * DM * FF; K = DM; N = FF; dst = (bf16_t*)(wl + LW_GU2); mode = 2; }
    else if ((r -= I_FU) < I_FD) { src = P->in[21] + (size_t)l * FF * DM; K = FF; N = DM; dst = (bf16_t*)(wl + LW_D2); }
    else { r -= I_FD; const int g = r >> 3; r &= 7; src = P->in[14] + (size_t)(l * 4 + g) * 16384; K = 128; N = 128; dst = (bf16_t*)(wl + LW_POOL) + (size_t)g * 16384; }
    transpose_item(src, K, N, dst, mode, scr, r, lane);
}
DI void prologue_rest(KP P, LAS unsigned char* lds, int w, int nw, int wid, int lane) {
    LAS float* scr = (LAS float*)(lds + wid * 8448);
    constexpr int REST = IPL - I_ADA;
    for (int it = w; it < 2 * REST; it += nw) { const int l = it / REST; convert_item(P, l, I_ADA + (it - l * REST), scr, lane); }
}
DI void prologue(KP P, LAS unsigned char* lds, int gw, int NGW, int gtid, int GT, int wid, int lane) {
    LAS float* scr = (LAS float*)(lds + wid * 8448);
    for (int it = gw; it < 2 * I_ADA; it += NGW) { const int l = it / I_ADA; convert_item(P, l, it - l * I_ADA, scr, lane); }
    bf16_t* CS = (bf16_t*)(P->ws + WS_CS);
    for (int idx = gtid; idx < 256 * DM; idx += GT) {
        const int row = idx >> 10; float v = 0.f;
        if (row < 8) v = P->in[2][idx]; else if (row < 136) v = P->in[3][idx - 8 * DM];
        const float s = v / (1.0f + __expf(-v));
        CS[idx] = (bf16_t)(pk2(row < 136 ? s : 0.f, 0.f) & 0xffffu);
    }
    float* TB = (float*)(P->ws + WS_TB);
    for (int idx = gtid; idx < 8 * TBLD; idx += GT) { const int h = idx / TBLD, d = idx % TBLD; const int dd = d < 128 ? d : 128;
        TB[idx] = P->in[13][t5_bucket(dd) * 8 + h] * LOG2E; }
}

template <bool FINAL>
DI void norm_phase(const float* xp, const float* xs, const float* gain, const float* modsh, bf16_t* H, float* Y, int gw, int NGW, int lane, float* xcopy = nullptr, int blk_lo = 0, int blk_hi = TT / 16, int r4_lo = 0, int r4_hi = 16, const float* part = nullptr, int nparts = 0) {
    for (int blk = blk_lo + gw; blk < blk_hi; blk += NGW) {
        const int row0 = blk * 16; const bool prompt = row0 < TP;
        f32x4 Gv[4], Sv[4];
        if (FINAL) {
#pragma unroll
            for (int j = 0; j < 4; ++j) { Gv[j] = ((const f32x4*)gain)[lane + 64 * j]; Sv[j] = (f32x4){0.f, 0.f, 0.f, 0.f}; }
        } else if (prompt) {
            const float* mp = modsh + (size_t)(row0 >> 12) * MODLD;
#pragma unroll
            for (int j = 0; j < 4; ++j) { Gv[j] = ((const f32x4*)gain)[lane + 64 * j] * (((const f32x4*)(mp + DM))[lane + 64 * j] + 1.0f); Sv[j] = ((const f32x4*)mp)[lane + 64 * j]; }
        }
#pragma unroll 1
        for (int r4 = r4_lo; r4 < r4_hi; r4 += 4) {
            f32x4 v[4][4]; float ss[4];
#pragma unroll
            for (int q = 0; q < 4; ++q) { const int row = row0 + r4 + q;
                const float* xr = row < TP ? xp + (size_t)row * DM : xs + (size_t)(row - TP) * DM;
#pragma unroll
                for (int j = 0; j < 4; ++j) v[q][j] = ((const f32x4*)xr)[lane + 64 * j]; }
            if (part) {
#pragma unroll 3
                for (int p = 0; p < nparts; ++p) {
#pragma unroll
                    for (int q = 0; q < 4; ++q) { const float* pr = part + ((size_t)p * 128 + (row0 + r4 + q - TP)) * DM;
#pragma unroll
                        for (int j = 0; j < 4; ++j) v[q][j] += ((const f32x4*)pr)[lane + 64 * j]; } }
            }
#pragma unroll
            for (int q = 0; q < 4; ++q) { float a = 0.f;
#pragma unroll
                for (int j = 0; j < 4; ++j) a += (v[q][j].x * v[q][j].x + v[q][j].y * v[q][j].y) + (v[q][j].z * v[q][j].z + v[q][j].w * v[q][j].w);
                ss[q] = a; }
#pragma unroll
            for (int o = 1; o < 64; o <<= 1) {
#pragma unroll
                for (int q = 0; q < 4; ++q) ss[q] += __shfl_xor(ss[q], o); }
#pragma unroll
            for (int q = 0; q < 4; ++q) { const int row = row0 + r4 + q;
                if (!FINAL && !prompt) {
                    const float* mp = modsh + (size_t)(8 + row - TP) * MODLD;
#pragma unroll
                    for (int j = 0; j < 4; ++j) { Gv[j] = ((const f32x4*)gain)[lane + 64 * j] * (((const f32x4*)(mp + DM))[lane + 64 * j] + 1.0f); Sv[j] = ((const f32x4*)mp)[lane + 64 * j]; }
                    if (xcopy) {
#pragma unroll
                        for (int j = 0; j < 4; ++j) ((f32x4*)(xcopy + (size_t)row * DM))[lane + 64 * j] = v[q][j]; }
                }
                const float rstd = 1.0f / sqrtf(ss[q] * (1.0f / DM) + EPS);
                if (FINAL) {
#pragma unroll
                    for (int j = 0; j < 4; ++j) ((f32x4*)(Y + (size_t)row * DM))[lane + 64 * j] = v[q][j] * rstd * Gv[j];
                } else {
#pragma unroll
                    for (int j = 0; j < 4; ++j) { const f32x4 h = v[q][j] * rstd * Gv[j] + Sv[j]; u32x2 w; w.x = pk2(h.x, h.y); w.y = pk2(h.z, h.w);
                        ((u32x2*)(H + (size_t)row * DM))[lane + 64 * j] = w; }
                }
            }
        }
    }
}

template <bool FINAL>
DI void norm_sample(const float* xs, const float* gain, const float* modsh, bf16_t* H, float* Y, int gw, int NGW, int lane, float* xcopy, const float* part, int nparts) {
    if ((gw & 63) != 0) return;
    const int ns = (NGW >> 6) > 0 ? (NGW >> 6) : 1;
    for (int k = gw >> 6; k < 32; k += ns) norm_phase<FINAL>(nullptr, xs, gain, modsh, H, Y, 0, 1 << 28, lane, xcopy, TP / 16 + (k >> 2), TP / 16 + (k >> 2) + 1, 4 * (k & 3), 4 * (k & 3) + 4, part, nparts);
}
template <bool FINAL>
DI void norm_phase_bf(const bf16_t* XB, const float* gain, const float* modsh, bf16_t* H, float* Y, int gw, int NGW, int lane) {
    for (int blk = gw; blk < TP / 16; blk += NGW) {
        const int row0 = blk * 16;
        f32x4 Gv[2][2], Sv[2][2];
        const float* mp = FINAL ? nullptr : modsh + (size_t)(row0 >> 12) * MODLD;
#pragma unroll
        for (int j = 0; j < 2; ++j)
#pragma unroll
            for (int h = 0; h < 2; ++h) { const int fi = 2 * lane + 128 * j + h;
                if (FINAL) { Gv[j][h] = ((const f32x4*)gain)[fi]; Sv[j][h] = (f32x4){0.f, 0.f, 0.f, 0.f}; }
                else { Gv[j][h] = ((const f32x4*)gain)[fi] * (((const f32x4*)(mp + DM))[fi] + 1.0f); Sv[j][h] = ((const f32x4*)mp)[fi]; } }
#pragma unroll 1
        for (int r8 = 0; r8 < 16; r8 += 8) {
            u32x4 raw[8][2]; float ss[8];
#pragma unroll
            for (int q = 0; q < 8; ++q)
#pragma unroll
                for (int j = 0; j < 2; ++j) raw[q][j] = *(const u32x4*)(XB + (size_t)(row0 + r8 + q) * DM + 8 * lane + 512 * j);
#pragma unroll
            for (int q = 0; q < 8; ++q) { float a = 0.f;
#pragma unroll
                for (int j = 0; j < 2; ++j)
#pragma unroll
                    for (int e = 0; e < 4; ++e) { const float lo = __uint_as_float(raw[q][j][e] << 16), hi = __uint_as_float(raw[q][j][e] & 0xffff0000u); a += lo * lo + hi * hi; }
                ss[q] = a; }
#pragma unroll
            for (int o = 1; o < 64; o <<= 1) {
#pragma unroll
                for (int q = 0; q < 8; ++q) ss[q] += __shfl_xor(ss[q], o); }
#pragma unroll
            for (int q = 0; q < 8; ++q) { const int row = row0 + r8 + q;
                const float rstd = 1.0f / sqrtf(ss[q] * (1.0f / DM) + EPS);
#pragma unroll
                for (int j = 0; j < 2; ++j) { const u32x4 r = raw[q][j];
                    const f32x4 x0 = {__uint_as_float(r.x << 16), __uint_as_float(r.x & 0xffff0000u), __uint_as_float(r.y << 16), __uint_as_float(r.y & 0xffff0000u)};
                    const f32x4 x1 = {__uint_as_float(r.z << 16), __uint_as_float(r.z & 0xffff0000u), __uint_as_float(r.w << 16), __uint_as_float(r.w & 0xffff0000u)};
                    const f32x4 h0 = x0 * rstd * Gv[j][0] + Sv[j][0], h1 = x1 * rstd * Gv[j][1] + Sv[j][1];
                    if (FINAL) { float* yp = Y + (size_t)row * DM + 8 * lane + 512 * j; __builtin_nontemporal_store(h0, (f32x4*)yp); __builtin_nontemporal_store(h1, (f32x4*)(yp + 4)); }
                    else { u32x4 w; w.x = pk2(h0[0], h0[1]); w.y = pk2(h0[2], h0[3]); w.z = pk2(h1[0], h1[1]); w.w = pk2(h1[2], h1[3]);
                        *(u32x4*)(H + (size_t)row * DM + 8 * lane + 512 * j) = w; }
                }
            }
        }
    }
}

constexpr int KS_LD = 72, VT_LD = 264;
constexpr int ATT_KS = 0, ATT_VT = 256 * KS_LD * 2, ATT_TB = ATT_VT + 64 * VT_LD * 2;
DI void attn_unit(LAS unsigned char* lds, const bf16_t* Z, bf16_t* MIX, const float* TB, const float* sinks_l, int b, int n, int kvh, int tid) {
    asm volatile("" : "+v"(tid));
    const int lane = tid & 63, wid = tid >> 6, r = lane & 31, hh = lane >> 5;
    LAS bf16_t* Ks = (LAS bf16_t*)(lds + ATT_KS); LAS bf16_t* Vt = (LAS bf16_t*)(lds + ATT_VT); LAS float* tb = (LAS float*)(lds + ATT_TB);
    const int base = b * SEQ + n * 128;
#pragma unroll
    for (int i = 0; i < 4; ++i) {
        const int c = tid + 512 * i, key = c >> 3, part = c & 7;
        u32x4 kv = {0u, 0u, 0u, 0u}, vv = {0u, 0u, 0u, 0u};
        if (n > 0 || key >= 128) { const bf16_t* zr = Z + (size_t)(base - 128 + key) * INW + kvh * 64 + part * 8; kv = *(const u32x4*)(zr + 512); vv = *(const u32x4*)(zr + 640); }
        *(LAS u32x4*)(Ks + key * KS_LD + part * 8) = kv;
        LAS bf16_t* vd = Vt + (part * 8) * VT_LD + key;
        vd[0 * VT_LD] = (bf16_t)(vv.x & 0xffffu); vd[1 * VT_LD] = (bf16_t)(vv.x >> 16); vd[2 * VT_LD] = (bf16_t)(vv.y & 0xffffu); vd[3 * VT_LD] = (bf16_t)(vv.y >> 16);
        vd[4 * VT_LD] = (bf16_t)(vv.z & 0xffffu); vd[5 * VT_LD] = (bf16_t)(vv.z >> 16); vd[6 * VT_LD] = (bf16_t)(vv.w & 0xffffu); vd[7 * VT_LD] = (bf16_t)(vv.w >> 16);
    }
    for (int i = tid; i < 4 * TBLD; i += 512) tb[i] = TB[kvh * 4 * TBLD + i];
    const int hl = wid >> 1, h = kvh * 4 + hl;
    const float sink2 = sinks_l[h] * LOG2E;
    LAS const float* tbh = tb + hl * TBLD;
    bf16x8 qf[4];
    {   const bf16_t* qrow = Z + (size_t)(base + (wid & 1) * 64 + r) * INW + h * 64 + 8 * hh;
#pragma unroll
        for (int c = 0; c < 4; ++c) qf[c] = *(const bf16x8*)(qrow + 16 * c); }
    __syncthreads();
#pragma unroll 1
    for (int sub = 0; sub < 2; ++sub) {
        const int qoff = (wid & 1) * 64 + sub * 32, kt0 = qoff >> 5, q = qoff + r;
        f32x16 sc[5];
#pragma unroll
        for (int t = 0; t < 5; ++t) {
#pragma unroll
            for (int i = 0; i < 16; ++i) sc[t][i] = 0.f;
#pragma unroll
            for (int c = 0; c < 4; ++c) { const bf16x8 a = *(LAS const bf16x8*)(Ks + (32 * (kt0 + t) + r) * KS_LD + 16 * c + 8 * hh); sc[t] = MFMA32(a, qf[c], sc[t]); }
        }
        if (sub == 0) {
            const bf16_t* qrow = Z + (size_t)(base + q + 32) * INW + h * 64 + 8 * hh;
#pragma unroll
            for (int c = 0; c < 4; ++c) qf[c] = *(const bf16x8*)(qrow + 16 * c);
        }
        float m = -INFINITY;
        const int rel = r - 4 * hh;
#pragma unroll
        for (int t = 0; t < 5; ++t) {
            const bool dead = (n == 0) && (kt0 + t < 4);
#pragma unroll
            for (int i = 0; i < 16; ++i) {
                const int cc = (i & 3) + 8 * (i >> 2);
                const int dist = 128 - 32 * t + rel - cc;
                bool valid = !dead;
                if (t == 0) valid = valid && (dist <= 128);
                if (t == 4) valid = valid && (dist >= 0);
                const float bias = tbh[(t == 0 || t == 4) ? (valid ? dist : 0) : dist];
                const float val = valid ? sc[t][i] * C2 + bias : -INFINITY;
                sc[t][i] = val; m = fmaxf(m, val);
            }
        }
        m = fmaxf(m, __shfl_xor(m, 32)); m = fmaxf(m, sink2);
        float sum = 0.f;
#pragma unroll
        for (int t = 0; t < 5; ++t)
#pragma unroll
            for (int i = 0; i < 16; ++i) { const float p = __builtin_amdgcn_exp2f(sc[t][i] - m); sc[t][i] = p; sum += p; }
        sum += __shfl_xor(sum, 32); sum += __builtin_amdgcn_exp2f(sink2 - m);
        const float inv = 1.0f / sum;
        f32x16 o[2];
#pragma unroll
        for (int i = 0; i < 16; ++i) { o[0][i] = 0.f; o[1][i] = 0.f; }
#pragma unroll
        for (int t = 0; t < 5; ++t)
#pragma unroll
            for (int s = 0; s < 2; ++s) {
                u32x4 pw; pw.x = pk2(sc[t][8 * s + 0], sc[t][8 * s + 1]); pw.y = pk2(sc[t][8 * s + 2], sc[t][8 * s + 3]); pw.z = pk2(sc[t][8 * s + 4], sc[t][8 * s + 5]); pw.w = pk2(sc[t][8 * s + 6], sc[t][8 * s + 7]);
                const bf16x8 pb = __builtin_bit_cast(bf16x8, pw);
#pragma unroll
                for (int dt = 0; dt < 2; ++dt) {
                    LAS const bf16_t* vr = Vt + (32 * dt + r) * VT_LD + 32 * (kt0 + t) + 16 * s + 4 * hh;
                    const s16x4 lo = *(LAS const s16x4*)vr, hi = *(LAS const s16x4*)(vr + 8);
                    const bf16x8 a = __builtin_shufflevector(lo, hi, 0, 1, 2, 3, 4, 5, 6, 7);
                    o[dt] = MFMA32(a, pb, o[dt]);
                }
            }
        bf16_t* orow = MIX + (size_t)(base + q) * DM + h * 64 + 4 * hh;
#pragma unroll
        for (int dt = 0; dt < 2; ++dt)
#pragma unroll
            for (int g4 = 0; g4 < 4; ++g4) { u32x2 w; w.x = pk2(o[dt][4 * g4 + 0] * inv, o[dt][4 * g4 + 1] * inv); w.y = pk2(o[dt][4 * g4 + 2] * inv, o[dt][4 * g4 + 3] * inv);
                *(u32x2*)(orow + 32 * dt + 8 * g4) = w; }
    }
    __syncthreads();
}

DI void sattn_task(LAS float* wl, const bf16_t* Z, const float* ck, const float* cv, bf16_t* MIX, const float* TB, const float* sinks_l, int s, int kvh, int lane) {
    asm volatile("" : "+v"(lane));
    const bf16_t* zrow = Z + (size_t)(TP + s) * INW;
#pragma unroll
    for (int hl = 0; hl < 4; ++hl) wl[hl * 64 + lane] = bf2f(zrow[(kvh * 4 + hl) * 64 + lane]) * C2;
    const float kn = bf2f(zrow[512 + kvh * 64 + lane]);
    asm volatile("s_waitcnt lgkmcnt(0)" ::: "memory");
    float sc[4][2];
#pragma unroll
    for (int kk = 0; kk < 2; ++kk) {
        const int j = lane + 64 * kk;
        const float* krow = ck + ((size_t)(s * 128 + j) * 2 + kvh) * 64;
        float a[4] = {0.f, 0.f, 0.f, 0.f};
#pragma unroll 8
        for (int d4 = 0; d4 < 16; ++d4) { const f32x4 kv = *(const f32x4*)(krow + 4 * d4);
#pragma unroll
            for (int hl = 0; hl < 4; ++hl) { const f32x4 qv = *(LAS const f32x4*)(wl + hl * 64 + 4 * d4); a[hl] += (kv.x * qv.x + kv.y * qv.y) + (kv.z * qv.z + kv.w * qv.w); } }
#pragma unroll
        for (int hl = 0; hl < 4; ++hl) sc[hl][kk] = a[hl] + TB[(kvh * 4 + hl) * TBLD + (128 - j)];
    }
    float pn[4];
#pragma unroll
    for (int hl = 0; hl < 4; ++hl) {
        const float sink2 = sinks_l[kvh * 4 + hl] * LOG2E;
        const float snew = wave_sum(kn * wl[hl * 64 + lane]) + TB[(kvh * 4 + hl) * TBLD + 0];
        float m = wave_max(fmaxf(sc[hl][0], sc[hl][1])); m = fmaxf(m, fmaxf(snew, sink2));
        const float p0 = __builtin_amdgcn_exp2f(sc[hl][0] - m), p1 = __builtin_amdgcn_exp2f(sc[hl][1] - m), pnw = __builtin_amdgcn_exp2f(snew - m);
        const float sum = wave_sum(p0 + p1) + pnw + __builtin_amdgcn_exp2f(sink2 - m);
        const float inv = 1.0f / sum;
        wl[256 + hl * TBLD + lane] = p0 * inv; wl[256 + hl * TBLD + 64 + lane] = p1 * inv; pn[hl] = pnw * inv;
    }
    asm volatile("s_waitcnt lgkmcnt(0)" ::: "memory");
    const int jg = lane >> 4, d4 = lane & 15;
    f32x4 o[4];
#pragma unroll
    for (int hl = 0; hl < 4; ++hl) o[hl] = (f32x4){0.f, 0.f, 0.f, 0.f};
    const float* vb = cv + ((size_t)(s * 128 + jg) * 2 + kvh) * 64 + 4 * d4;
#pragma unroll 8
    for (int i = 0; i < 32; ++i) { const f32x4 vv = *(const f32x4*)(vb + (size_t)i * 512);
#pragma unroll
        for (int hl = 0; hl < 4; ++hl) o[hl] += vv * wl[256 + hl * TBLD + 4 * i + jg]; }
    const f32x4 vn4 = bf4_to_f4(zrow + 640 + kvh * 64 + 4 * d4);
#pragma unroll
    for (int hl = 0; hl < 4; ++hl) {
#pragma unroll
        for (int e = 0; e < 4; ++e) { float v = o[hl][e]; v += __shfl_xor(v, 16); v += __shfl_xor(v, 32); o[hl][e] = v + pn[hl] * vn4[e]; }
        if (jg == 0) { u32x2 w; w.x = pk2(o[hl][0], o[hl][1]); w.y = pk2(o[hl][2], o[hl][3]); *(u32x2*)(MIX + (size_t)(TP + s) * DM + (kvh * 4 + hl) * 64 + 4 * d4) = w; }
    }
    asm volatile("s_waitcnt lgkmcnt(0)" ::: "memory");
}

constexpr int PU_LD = 136;
constexpr int POOL_U = 0, POOL_P = 144 * PU_LD * 2, POOL_O = POOL_P + 128 * PU_LD * 2;
DI void pool_unit(LAS unsigned char* lds, const bf16_t* Z, const bf16_t* PWT, const float* pscale_l, bf16_t* MIX, int ub, int tid) {
    asm volatile("" : "+v"(tid));
    const int lane = tid & 63, wid = tid >> 6, r = lane & 31, hh = lane >> 5;
    LAS bf16_t* Ug = (LAS bf16_t*)(lds + POOL_U); LAS bf16_t* Pg = (LAS bf16_t*)(lds + POOL_P); LAS bf16_t* Og = (LAS bf16_t*)(lds + POOL_O);
    const int b = ub >> 5, n = ub & 31;
    const bf16_t* zb = Z + (size_t)(b * SEQ + n * 128 - 15) * INW + 768;
    bf16_t* ob = MIX + (size_t)(b * SEQ + n * 128) * DM + 512;
    u32x4 ureg[5];
#define POOL_LOADU(gg) do { _Pragma("unroll") for (int i_ = 0; i_ < 5; ++i_) { const int c_ = tid + 512 * i_, row_ = c_ >> 4, part_ = c_ & 15; \
        u32x4 v_ = {0u, 0u, 0u, 0u}; if (c_ < 143 * 16 && n * 128 - 15 + row_ >= 0) v_ = *(const u32x4*)(zb + (size_t)row_ * INW + (gg) * 128 + part_ * 8); ureg[i_] = v_; } } while (0)
    POOL_LOADU(0);
    const int mt = wid >> 1, nt0 = (wid & 1) * 2;
#pragma unroll 1
    for (int g = 0; g < 4; ++g) {
        const int w = 2 << g;
        bf16x8 bfr[8][2];
#pragma unroll
        for (int ks = 0; ks < 8; ++ks)
#pragma unroll
            for (int qq = 0; qq < 2; ++qq) bfr[ks][qq] = *(const bf16x8*)(PWT + (size_t)g * 16384 + (32 * (nt0 + qq) + r) * 128 + 16 * ks + 8 * hh);
#pragma unroll
        for (int i = 0; i < 5; ++i) { const int c = tid + 512 * i; if (c < 143 * 16) *(LAS u32x4*)(Ug + (c >> 4) * PU_LD + (c & 15) * 8) = ureg[i]; }
        __syncthreads();
        if (g < 3) POOL_LOADU(g + 1);
        {   const int c2 = tid & 63, t0 = wid * 16;
            float a0 = 0.f, a1 = 0.f;
            for (int s = 0; s < w; ++s) { const unsigned uv = *(LAS const unsigned*)(Ug + (t0 + 15 - s) * PU_LD + 2 * c2); a0 += __uint_as_float(uv << 16); a1 += __uint_as_float(uv & 0xffff0000u); }
            for (int t = t0; t < t0 + 16; ++t) {
                const unsigned uv = *(LAS const unsigned*)(Ug + (t + 15) * PU_LD + 2 * c2);
                const float u0 = __uint_as_float(uv << 16), u1 = __uint_as_float(uv & 0xffff0000u);
                const int pos1 = n * 128 + t + 1; const float ic = 1.0f / (float)(pos1 < w ? pos1 : w);
                *(LAS unsigned*)(Pg + t * PU_LD + 2 * c2) = pk2(a0 * ic - u0, a1 * ic - u1);
                if (t + 1 < t0 + 16) {
                    const unsigned ua = *(LAS const unsigned*)(Ug + (t + 16) * PU_LD + 2 * c2), ud = *(LAS const unsigned*)(Ug + (t + 16 - w) * PU_LD + 2 * c2);
                    a0 += __uint_as_float(ua << 16) - __uint_as_float(ud << 16); a1 += __uint_as_float(ua & 0xffff0000u) - __uint_as_float(ud & 0xffff0000u);
                }
            }
        }
        __syncthreads();
        {   f32x16 acc[2];
#pragma unroll
            for (int i = 0; i < 16; ++i) { acc[0][i] = 0.f; acc[1][i] = 0.f; }
#pragma unroll
            for (int ks = 0; ks < 8; ++ks) {
                const bf16x8 a = *(LAS const bf16x8*)(Pg + (32 * mt + r) * PU_LD + 16 * ks + 8 * hh);
#pragma unroll
                for (int qq = 0; qq < 2; ++qq) acc[qq] = MFMA32(a, bfr[ks][qq], acc[qq]);
            }
#pragma unroll
            for (int qq = 0; qq < 2; ++qq) { const int cl = 32 * (nt0 + qq) + r; const float ps = pscale_l[g * 128 + cl];
#pragma unroll
                for (int i = 0; i < 16; ++i) Og[(32 * mt + crow(i, hh)) * PU_LD + cl] = (bf16_t)(pk2(acc[qq][i] * ps, 0.f) & 0xffffu); }
        }
        __syncthreads();
#pragma unroll
        for (int i = 0; i < 4; ++i) { const int c = tid + 512 * i, row = c >> 4, part = c & 15;
            *(u32x4*)(ob + (size_t)row * DM + g * 128 + part * 8) = *(LAS const u32x4*)(Og + row * PU_LD + part * 8); }
    }
#undef POOL_LOADU
}
DI void pool_unit_sample(LAS unsigned char* lds, const bf16_t* Z, const float* sp_l, const bf16_t* PWT, const float* pscale_l, bf16_t* MIX, int k, int tid) {
    asm volatile("" : "+v"(tid));
    const int lane = tid & 63, wid = tid >> 6, r = lane & 31, hh = lane >> 5;
    LAS bf16_t* Pg = (LAS bf16_t*)(lds + POOL_P);
    const int g = k >> 2, s0 = (k & 3) * 32, w = 2 << g;
    for (int idx = tid; idx < 32 * 64; idx += 512) { const int sl = idx >> 6, c2 = idx & 63, s = s0 + sl;
        const unsigned uv = *(const unsigned*)(Z + (size_t)(TP + s) * INW + 768 + g * 128 + 2 * c2);
        const float u0 = __uint_as_float(uv << 16), u1 = __uint_as_float(uv & 0xffff0000u);
        float a0 = u0, a1 = u1;
#pragma unroll
        for (int i = 0; i < 15; ++i) { if (i >= 16 - w) { const f32x2 sv = *(const f32x2*)(sp_l + ((size_t)s * 15 + i) * 512 + g * 128 + 2 * c2); a0 += sv.x; a1 += sv.y; } }
        const float ic = 1.0f / (float)w;
        *(LAS unsigned*)(Pg + sl * PU_LD + 2 * c2) = pk2(a0 * ic - u0, a1 * ic - u1); }
    __syncthreads();
    if (wid < 2) {
        f32x16 acc[2];
#pragma unroll
        for (int i = 0; i < 16; ++i) { acc[0][i] = 0.f; acc[1][i] = 0.f; }
#pragma unroll
        for (int ks = 0; ks < 8; ++ks) {
            const bf16x8 a = *(LAS const bf16x8*)(Pg + r * PU_LD + 16 * ks + 8 * hh);
#pragma unroll
            for (int qq = 0; qq < 2; ++qq) { const bf16x8 bb = *(const bf16x8*)(PWT + (size_t)g * 16384 + (32 * (wid * 2 + qq) + r) * 128 + 16 * ks + 8 * hh); acc[qq] = MFMA32(a, bb, acc[qq]); }
        }
#pragma unroll
        for (int qq = 0; qq < 2; ++qq) { const int col = g * 128 + 32 * (wid * 2 + qq) + r; const float ps = pscale_l[col];
#pragma unroll
            for (int i = 0; i < 16; ++i) MIX[(size_t)(TP + s0 + crow(i, hh)) * DM + 512 + col] = (bf16_t)(pk2(acc[qq][i] * ps, 0.f) & 0xffffu); }
    }
    __syncthreads();
}

DI void states_copy(KP P, const bf16_t* Z, int l, int gtid, int GT) {
    float* out = P->out;
    for (int idx = gtid; idx < 8 * 128 * 32; idx += GT) { const int c4 = idx & 31, j = (idx >> 5) & 127, b = idx >> 12;
        const bf16_t* zr = Z + (size_t)(b * SEQ + SEQ - 128 + j) * INW + c4 * 4;
        *(f32x4*)(out + O_KP + ((size_t)(l * 8 + b) * 128 + j) * 128 + c4 * 4) = bf4_to_f4(zr + 512);
        *(f32x4*)(out + O_VP + ((size_t)(l * 8 + b) * 128 + j) * 128 + c4 * 4) = bf4_to_f4(zr + 640); }
    for (int idx = gtid; idx < 8 * 15 * 128; idx += GT) { const int c4 = idx & 127, bi = idx >> 7, i = bi % 15, b = bi / 15;
        *(f32x4*)(out + O_PP + ((size_t)(l * 8 + b) * 15 + i) * 512 + c4 * 4) = bf4_to_f4(Z + (size_t)(b * SEQ + SEQ - 15 + i) * INW + 768 + c4 * 4); }
    for (int idx = gtid; idx < 128 * 32; idx += GT) { const int c4 = idx & 31, s = idx >> 5;
        const bf16_t* zr = Z + (size_t)(TP + s) * INW + c4 * 4;
        *(f32x4*)(out + O_KS + ((size_t)(l * 128 + s) * 128 + 127) * 128 + c4 * 4) = bf4_to_f4(zr + 512);
        *(f32x4*)(out + O_VS + ((size_t)(l * 128 + s) * 128 + 127) * 128 + c4 * 4) = bf4_to_f4(zr + 640); }
    for (int idx = gtid; idx < 128 * 128; idx += GT) { const int c4 = idx & 127, s = idx >> 7;
        *(f32x4*)(out + O_PS + ((size_t)(l * 128 + s) * 15 + 14) * 512 + c4 * 4) = bf4_to_f4(Z + (size_t)(TP + s) * INW + 768 + c4 * 4); }
}
DI void states_shift(KP P, int t, int NT) {
    float* out = P->out; const float* ck = P->in[4]; const float* cv = P->in[5]; const float* sp = P->in[6];
#pragma unroll 4
    for (int idx = t; idx < 256 * 127 * 32; idx += NT) { const int ls = idx / (127 * 32), r = idx - ls * (127 * 32);
        const size_t so = (size_t)ls * 16384 + 128 + (size_t)r * 4, dd = (size_t)ls * 16384 + (size_t)r * 4;
        const f32x4 a = *(const f32x4*)(ck + so), b = *(const f32x4*)(cv + so);
        *(f32x4*)(out + O_KS + dd) = a; *(f32x4*)(out + O_VS + dd) = b; }
#pragma unroll 4
    for (int idx = t; idx < 256 * 14 * 128; idx += NT) { const int ls = idx / (14 * 128), r = idx - ls * (14 * 128);
        *(f32x4*)(out + O_PS + (size_t)ls * 7680 + (size_t)r * 4) = *(const f32x4*)(sp + (size_t)ls * 7680 + 512 + (size_t)r * 4); }
}

#define XB_TMO      128
#define XB_XCNT(j)  (256  + 64 * (j))
#define XB_XSUB(j)  (1280 + 64 * (j))
#define XB_XGEN(j)  (2304 + 64 * (j))
#define XB_TOP      3328
#define XB_TOPGEN   3392
#define XCD_BAR_WORDS 3456
#define XB_SPIN_CAP (1u << 18)

__device__ __forceinline__ unsigned xb_ld(unsigned* p)              { return __hip_atomic_load(p, __ATOMIC_RELAXED, __HIP_MEMORY_SCOPE_AGENT); }
__device__ __forceinline__ unsigned xb_add(unsigned* p, unsigned v) { return __hip_atomic_fetch_add(p, v, __ATOMIC_RELAXED, __HIP_MEMORY_SCOPE_AGENT); }
__device__ __forceinline__ unsigned xb_xcc_id() { return (unsigned)__builtin_amdgcn_s_getreg((3 << 11) | 20) & 0xFu; }
#define XB_SPIN(cond, bar) do { unsigned _sp = 0; while (cond) { __builtin_amdgcn_s_sleep(1); \
    if ((++_sp & 255u) == 0u) { if (xb_ld(&(bar)[XB_TMO])) break; if (_sp > XB_SPIN_CAP) { atomicAdd(&(bar)[XB_TMO], 1u); break; } } } } while (0)

struct XcdBarrier {
    unsigned* bar; unsigned x;
    volatile LAS unsigned* st;
};

__device__ __forceinline__ XcdBarrier xcd_barrier_post(unsigned* bar, volatile LAS unsigned* st) {
    XcdBarrier b; b.bar = bar; b.x = xb_xcc_id(); b.st = st;
    if (threadIdx.x == 0) (void)xb_add(&bar[XB_XCNT(b.x)], 1u);
    return b;
}
__device__ __forceinline__ void xcd_barrier_complete(unsigned* bar, unsigned x, unsigned& nloc, unsigned& nx) {
    const unsigned G = gridDim.x * gridDim.y * gridDim.z;
    unsigned sum, cnt, mine, sp = 0u;
    for (;;) {
        sum = 0u; cnt = 0u; mine = 0u;
#pragma unroll
        for (unsigned j = 0; j < 16; ++j) { const unsigned c = xb_ld(&bar[XB_XCNT(j)]); sum += c; cnt += (c > 0u) ? 1u : 0u; mine = (j == x) ? c : mine; }
        if (sum == G) break;
        __builtin_amdgcn_s_sleep(1);
        if ((++sp & 255u) == 0u) { if (xb_ld(&bar[XB_TMO])) break; if (sp > XB_SPIN_CAP) { atomicAdd(&bar[XB_TMO], 1u); break; } }
    }
    nloc = mine > 0u ? mine : 1u; nx = cnt > 0u ? cnt : 1u;
}

__device__ __forceinline__ void xcd_barrier(const XcdBarrier& b) {
    asm volatile("s_waitcnt vmcnt(0)" ::: "memory");
    __syncthreads();
    if (threadIdx.x == 0) {
        unsigned* bar = b.bar;
        __builtin_amdgcn_s_waitcnt(0);
        unsigned nloc = b.st[0], nx = b.st[1];
        if (nloc == 0u) { xcd_barrier_complete(bar, b.x, nloc, nx); b.st[0] = nloc; b.st[1] = nx; }
        const unsigned old = xb_add(&bar[XB_XSUB(b.x)], 1u);
        const unsigned gen = old / nloc;
        if (old + 1u == (gen + 1u) * nloc) {
            __builtin_amdgcn_fence(__ATOMIC_RELEASE, "agent");
            asm volatile("s_waitcnt vmcnt(0)" ::: "memory");
            const unsigned og = xb_add(&bar[XB_TOP], 1u);
            const unsigned tg = og / nx;
            if (og + 1u == (tg + 1u) * nx) xb_add(&bar[XB_TOPGEN], 1u);
            else XB_SPIN(xb_ld(&bar[XB_TOPGEN]) == tg, bar);
            __builtin_amdgcn_fence(__ATOMIC_ACQUIRE, "agent");
            xb_add(&bar[XB_XGEN(b.x)], 1u);
            asm volatile("s_waitcnt vmcnt(0)" ::: "memory");
        } else {
            XB_SPIN(xb_ld(&bar[XB_XGEN(b.x)]) == gen, bar);
            __builtin_amdgcn_fence(__ATOMIC_ACQUIRE, "agent");
            asm volatile("s_waitcnt vmcnt(0)" ::: "memory");
        }
    }
    __syncthreads();
}
DI KP kargs() { unsigned long long v = (unsigned long long)__builtin_amdgcn_kernarg_segment_ptr(); asm volatile("" : "+s"(v)); return (KP)v; }
#define PH_VARS KP Pk = kargs(); int tid = threadIdx.x; asm volatile("" : "+v"(tid)); const int lane = tid & 63, wid = __builtin_amdgcn_readfirstlane(tid >> 6); \
    const int G = gridDim.x, bx = blockIdx.x; const int gw = bx * 8 + wid, NGW = G * 8, gtid = bx * 512 + tid, GT = G * 512; unsigned char* ws = Pk->ws; (void)lane; (void)gw; (void)NGW; (void)gtid; (void)GT; (void)ws;
__global__ void __launch_bounds__(512, 2) fwd(Params Pdummy) {
    extern __shared__ __attribute__((aligned(16))) unsigned char lds_g[];
    LAS unsigned char* lds = (LAS unsigned char*)lds_g;
    cg::grid_group grid = cg::this_grid();
    int lo, hi; unsigned* barw; { KP Pk = kargs(); lo = Pk->ph_lo; hi = Pk->ph_hi; barw = (unsigned*)(Pk->ws + WS_BAR); }
    if (hi > 1000) grid.sync();
    if (threadIdx.x < 2) ((volatile LAS unsigned*)(lds + 131072))[threadIdx.x] = 0u;
    __syncthreads();
    XcdBarrier xb; xb.bar = barw; xb.x = 0; xb.st = nullptr;
    if (hi - lo > 1) xb = xcd_barrier_post(barw, (volatile LAS unsigned*)(lds + 131072));
#ifndef PROBE_REP
#define PROBE_REP -1
#endif
#ifndef PROBE_N
#define PROBE_N 0
#endif
#ifndef PROBE_MIX
#define PROBE_MIX 0
#endif
#ifndef STAG_TICKS
#define STAG_TICKS 0
#endif
#define STAGGER() do { if (STAG_TICKS > 0) { const unsigned long long t0_ = __builtin_amdgcn_s_memrealtime(); const unsigned long long d_ = (unsigned long long)((bx >> 3) & 3) * STAG_TICKS; while (__builtin_amdgcn_s_memrealtime() - t0_ < d_) __builtin_amdgcn_s_sleep(8); } } while (0)
#ifndef PROBE_SYNC
#define PROBE_SYNC 0
#endif
#define REPS(k) for (int rep_ = 0; rep_ < ((k) == PROBE_REP ? 1 + PROBE_N : 1); ++rep_)
#define IN(k) (lo <= (k) && (k) < hi)
#define SEAM(k) do { if (IN(k) && IN((k) + 1)) xcd_barrier(xb); } while (0)
    const bool merged = IN(0) && IN(1) && (int)gridDim.x > MODLD / 256;
    if (IN(0)) { PH_VARS
        prologue(Pk, lds, gw, NGW, gtid, GT, wid, lane);
        if (merged) {
            unsigned* flag = (unsigned*)(ws + WS_BAR) + 3840;
            asm volatile("s_waitcnt vmcnt(0)" ::: "memory"); __syncthreads();
            if (tid == 0) { __builtin_amdgcn_fence(__ATOMIC_RELEASE, "agent"); asm volatile("s_waitcnt vmcnt(0)" ::: "memory"); __hip_atomic_fetch_add(flag, 1u, __ATOMIC_RELAXED, __HIP_MEMORY_SCOPE_AGENT); }
            if (bx < MODLD / 256) {
                if (wid == 0) { unsigned sp = 0;
                    while ((unsigned)__builtin_amdgcn_readfirstlane(__hip_atomic_load(flag, __ATOMIC_RELAXED, __HIP_MEMORY_SCOPE_AGENT)) < (unsigned)G) { __builtin_amdgcn_s_sleep(2); if (++sp > (1u << 22)) break; }
                    __builtin_amdgcn_fence(__ATOMIC_ACQUIRE, "agent"); asm volatile("s_waitcnt vmcnt(0)" ::: "memory"); }
                __syncthreads();
                pg8::Gemm g{(const bf16_t*)(ws + WS_CS), (const bf16_t*)(ws + WS_WADA), 256, MODLD, DM}; pg8::StaticOrder S; S.init(256, MODLD, G, bx);
                EpiMod E{(float*)(ws + WS_MOD), Pk->in[8]};
                pg8::gemm_phase<EpiMod, pg8::StaticOrder, PG8_ALIGN, PG8_SP2>(lds, g, S, E, tid);
            } else {
                prologue_rest(Pk, lds, (bx - MODLD / 256) * 8 + wid, (G - MODLD / 256) * 8, wid, lane);
            }
        } else prologue_rest(Pk, lds, gw, NGW, wid, lane);
    }
    SEAM(0);
    for (int i_ = 0; i_ < PROBE_SYNC; ++i_) xcd_barrier(xb);
    if (IN(1) && !merged) { PH_VARS
        pg8::Gemm g{(const bf16_t*)(ws + WS_CS), (const bf16_t*)(ws + WS_WADA), 256, MODLD, DM}; pg8::StaticOrder S; S.init(256, MODLD, G, bx);
        EpiMod E{(float*)(ws + WS_MOD), Pk->in[8]};
        pg8::gemm_phase<EpiMod, pg8::StaticOrder, PG8_ALIGN, PG8_SP2>(lds, g, S, E, tid);
        states_shift(Pk, gtid, GT);
    }
    if (!merged) SEAM(1);
#pragma unroll 1
    for (int l = 0; l < 2; ++l) {
        const int pb = 2 + 10 * l;
#define LAYER_VARS unsigned char* wl = ws + WS_L0 + (size_t)l * LAYER_BYTES; bf16_t* XB = (bf16_t*)(ws + WS_X); float* XS = (float*)(ws + WS_XS); float* XSv = XS - (size_t)TP * DM; float* PART = (float*)(ws + WS_WADA); bf16_t* H = (bf16_t*)(ws + WS_H); bf16_t* ACT = (bf16_t*)(ws + WS_ACT); bf16_t* Z = (bf16_t*)(ws + WS_Z); bf16_t* MIX = (bf16_t*)(ws + WS_MIX); \
        const float* modl = (const float*)(ws + WS_MOD) + (size_t)l * NMOD; const float* gain_l = Pk->in[9] + (size_t)l * 3 * DM; \
        (void)wl; (void)XB; (void)XS; (void)XSv; (void)PART; (void)H; (void)ACT; (void)Z; (void)MIX; (void)modl; (void)gain_l;
        if (IN(pb + 0)) REPS(pb + 0) { PH_VARS LAYER_VARS
            if (l == 0) { norm_phase<false>(Pk->in[0], nullptr, gain_l, modl, H, nullptr, gw, NGW, lane, nullptr, 0, TP / 16); norm_sample<false>(Pk->in[1], gain_l, modl, H, nullptr, gw, NGW, lane, XSv, nullptr, 0); }
            else { norm_phase_bf<false>(XB, gain_l, modl, H, nullptr, gw, NGW, lane); norm_sample<false>(XS, gain_l, modl, H, nullptr, gw, NGW, lane, XSv, PART, FF / 256); } }
        SEAM(pb + 0);
        if (IN(pb + 1)) REPS(pb + 1) { PH_VARS LAYER_VARS
            pg8::Gemm g{H, (const bf16_t*)(wl + LW_GU1), MPAD, 2 * FF, DM}; TailOrder S; S.init(2 * FF, G, bx);
            EpiSwiGLU E{ACT};
            pg8::gemm_phase<EpiSwiGLU, TailOrder, PG8_ALIGN, PG8_SP2>(lds, g, S, E, tid);
        }
        SEAM(pb + 1);
        if (IN(pb + 2)) REPS(pb + 2) { PH_VARS LAYER_VARS
            pg8::Gemm g{ACT, (const bf16_t*)(wl + LW_D1), MPAD, DM, FF}; SplitOrder S; S.init(DM, FF, G, bx);
            EpiResid E{l == 0 ? Pk->in[0] : nullptr, XB, PART, modl + 2 * DM, 0.5f};
            STAGGER(); pg8::gemm_phase<EpiResid, SplitOrder, PG8_ALIGN, PG8_SP2>(lds, g, S, E, tid);
        }
        SEAM(pb + 2);
        if (IN(pb + 3)) REPS(pb + 3) { PH_VARS LAYER_VARS norm_phase_bf<false>(XB, gain_l + DM, modl + 3 * DM, H, nullptr, gw, NGW, lane); norm_sample<false>(XS, gain_l + DM, modl + 3 * DM, H, nullptr, gw, NGW, lane, XSv, PART, FF / 256); }
        SEAM(pb + 3);
        if (IN(pb + 4)) REPS(pb + 4) { PH_VARS LAYER_VARS
            pg8::Gemm g{H, (const bf16_t*)(wl + LW_IN), MPAD, INW, DM}; TailOrder S; S.init(INW, G, bx);
            EpiStoreBf16 E{Z, INW};
            pg8::gemm_phase<EpiStoreBf16, TailOrder, PG8_ALIGN, PG8_SP2>(lds, g, S, E, tid);
            if (l == 0 && merged) {
                constexpr int NB3 = (TP / 256 * (INW / 256) + INW / 256) - 512;
                if (G <= NB3 + 16) states_shift(Pk, gtid, GT); else if (bx >= NB3) states_shift(Pk, (bx - NB3) * 512 + tid, (G - NB3) * 512);
            }
        }
        SEAM(pb + 4);
        if (IN(pb + 5)) REPS(pb + 5) { PH_VARS LAYER_VARS
            const float* TB = (const float*)(ws + WS_TB);
            const float* sinks_l = Pk->in[12] + l * 8;
            const float* ck = Pk->in[4] + (size_t)l * 128 * 128 * 128; const float* cv = Pk->in[5] + (size_t)l * 128 * 128 * 128; const float* sp = Pk->in[6] + (size_t)l * 128 * 15 * 512;
            for (int id = bx; id < 816; id += G) {
                if (id < 512) { for (int rp = 0; rp < (PROBE_MIX == 1 ? 2 : 1); ++rp) { const int kvh = id & 1, bn = id >> 1; attn_unit(lds, Z, MIX, TB, sinks_l, bn >> 5, bn & 31, kvh, tid); } }
                else if (id < 784) { for (int rp = 0; rp < (PROBE_MIX == 2 ? 2 : 1); ++rp) { if (id < 768) pool_unit(lds, Z, (const bf16_t*)(wl + LW_POOL), Pk->in[15] + l * 512, MIX, id - 512, tid); else pool_unit_sample(lds, Z, sp, (const bf16_t*)(wl + LW_POOL), Pk->in[15] + l * 512, MIX, id - 768, tid); } }
                else { for (int rp = 0; rp < (PROBE_MIX == 3 ? 2 : 1); ++rp) { const int task = (id - 784) * 8 + wid; sattn_task((LAS float*)(lds + wid * 4096), Z, ck, cv, MIX, TB, sinks_l, task >> 1, task & 1, lane); __syncthreads(); } }
            }
            for (int rp = 0; rp < (PROBE_MIX == 4 ? 2 : 1); ++rp) states_copy(Pk, Z, l, gtid, GT);
        }
        SEAM(pb + 5);
        if (IN(pb + 6)) REPS(pb + 6) { PH_VARS LAYER_VARS
            pg8::Gemm g{MIX, (const bf16_t*)(wl + LW_OUT), MPAD, DM, DM}; SplitOrder S; S.init(DM, DM, G, bx);
            EpiResid E{nullptr, XB, PART, modl + 5 * DM, 1.0f};
            STAGGER(); pg8::gemm_phase<EpiResid, SplitOrder, PG8_ALIGN, PG8_SP2>(lds, g, S, E, tid);
        }
        SEAM(pb + 6);
        if (IN(pb + 7)) REPS(pb + 7) { PH_VARS LAYER_VARS norm_phase_bf<false>(XB, gain_l + 2 * DM, modl + 6 * DM, H, nullptr, gw, NGW, lane); norm_sample<false>(XS, gain_l + 2 * DM, modl + 6 * DM, H, nullptr, gw, NGW, lane, XSv, PART, DM / 256); }
        SEAM(pb + 7);
        if (IN(pb + 8)) REPS(pb + 8) { PH_VARS LAYER_VARS
            pg8::Gemm g{H, (const bf16_t*)(wl + LW_GU2), MPAD, 2 * FF, DM}; TailOrder S; S.init(2 * FF, G, bx);
            EpiSwiGLU E{ACT};
            pg8::gemm_phase<EpiSwiGLU, TailOrder, PG8_ALIGN, PG8_SP2>(lds, g, S, E, tid);
        }
        SEAM(pb + 8);
        if (IN(pb + 9)) REPS(pb + 9) { PH_VARS LAYER_VARS
            pg8::Gemm g{ACT, (const bf16_t*)(wl + LW_D2), MPAD, DM, FF}; SplitOrder S; S.init(DM, FF, G, bx);
            EpiResid E{nullptr, XB, PART, modl + 8 * DM, 0.5f};
            STAGGER(); pg8::gemm_phase<EpiResid, SplitOrder, PG8_ALIGN, PG8_SP2>(lds, g, S, E, tid);
        }
        SEAM(pb + 9);
    }
    if (IN(22)) REPS(22) { PH_VARS norm_phase_bf<true>((const bf16_t*)(ws + WS_X), Pk->in[22], nullptr, nullptr, Pk->out, gw, NGW, lane); norm_sample<true>((const float*)(ws + WS_XS), Pk->in[22], nullptr, nullptr, Pk->out, gw, NGW, lane, nullptr, (const float*)(ws + WS_WADA), FF / 256); }
#undef IN
#undef SEAM
}

extern "C" void kernel_launch(void* const* d_in, const int* in_sizes, int n_in, void* d_out, int out_size, void* d_ws, size_t ws_size, hipStream_t stream) {
    static int grid = 0;
    if (grid == 0) {
        if (n_in != 23 || (size_t)out_size != O_END || ws_size < WS_END) { fprintf(stderr, "kernel_launch: unexpected sizes n_in %d out %d ws %zu\n", n_in, out_size, ws_size); grid = -1; return; }
        int dev = 0, cus = 0, per_cu = 0;
        (void)hipGetDevice(&dev); (void)hipDeviceGetAttribute(&cus, hipDeviceAttributeMultiprocessorCount, dev);
        if (hipFuncSetAttribute((const void*)fwd, hipFuncAttributeMaxDynamicSharedMemorySize, LDS_BYTES) != hipSuccess) { fprintf(stderr, "kernel_launch: hipFuncSetAttribute failed\n"); grid = -1; return; }
        if (hipOccupancyMaxActiveBlocksPerMultiprocessor(&per_cu, (const void*)fwd, 512, LDS_BYTES) != hipSuccess || per_cu < 1) { fprintf(stderr, "kernel_launch: occupancy query says %d\n", per_cu); per_cu = 1; }
        (void)hipGetLastError();
        grid = cus * per_cu;
    }
    if (grid < 0) return;
    Params p{};
    for (int i = 0; i < 23; ++i) p.in[i] = (const float*)d_in[i];
    p.out = (float*)d_out; p.ws = (unsigned char*)d_ws;
#if N_LAUNCH_PER_PHASE
    for (int ph = 0; ph < NPH; ++ph) { p.ph_lo = ph; p.ph_hi = ph + 1; hipLaunchKernelGGL(fwd, dim3(grid), dim3(512), LDS_BYTES, stream, p); }
#else
    p.ph_lo = 0; p.ph_hi = NPH;
    if (hipMemsetAsync((char*)d_ws + WS_BAR, 0, WS_BAR_BYTES, stream) != hipSuccess) { fprintf(stderr, "kernel_launch: memset failed\n"); return; }
    void* args[] = {&p};
    hipError_t e = hipLaunchCooperativeKernel((const void*)fwd, dim3(grid), dim3(512), args, LDS_BYTES, stream);
    if (e != hipSuccess) fprintf(stderr, "kernel_launch: cooperative launch failed: %s (grid %d)\n", hipGetErrorString(e), grid);
#endif
}
```

```cpp
#define STAG_TICKS 0
#include <hip/hip_runtime.h>
#include <hip/hip_cooperative_groups.h>
#include <cstdio>
#include <cstdint>
namespace cg = cooperative_groups;
namespace pg8 {
#define PG8_LAS __attribute__((address_space(3)))
typedef unsigned short bf16_t;
typedef short bf16x8 __attribute__((ext_vector_type(8)));
typedef float f32x4 __attribute__((ext_vector_type(4)));
typedef unsigned u32x4 __attribute__((ext_vector_type(4)));
constexpr int BM = 256, BK = 64, HALF = 128, HTB = HALF * BK * 2  , STAGE_BYTES = 8 * HTB, NXCD = 8, WGM = 8;

__host__ __device__ __forceinline__ int lds_byte(int r, int c) { const int st = (r >> 4) * 2 + (c >> 5), rr = r & 15, cc = c & 31, ob = rr * 64 + cc * 2; return st * 1024 + (ob ^ (((ob >> 9) & 1) << 5)); }
__host__ __device__ __forceinline__ void stage_rc(int b, int& R, int& C) { const int st = b / 1024, sb = b % 1024, swz = sb ^ (((sb >> 9) & 1) << 5); R = (st >> 1) * 16 + swz / 64; C = (st & 1) * 32 + (swz % 64) / 2; }
__host__ __device__ __forceinline__ int perm32(int rho) { const int n = rho >> 4, i = rho & 15; return 8 * (i >> 2) + 4 * n + (i & 3); }

struct Unit { int pm, pn, k0; };
struct Gemm { const bf16_t* A; const bf16_t* Bt; int M, N, K; };

struct StaticOrder {
    static constexpr bool SPLIT = false;
    int nM, nN, nwg, G, c;
    __host__ __device__ void init(int M, int N, int G_, int c_, int K_ = 1024, int half_pm_ = -1) { nM = M / BM; nN = N / BM; nwg = nM * nN; G = G_; c = c_; (void)K_; (void)half_pm_; }
    __host__ __device__ bool next(int i, Unit& u) const {
        const long L = (long)i * G + c; if (L >= nwg) return false;
        int wgid = (int)L; { const int q = nwg / NXCD, r = nwg % NXCD, xcd = wgid % NXCD, off = wgid / NXCD; wgid = (xcd < r ? xcd * (q + 1) : r * (q + 1) + (xcd - r) * q) + off; }
        const int nig = WGM * nN, gid = wgid / nig, fm = gid * WGM, gsz = (nM - fm) < WGM ? (nM - fm) : WGM;
        u.pm = fm + ((wgid % nig) % gsz); u.pn = (wgid % nig) / gsz; u.k0 = 0; return true;
    }
    __device__ __forceinline__ void a_ready(const Unit&) const {}
    __device__ __forceinline__ void done(const Unit&) const {}
};

__device__ __forceinline__ unsigned cvt_pk_bf16(float lo, float hi) { unsigned r; asm volatile("v_cvt_pk_bf16_f32 %0, %1, %2" : "=v"(r) : "v"(lo), "v"(hi)); return r; }
typedef float f32x2 __attribute__((ext_vector_type(2)));
template <class Epi, class Sched, bool ALIGN_EPI = false, bool SP2 = false>
__device__ __forceinline__ void gemm_phase(PG8_LAS unsigned char* lds, const Gemm g, const Sched& S, const Epi& E, const int tid_in) {
    const int tid = tid_in, wid = __builtin_amdgcn_readfirstlane(tid >> 6), lane = tid & 63, wr = wid >> 2, wc = wid & 3, fr = lane & 15, fq = lane >> 4;
    const int K = g.K;
    unsigned voffA[2], voffB[2];
#pragma unroll
    for (int i = 0; i < 2; ++i) { int R, C; stage_rc(tid * 16 + i * 8192, R, C); const int Rb = Epi::PERM ? ((R & ~31) + perm32(R & 31)) : R;
        voffA[i] = (unsigned)(R * K + C) * 2u; voffB[i] = (unsigned)(Rb * K + C) * 2u; }
    const size_t kstep = (size_t)(BK * 2);
    const size_t hstep = (size_t)HALF * K * 2;
    const size_t tstep = 2 * hstep;
    const unsigned ldsw = (unsigned)wid * 1024u;
    const int aoff = lds_byte(wr * 64 + fr, fq * 8), boff = lds_byte(wc * 32 + fr, fq * 8);
#define PG8_SA(b, h) (((b) * 2 + (h)) * HTB)
#define PG8_SB(b, h) ((4 + (b) * 2 + (h)) * HTB)
#define PG8_STAGE(bufoff, gbase, voff) do { _Pragma("unroll") for (int _i = 0; _i < 2; ++_i) \
        __builtin_amdgcn_global_load_lds((const unsigned*)((const char*)(gbase) + (voff)[_i]), (PG8_LAS unsigned*)(lds + (bufoff) + ldsw + _i * 8192), 16, 0, 0); } while (0)
#define PG8_LDA(dst, b, h) do { _Pragma("unroll") for (int m = 0; m < 4; ++m) _Pragma("unroll") for (int k = 0; k < 2; ++k) dst[m][k] = *(const PG8_LAS bf16x8*)(lds + PG8_SA(b, h) + aoff + m * 2048 + k * 1024); } while (0)
#define PG8_LDB(dst, b, h) do { _Pragma("unroll") for (int n = 0; n < 2; ++n) _Pragma("unroll") for (int k = 0; k < 2; ++k) dst[n][k] = *(const PG8_LAS bf16x8*)(lds + PG8_SB(b, h) + boff + n * 2048 + k * 1024); } while (0)
#define PG8_MMA(ai, bj, At, Bt) do { __builtin_amdgcn_s_setprio(1); _Pragma("unroll") for (int m = 0; m < 4; ++m) _Pragma("unroll") for (int n = 0; n < 2; ++n) _Pragma("unroll") for (int k = 0; k < 2; ++k) \
        acc[ai][bj][m][n] = __builtin_amdgcn_mfma_f32_16x16x32_bf16(Bt[n][k], At[m][k], acc[ai][bj][m][n], 0, 0, 0); __builtin_amdgcn_s_setprio(0); } while (0)
#define PG8_WAIT_V(n) asm volatile("s_waitcnt vmcnt(" #n ")" ::: "memory")
#define PG8_WAIT_L(n) asm volatile("s_waitcnt lgkmcnt(" #n ")" ::: "memory")
#define PG8_BAR __builtin_amdgcn_s_barrier()
#define PG8_SCHED __builtin_amdgcn_sched_barrier(0)
    Unit cur, nxt; int ui = 0;
    if (!S.next(0, cur)) return;
    f32x4 acc[2][2][4][2];
#pragma unroll
    for (int a = 0; a < 2; ++a)
#pragma unroll
        for (int b = 0; b < 2; ++b)
#pragma unroll
            for (int m = 0; m < 4; ++m)
#pragma unroll
                for (int n = 0; n < 2; ++n) acc[a][b][m][n] = (f32x4){0.f, 0.f, 0.f, 0.f};
    bf16x8 At[4][2], B0[2][2], B1[2][2];
    const char* cA = (const char*)g.A + (size_t)cur.pm * tstep + (size_t)cur.k0 * kstep; const char* cB = (const char*)g.Bt + (size_t)cur.pn * tstep + (size_t)cur.k0 * kstep;
    S.a_ready(cur);
    if constexpr (SP2) {
        PG8_STAGE(PG8_SB(0, 0), cB, voffB); PG8_STAGE(PG8_SB(0, 1), cB + hstep, voffB); PG8_STAGE(PG8_SA(0, 0), cA, voffA); PG8_STAGE(PG8_SA(0, 1), cA + hstep, voffA);
        if (wr == 1) PG8_BAR;
        PG8_WAIT_V(2); PG8_BAR;
        PG8_STAGE(PG8_SB(1, 0), cB + kstep, voffB); PG8_STAGE(PG8_SA(1, 0), cA + kstep, voffA); PG8_STAGE(PG8_SB(1, 1), cB + hstep + kstep, voffB);
        PG8_WAIT_V(6); PG8_BAR;
    } else {
        PG8_STAGE(PG8_SB(0, 0), cB, voffB); PG8_STAGE(PG8_SA(0, 0), cA, voffA); PG8_STAGE(PG8_SB(0, 1), cB + hstep, voffB); PG8_STAGE(PG8_SA(0, 1), cA + hstep, voffA);
        if (wr == 1) PG8_BAR;
        PG8_WAIT_V(4); PG8_BAR;
        PG8_STAGE(PG8_SB(1, 0), cB + kstep, voffB); PG8_STAGE(PG8_SA(1, 0), cA + kstep, voffA); PG8_STAGE(PG8_SB(1, 1), cB + hstep + kstep, voffB);
        PG8_WAIT_V(6); PG8_BAR;
    }
    for (;;) {
        const bool has_next = S.next(ui + 1, nxt);
        const char* nA = has_next ? (const char*)g.A + (size_t)nxt.pm * tstep + (size_t)nxt.k0 * kstep : cA; const char* nB = has_next ? (const char*)g.Bt + (size_t)nxt.pn * tstep + (size_t)nxt.k0 * kstep : cB;
        const bool full = (cur.pm != 128); const int nt = (Sched::SPLIT && !full) ? 4 : K / BK;
        for (int t = 0; t < nt; t += 2) {
            const bool last = (t == nt - 2);
            const char* a1 = cA + (size_t)(t + 1) * kstep;
            const char* a2 = last ? nA : cA + (size_t)(t + 2) * kstep; const char* b2 = last ? nB : cB + (size_t)(t + 2) * kstep;
            const char* a3 = a2 + kstep; const char* b3 = b2 + kstep;
            if (last && has_next) S.a_ready(nxt);
            if constexpr (SP2) {
            PG8_LDB(B0, 0, 0); PG8_LDB(B1, 0, 1); PG8_SCHED; PG8_LDA(At, 0, 0); PG8_STAGE(PG8_SA(1, 1), a1 + hstep, voffA);
            PG8_WAIT_V(8); PG8_WAIT_L(0); PG8_BAR; PG8_MMA(0, 0, At, B0); PG8_MMA(0, 1, At, B1); PG8_BAR; PG8_SCHED;
            if (full) PG8_LDA(At, 0, 1); PG8_STAGE(PG8_SB(0, 0), b2, voffB); PG8_STAGE(PG8_SB(0, 1), b2 + hstep, voffB); PG8_STAGE(PG8_SA(0, 0), a2, voffA);
            PG8_WAIT_V(8); PG8_WAIT_L(0); PG8_BAR; if (full) { PG8_MMA(1, 0, At, B0); PG8_MMA(1, 1, At, B1); } PG8_BAR; PG8_SCHED;
            PG8_LDB(B0, 1, 0); PG8_LDB(B1, 1, 1); PG8_SCHED; PG8_LDA(At, 1, 0); PG8_STAGE(PG8_SA(0, 1), a2 + hstep, voffA);
            PG8_WAIT_V(8); PG8_WAIT_L(0); PG8_BAR; PG8_MMA(0, 0, At, B0); PG8_MMA(0, 1, At, B1); PG8_BAR; PG8_SCHED;
            if (full) PG8_LDA(At, 1, 1); PG8_STAGE(PG8_SB(1, 0), b3, voffB); PG8_STAGE(PG8_SB(1, 1), b3 + hstep, voffB); PG8_STAGE(PG8_SA(1, 0), a3, voffA);
            PG8_WAIT_V(8); PG8_WAIT_L(0); PG8_BAR; if (full) { PG8_MMA(1, 0, At, B0); PG8_MMA(1, 1, At, B1); } PG8_BAR; PG8_SCHED;
            } else {
            PG8_LDB(B0, 0, 0); PG8_SCHED; PG8_LDA(At, 0, 0); PG8_STAGE(PG8_SA(1, 1), a1 + hstep, voffA);
            PG8_WAIT_L(8); PG8_BAR; PG8_WAIT_L(0); PG8_MMA(0, 0, At, B0); PG8_BAR; PG8_SCHED;
            PG8_LDB(B1, 0, 1); PG8_STAGE(PG8_SB(0, 0), b2, voffB);
            PG8_BAR; PG8_WAIT_L(0); PG8_MMA(0, 1, At, B1); PG8_BAR;
            PG8_LDA(At, 0, 1); PG8_STAGE(PG8_SA(0, 0), a2, voffA);
            PG8_BAR; PG8_WAIT_L(0); PG8_MMA(1, 0, At, B0); PG8_BAR; PG8_SCHED;
            PG8_STAGE(PG8_SB(0, 1), b2 + hstep, voffB);
            PG8_WAIT_V(6); PG8_BAR; PG8_MMA(1, 1, At, B1); PG8_BAR;
            PG8_LDB(B0, 1, 0); PG8_SCHED; PG8_LDA(At, 1, 0); PG8_STAGE(PG8_SA(0, 1), a2 + hstep, voffA);
            PG8_WAIT_L(8); PG8_BAR; PG8_WAIT_L(0); PG8_MMA(0, 0, At, B0); PG8_BAR; PG8_SCHED;
            PG8_LDB(B1, 1, 1); PG8_STAGE(PG8_SB(1, 0), b3, voffB);
            PG8_BAR; PG8_WAIT_L(0); PG8_MMA(0, 1, At, B1); PG8_BAR;
            PG8_LDA(At, 1, 1); PG8_STAGE(PG8_SA(1, 0), a3, voffA);
            PG8_BAR; PG8_WAIT_L(0); PG8_MMA(1, 0, At, B0); PG8_BAR; PG8_SCHED;
            PG8_STAGE(PG8_SB(1, 1), b3 + hstep, voffB);
            PG8_WAIT_V(6); PG8_BAR; PG8_MMA(1, 1, At, B1); PG8_BAR;
            }
        }
        if constexpr (ALIGN_EPI) { if (wr == 0) PG8_BAR; }
        if constexpr (!Epi::AFTER_DRAIN) { E(acc, cur, wr, wc, fr, fq); S.done(cur); }
        if (!has_next) break;
#pragma unroll
        for (int a = 0; a < 2; ++a)
#pragma unroll
            for (int b = 0; b < 2; ++b)
#pragma unroll
                for (int m = 0; m < 4; ++m)
#pragma unroll
                    for (int n = 0; n < 2; ++n) acc[a][b][m][n] = (f32x4){0.f, 0.f, 0.f, 0.f};
        cur = nxt; cA = nA; cB = nB; ++ui;
        if constexpr (ALIGN_EPI) { if (wr == 1) PG8_BAR; }
    }
    PG8_WAIT_V(0);
    if constexpr (!ALIGN_EPI) { if (wr == 0) PG8_BAR; }
    PG8_BAR;
    if constexpr (Epi::AFTER_DRAIN) { E.fused(acc, cur, wr, wc, fr, fq, lds, wid, lane); S.done(cur); }
#undef PG8_SA
#undef PG8_SB
#undef PG8_STAGE
#undef PG8_LDA
#undef PG8_LDB
#undef PG8_MMA
#undef PG8_WAIT_V
#undef PG8_WAIT_L
#undef PG8_BAR
#undef PG8_SCHED
}
}
#ifndef PG8_SP2
#define PG8_SP2 true
#endif
#ifndef PG8_ALIGN
#define PG8_ALIGN true
#endif
#ifndef N_LAUNCH_PER_PHASE
#define N_LAUNCH_PER_PHASE 0
#endif

#define DI __device__ __forceinline__
#define LAS __attribute__((address_space(3)))
typedef unsigned short bf16_t;
typedef short bf16x8 __attribute__((ext_vector_type(8)));
typedef short s16x4 __attribute__((ext_vector_type(4)));
typedef float f32x4 __attribute__((ext_vector_type(4)));
typedef float f32x2 __attribute__((ext_vector_type(2)));
typedef float f32x16 __attribute__((ext_vector_type(16)));
typedef unsigned u32x4 __attribute__((ext_vector_type(4)));
typedef unsigned u32x2 __attribute__((ext_vector_type(2)));
typedef __bf16 bf16x2_t __attribute__((ext_vector_type(2)));

constexpr int TP = 32768, TS = 128, TT = TP + TS, MPAD = 33024;
constexpr int DM = 1024, FF = 2816, INW = 1280, NMOD = 9216, MODLD = 2 * NMOD;
constexpr int SEQ = 4096;
constexpr float EPS = 1e-6f, LOG2E = 1.4426950408889634f, C2 = 0.125f * 1.4426950408889634f;
constexpr int TBLD = 132;
constexpr size_t O_Y = 0, O_KP = 33685504, O_VP = 33947648, O_PP = 34209792, O_KS = 34332672, O_VS = 38526976, O_PS = 42721280, O_END = 44687360;
constexpr size_t MiB = 1u << 20;
constexpr size_t WS_XS = 1 * (1u << 20) + 512 * 1024;
constexpr size_t WS_BAR = 65536, WS_BAR_BYTES = 16384;
constexpr size_t WS_TB = 0, WS_CS = 1 * MiB, WS_MOD = 2 * MiB, WS_WADA = 12 * MiB, WS_L0 = 48 * MiB, LAYER_BYTES = 38 * MiB;
constexpr size_t LW_GU1 = 0, LW_D1 = 11 * MiB, LW_IN = 16 * MiB + MiB / 2, LW_OUT = 19 * MiB, LW_GU2 = 21 * MiB, LW_D2 = 32 * MiB, LW_POOL = 37 * MiB + MiB / 2;
constexpr size_t WS_X = 124 * MiB, WS_H = 253 * MiB, WS_ACT = 318 * MiB, WS_Z = WS_ACT, WS_MIX = WS_ACT + 96 * MiB, WS_END = 496 * MiB;
static_assert(WS_X + (size_t)MPAD * DM * 4 <= WS_H && WS_H + (size_t)MPAD * DM * 2 <= WS_ACT && WS_ACT + (size_t)MPAD * FF * 2 <= WS_END, "ws map");
static_assert(WS_Z + (size_t)MPAD * INW * 2 <= WS_MIX && WS_MIX + (size_t)MPAD * DM * 2 <= WS_END, "ws map 2");
static_assert(WS_MOD + (size_t)136 * MODLD * 4 <= WS_WADA && WS_WADA + (size_t)MODLD * DM * 2 <= WS_L0 && WS_L0 + 2 * LAYER_BYTES <= WS_X, "ws map 3");
constexpr int LDS_BYTES = 147456;
constexpr int NPH = 23;

struct Params { const float* in[23]; float* out; unsigned char* ws; int ph_lo, ph_hi; };

DI float bf2f(bf16_t b) { return __uint_as_float((unsigned)b << 16); }
DI unsigned pk2(float lo, float hi) { f32x2 v = {lo, hi}; bf16x2_t b = __builtin_convertvector(v, bf16x2_t); return __builtin_bit_cast(unsigned, b); }
DI float wave_sum(float v) {
#pragma unroll
    for (int o = 1; o < 64; o <<= 1) v += __shfl_xor(v, o);
    return v;
}
DI float wave_max(float v) {
#pragma unroll
    for (int o = 1; o < 64; o <<= 1) v = fmaxf(v, __shfl_xor(v, o));
    return v;
}
DI int crow(int r, int hi) { return (r & 3) + 8 * (r >> 2) + 4 * hi; }
DI f32x4 bf4_to_f4(const bf16_t* p) { const u32x2 v = *(const u32x2*)p; return (f32x4){__uint_as_float(v.x << 16), __uint_as_float(v.x & 0xffff0000u), __uint_as_float(v.y << 16), __uint_as_float(v.y & 0xffff0000u)}; }
#define MFMA32(a, b, c) __builtin_amdgcn_mfma_f32_32x32x16_bf16((a), (b), (c), 0, 0, 0)

struct EpiStoreBf16 {
    static constexpr bool PERM = true, AFTER_DRAIN = false;
    bf16_t* O; int ldc;
    DI void operator()(const pg8::f32x4 (&acc)[2][2][4][2], const pg8::Unit& u, int wr, int wc, int fr, int fq) const {
        const int row0 = u.pm * 256 + wr * 64 + fr, col0 = u.pn * 256 + wc * 32 + 8 * fq;
#pragma unroll
        for (int ai = 0; ai < 2; ++ai)
#pragma unroll
            for (int m = 0; m < 4; ++m) { bf16_t* rowp = O + (size_t)(row0 + ai * 128 + m * 16) * ldc + col0;
#pragma unroll
                for (int bj = 0; bj < 2; ++bj) { const f32x4 v0 = acc[ai][bj][m][0], v1 = acc[ai][bj][m][1];
                    u32x4 w; w.x = pk2(v0[0], v0[1]); w.y = pk2(v0[2], v0[3]); w.z = pk2(v1[0], v1[1]); w.w = pk2(v1[2], v1[3]);
                    *(u32x4*)(rowp + bj * 128) = w; } }
    }
};
DI float silu_mul(float g, float u) { return g * u * __builtin_amdgcn_rcpf(1.0f + __builtin_amdgcn_exp2f(-g * LOG2E)); }
struct EpiSwiGLU {
    static constexpr bool PERM = true, AFTER_DRAIN = false;
    bf16_t* O;
    DI void operator()(const pg8::f32x4 (&acc)[2][2][4][2], const pg8::Unit& u, int wr, int wc, int fr, int fq) const {
        const int row0 = u.pm * 256 + wr * 64 + fr, col0 = u.pn * 128 + wc * 32 + 8 * fq;
#pragma unroll
        for (int ai = 0; ai < 2; ++ai)
#pragma unroll
            for (int m = 0; m < 4; ++m) { bf16_t* rowp = O + (size_t)(row0 + ai * 128 + m * 16) * FF + col0;
                const f32x4 g0 = acc[ai][0][m][0], g1 = acc[ai][0][m][1], u0 = acc[ai][1][m][0], u1 = acc[ai][1][m][1];
                u32x4 w; w.x = pk2(silu_mul(g0[0], u0[0]), silu_mul(g0[1], u0[1])); w.y = pk2(silu_mul(g0[2], u0[2]), silu_mul(g0[3], u0[3]));
                w.z = pk2(silu_mul(g1[0], u1[0]), silu_mul(g1[1], u1[1])); w.w = pk2(silu_mul(g1[2], u1[2]), silu_mul(g1[3], u1[3]));
                *(u32x4*)rowp = w; }
    }
};
struct TailOrder {
    static constexpr bool SPLIT = false;
    pg8::StaticOrder base; int nmain, nN, G, c;
    DI void init(int N, int G_, int c_) { base.init(TP, N, G_, c_); nN = N / 256; nmain = (TP / 256) * nN; G = G_; c = c_; }
    DI bool next(int i, pg8::Unit& u) const {
        const int L = i * G + c;
        if (L < nmain) return base.next(i, u);
        const int s = L - nmain; if (s >= nN) return false;
        u.pm = TP / 256; u.pn = s; u.k0 = 0; return true;
    }
    DI void a_ready(const pg8::Unit&) const {}
    DI void done(const pg8::Unit&) const {}
};
struct SplitOrder {
    static constexpr bool SPLIT = true;
    pg8::StaticOrder base; int nmain, nN, nchunk, G, c;
    DI void init(int N, int K, int G_, int c_) { base.init(TP, N, G_, c_, K, -1); nN = N / 256; nmain = (TP / 256) * nN; nchunk = K / 256; G = G_; c = c_; }
    DI bool next(int i, pg8::Unit& u) const {
        const int L = i * G + c;
        if (L < nmain) return base.next(i, u);
        const int s = L - nmain; if (s >= nN * nchunk) return false;
        u.pm = TP / 256; u.pn = s % nN; u.k0 = (s / nN) * 4; return true;
    }
    DI void a_ready(const pg8::Unit&) const {}
    DI void done(const pg8::Unit&) const {}
};
struct EpiResid {
    static constexpr bool PERM = true, AFTER_DRAIN = false;
    const float* xin_f32; bf16_t* XB; float* PART; const float* gate; float coef;
    DI void operator()(const pg8::f32x4 (&acc)[2][2][4][2], const pg8::Unit& u, int wr, int wc, int fr, int fq) const {
        const int row0 = u.pm * 256 + wr * 64 + fr, col0 = u.pn * 256 + wc * 32 + 8 * fq;
        if (u.pm == TP / 256) {
#pragma unroll
            for (int m = 0; m < 4; ++m) { const int row = row0 + m * 16; const float* gp = gate + (size_t)(8 + row - TP) * MODLD; float* dst = PART + ((size_t)(u.k0 >> 2) * 128 + (row - TP)) * DM;
#pragma unroll
                for (int bj = 0; bj < 2; ++bj)
#pragma unroll
                    for (int n = 0; n < 2; ++n) { const int col = col0 + bj * 128 + n * 4; const f32x4 gv = *(const f32x4*)(gp + col); const f32x4 v = (gv * coef) * acc[0][bj][m][n];
                        *(f32x4*)(dst + col) = v; } }
            return;
        }
        const float* gp = gate + (size_t)(u.pm >> 4) * MODLD;
        f32x4 gv[2][2];
#pragma unroll
        for (int bj = 0; bj < 2; ++bj)
#pragma unroll
            for (int n = 0; n < 2; ++n) gv[bj][n] = *(const f32x4*)(gp + col0 + bj * 128 + n * 4) * coef;
        if (xin_f32) {
#pragma unroll
            for (int ai = 0; ai < 2; ++ai)
#pragma unroll
                for (int m = 0; m < 4; ++m) { const size_t ro = (size_t)(row0 + ai * 128 + m * 16) * DM + col0;
#pragma unroll
                    for (int bj = 0; bj < 2; ++bj) { const f32x4 x0 = *(const f32x4*)(xin_f32 + ro + bj * 128), x1 = *(const f32x4*)(xin_f32 + ro + bj * 128 + 4);
                        const f32x4 o0 = x0 + gv[bj][0] * acc[ai][bj][m][0], o1 = x1 + gv[bj][1] * acc[ai][bj][m][1];
                        u32x4 w; w.x = pk2(o0[0], o0[1]); w.y = pk2(o0[2], o0[3]); w.z = pk2(o1[0], o1[1]); w.w = pk2(o1[2], o1[3]);
                        *(u32x4*)(XB + ro + bj * 128) = w; } }
        } else {
#pragma unroll
            for (int ai = 0; ai < 2; ++ai) {
                u32x4 xr[4][2];
#pragma unroll
                for (int m = 0; m < 4; ++m)
#pragma unroll
                    for (int bj = 0; bj < 2; ++bj) xr[m][bj] = *(const u32x4*)(XB + (size_t)(row0 + ai * 128 + m * 16) * DM + col0 + bj * 128);
                asm volatile("" ::: "memory");
#pragma unroll
                for (int m = 0; m < 4; ++m)
#pragma unroll
                    for (int bj = 0; bj < 2; ++bj) { const u32x4 r = xr[m][bj];
                        const f32x4 x0 = {__uint_as_float(r.x << 16), __uint_as_float(r.x & 0xffff0000u), __uint_as_float(r.y << 16), __uint_as_float(r.y & 0xffff0000u)};
                        const f32x4 x1 = {__uint_as_float(r.z << 16), __uint_as_float(r.z & 0xffff0000u), __uint_as_float(r.w << 16), __uint_as_float(r.w & 0xffff0000u)};
                        const f32x4 o0 = x0 + gv[bj][0] * acc[ai][bj][m][0], o1 = x1 + gv[bj][1] * acc[ai][bj][m][1];
                        u32x4 w; w.x = pk2(o0[0], o0[1]); w.y = pk2(o0[2], o0[3]); w.z = pk2(o1[0], o1[1]); w.w = pk2(o1[2], o1[3]);
                        *(u32x4*)(XB + (size_t)(row0 + ai * 128 + m * 16) * DM + col0 + bj * 128) = w; }
                asm volatile("" ::: "memory");
            }
        }
    }
};
struct EpiMod {
    static constexpr bool PERM = false, AFTER_DRAIN = false;
    float* mod; const float* bias;
    DI void operator()(const pg8::f32x4 (&acc)[2][2][4][2], const pg8::Unit& u, int wr, int wc, int fr, int fq) const {
        const int row0 = u.pm * 256 + wr * 64 + fr, col0 = u.pn * 256 + wc * 32 + 4 * fq;
#pragma unroll
        for (int ai = 0; ai < 2; ++ai)
#pragma unroll
            for (int m = 0; m < 4; ++m) { const int row = row0 + ai * 128 + m * 16;
                if (row < 136) {
#pragma unroll
                    for (int bj = 0; bj < 2; ++bj)
#pragma unroll
                        for (int n = 0; n < 2; ++n) { const int col = col0 + bj * 128 + n * 16;
                            *(f32x4*)(mod + (size_t)row * MODLD + col) = acc[ai][bj][m][n] + *(const f32x4*)(bias + col); } } }
    }
};
typedef const __attribute__((address_space(4))) Params* KP;
DI void transpose_item(const float* W, int K, int N, bf16_t* WT, int mode, LAS float* scr, int item, int lane) {
    const int nblk = N / 32, kb = item / nblk, nb = item % nblk, k0 = 64 * kb, n0 = 32 * nb;
#pragma unroll 8
    for (int i = 0; i < 32; ++i) { const int kk = 2 * i + (lane >> 5); scr[kk * 33 + (lane & 31)] = W[(size_t)(k0 + kk) * N + n0 + (lane & 31)]; }
    asm volatile("s_waitcnt lgkmcnt(0)" ::: "memory");
    int rbase = n0;
    if (mode == 1) rbase = (n0 >> 7) * 256 + (n0 & 127);
    if (mode == 2) rbase = (n0 >> 7) * 256 + 128 + (n0 & 127);
    const int c = lane & 7;
#pragma unroll
    for (int j = 0; j < 4; ++j) { const int n = (lane >> 3) + 8 * j; const LAS float* s = scr + (8 * c) * 33 + n;
        u32x4 o; o.x = pk2(s[0 * 33], s[1 * 33]); o.y = pk2(s[2 * 33], s[3 * 33]); o.z = pk2(s[4 * 33], s[5 * 33]); o.w = pk2(s[6 * 33], s[7 * 33]);
        *(u32x4*)(WT + (size_t)(rbase + n) * K + k0 + 8 * c) = o; }
    asm volatile("s_waitcnt lgkmcnt(0)" ::: "memory");
}
constexpr int I_ADA = (DM / 64) * (NMOD / 32), I_FU = (DM / 64) * (FF / 32), I_FD = (FF / 64) * (DM / 32), I_IN = (DM / 64) * (INW / 32), I_OUT = (DM / 64) * (DM / 32), I_POOL = 4 * 8;
constexpr int IPL = I_ADA + 4 * I_FU + 2 * I_FD + I_IN + I_OUT + I_POOL;
DI int t5_bucket(int n) {
    if (n < 16) return n;
    int b = 16;
    b += (n >= 19); b += (n >= 21); b += (n >= 24); b += (n >= 27); b += (n >= 31); b += (n >= 35); b += (n >= 40); b += (n >= 46);
    b += (n >= 52); b += (n >= 59); b += (n >= 67); b += (n >= 77); b += (n >= 87); b += (n >= 99); b += (n >= 113);
    return b;
}
DI void convert_item(KP P, int l, int r, LAS float* scr, int lane) {
    unsigned char* wl = P->ws + WS_L0 + (size_t)l * LAYER_BYTES;
    const float* src; bf16_t* dst; int K, N, mode = 0;
    if (r < I_ADA) { src = P->in[7] + (size_t)l * DM * NMOD; K = DM; N = NMOD; dst = (bf16_t*)(P->ws + WS_WADA) + (size_t)l * NMOD * DM; }
    else if ((r -= I_ADA) < I_FU) { src = P->in[16] + (size_t)l * DM * FF; K = DM; N = FF; dst = (bf16_t*)(wl + LW_GU1); mode = 1; }
    else if ((r -= I_FU) < I_FU) { src = P->in[17] + (size_t)l * DM * FF; K = DM; N = FF; dst = (bf16_t*)(wl + LW_GU1); mode = 2; }
    else if ((r -= I_FU) < I_FD) { src = P->in[18] + (size_t)l * FF * DM; K = FF; N = DM; dst = (bf16_t*)(wl + LW_D1); }
    else if ((r -= I_FD) < I_IN) { src = P->in[10] + (size_t)l * DM * INW; K = DM; N = INW; dst = (bf16_t*)(wl + LW_IN); }
    else if ((r -= I_IN) < I_OUT) { src = P->in[11] + (size_t)l * DM * DM; K = DM; N = DM; dst = (bf16_t*)(wl + LW_OUT); }
    else if ((r -= I_OUT) < I_FU) { src = P->in[19] + (size_t)l * DM * FF; K = DM; N = FF; dst = (bf16_t*)(wl + LW_GU2); mode = 1; }
    else if ((r -= I_FU) < I_FU) { src = P->in[20] + (size_t)l * DM * FF; K = DM; N = FF; dst = (bf16_t*)(wl + LW_GU2); mode = 2; }
    else if ((r -= I_FU) < I_FD) { src = P->in[21] + (size_t)l * FF * DM; K = FF; N = DM; dst = (bf16_t*)(wl + LW_D2); }
    else { r -= I_FD; const int g = r >> 3; r &= 7; src = P->in[14] + (size_t)(l * 4 + g) * 16384; K = 128; N = 128; dst = (bf16_t*)(wl + LW_POOL) + (size_t)g * 16384; }
    transpose_item(src, K, N, dst, mode, scr, r, lane);
}
DI void prologue_rest(KP P, LAS unsigned char* lds, int w, int nw, int wid, int lane) {
    LAS float* scr = (LAS float*)(lds + wid * 8448);
    constexpr int REST = IPL - I_ADA;
    for (int it = w; it < 2 * REST; it += nw) { const int l = it / REST; convert_item(P, l, I_ADA + (it - l * REST), scr, lane); }
}
DI void prologue(KP P, LAS unsigned char* lds, int gw, int NGW, int gtid, int GT, int wid, int lane) {
    LAS float* scr = (LAS float*)(lds + wid * 8448);
    for (int it = gw; it < 2 * I_ADA; it += NGW) { const int l = it / I_ADA; convert_item(P, l, it - l * I_ADA, scr, lane); }
    bf16_t* CS = (bf16_t*)(P->ws + WS_CS);
    for (int idx = gtid; idx < 256 * DM; idx += GT) {
        const int row = idx >> 10; float v = 0.f;
        if (row < 8) v = P->in[2][idx]; else if (row < 136) v = P->in[3][idx - 8 * DM];
        const float s = v / (1.0f + __expf(-v));
        CS[idx] = (bf16_t)(pk2(row < 136 ? s : 0.f, 0.f) & 0xffffu);
    }
    float* TB = (float*)(P->ws + WS_TB);
    for (int idx = gtid; idx < 8 * TBLD; idx += GT) { const int h = idx / TBLD, d = idx % TBLD; const int dd = d < 128 ? d : 128;
        TB[idx] = P->in[13][t5_bucket(dd) * 8 + h] * LOG2E; }
}

template <bool FINAL>
DI void norm_phase(const float* xp, const float* xs, const float* gain, const float* modsh, bf16_t* H, float* Y, int gw, int NGW, int lane, float* xcopy = nullptr, int blk_lo = 0, int blk_hi = TT / 16, int r4_lo = 0, int r4_hi = 16, const float* part = nullptr, int nparts = 0) {
    for (int blk = blk_lo + gw; blk < blk_hi; blk += NGW) {
        const int row0 = blk * 16; const bool prompt = row0 < TP;
        f32x4 Gv[4], Sv[4];
        if (FINAL) {
#pragma unroll
            for (int j = 0; j < 4; ++j) { Gv[j] = ((const f32x4*)gain)[lane + 64 * j]; Sv[j] = (f32x4){0.f, 0.f, 0.f, 0.f}; }
        } else if (prompt) {
            const float* mp = modsh + (size_t)(row0 >> 12) * MODLD;
#pragma unroll
            for (int j = 0; j < 4; ++j) { Gv[j] = ((const f32x4*)gain)[lane + 64 * j] * (((const f32x4*)(mp + DM))[lane + 64 * j] + 1.0f); Sv[j] = ((const f32x4*)mp)[lane + 64 * j]; }
        }
#pragma unroll 1
        for (int r4 = r4_lo; r4 < r4_hi; r4 += 4) {
            f32x4 v[4][4]; float ss[4];
#pragma unroll
            for (int q = 0; q < 4; ++q) { const int row = row0 + r4 + q;
                const float* xr = row < TP ? xp + (size_t)row * DM : xs + (size_t)(row - TP) * DM;
#pragma unroll
                for (int j = 0; j < 4; ++j) v[q][j] = ((const f32x4*)xr)[lane + 64 * j]; }
            if (part) {
#pragma unroll 3
                for (int p = 0; p < nparts; ++p) {
#pragma unroll
                    for (int q = 0; q < 4; ++q) { const float* pr = part + ((size_t)p * 128 + (row0 + r4 + q - TP)) * DM;
#pragma unroll
                        for (int j = 0; j < 4; ++j) v[q][j] += ((const f32x4*)pr)[lane + 64 * j]; } }
            }
#pragma unroll
            for (int q = 0; q < 4; ++q) { float a = 0.f;
#pragma unroll
                for (int j = 0; j < 4; ++j) a += (v[q][j].x * v[q][j].x + v[q][j].y * v[q][j].y) + (v[q][j].z * v[q][j].z + v[q][j].w * v[q][j].w);
                ss[q] = a; }
#pragma unroll
            for (int o = 1; o < 64; o <<= 1) {
#pragma unroll
                for (int q = 0; q < 4; ++q) ss[q] += __shfl_xor(ss[q], o); }
#pragma unroll
            for (int q = 0; q < 4; ++q) { const int row = row0 + r4 + q;
                if (!FINAL && !prompt) {
                    const float* mp = modsh + (size_t)(8 + row - TP) * MODLD;
#pragma unroll
                    for (int j = 0; j < 4; ++j) { Gv[j] = ((const f32x4*)gain)[lane + 64 * j] * (((const f32x4*)(mp + DM))[lane + 64 * j] + 1.0f); Sv[j] = ((const f32x4*)mp)[lane + 64 * j]; }
                    if (xcopy) {
#pragma unroll
                        for (int j = 0; j < 4; ++j) ((f32x4*)(xcopy + (size_t)row * DM))[lane + 64 * j] = v[q][j]; }
                }
                const float rstd = 1.0f / sqrtf(ss[q] * (1.0f / DM) + EPS);
                if (FINAL) {
#pragma unroll
                    for (int j = 0; j < 4; ++j) ((f32x4*)(Y + (size_t)row * DM))[lane + 64 * j] = v[q][j] * rstd * Gv[j];
                } else {
#pragma unroll
                    for (int j = 0; j < 4; ++j) { const f32x4 h = v[q][j] * rstd * Gv[j] + Sv[j]; u32x2 w; w.x = pk2(h.x, h.y); w.y = pk2(h.z, h.w);
                        ((u32x2*)(H + (size_t)row * DM))[lane + 64 * j] = w; }
                }
            }
        }
    }
}

template <bool FINAL>
DI void norm_sample(const float* xs, const float* gain, const float* modsh, bf16_t* H, float* Y, int gw, int NGW, int lane, float* xcopy, const float* part, int nparts) {
    if ((gw & 63) != 0) return;
    const int ns = (NGW >> 6) > 0 ? (NGW >> 6) : 1;
    for (int k = gw >> 6; k < 32; k += ns) norm_phase<FINAL>(nullptr, xs, gain, modsh, H, Y, 0, 1 << 28, lane, xcopy, TP / 16 + (k >> 2), TP / 16 + (k >> 2) + 1, 4 * (k & 3), 4 * (k & 3) + 4, part, nparts);
}
template <bool FINAL>
DI void norm_phase_bf(const bf16_t* XB, const float* gain, const float* modsh, bf16_t* H, float* Y, int gw, int NGW, int lane) {
    for (int blk = gw; blk < TP / 16; blk += NGW) {
        const int row0 = blk * 16;
        f32x4 Gv[2][2], Sv[2][2];
        const float* mp = FINAL ? nullptr : modsh + (size_t)(row0 >> 12) * MODLD;
#pragma unroll
        for (int j = 0; j < 2; ++j)
#pragma unroll
            for (int h = 0; h < 2; ++h) { const int fi = 2 * lane + 128 * j + h;
                if (FINAL) { Gv[j][h] = ((const f32x4*)gain)[fi]; Sv[j][h] = (f32x4){0.f, 0.f, 0.f, 0.f}; }
                else { Gv[j][h] = ((const f32x4*)gain)[fi] * (((const f32x4*)(mp + DM))[fi] + 1.0f); Sv[j][h] = ((const f32x4*)mp)[fi]; } }
#pragma unroll 1
        for (int r8 = 0; r8 < 16; r8 += 8) {
            u32x4 raw[8][2]; float ss[8];
#pragma unroll
            for (int q = 0; q < 8; ++q)
#pragma unroll
                for (int j = 0; j < 2; ++j) raw[q][j] = *(const u32x4*)(XB + (size_t)(row0 + r8 + q) * DM + 8 * lane + 512 * j);
#pragma unroll
            for (int q = 0; q < 8; ++q) { float a = 0.f;
#pragma unroll
                for (int j = 0; j < 2; ++j)
#pragma unroll
                    for (int e = 0; e < 4; ++e) { const float lo = __uint_as_float(raw[q][j][e] << 16), hi = __uint_as_float(raw[q][j][e] & 0xffff0000u); a += lo * lo + hi * hi; }
                ss[q] = a; }
#pragma unroll
            for (int o = 1; o < 64; o <<= 1) {
#pragma unroll
                for (int q = 0; q < 8; ++q) ss[q] += __shfl_xor(ss[q], o); }
#pragma unroll
            for (int q = 0; q < 8; ++q) { const int row = row0 + r8 + q;
                const float rstd = 1.0f / sqrtf(ss[q] * (1.0f / DM) + EPS);
#pragma unroll
                for (int j = 0; j < 2; ++j) { const u32x4 r = raw[q][j];
                    const f32x4 x0 = {__uint_as_float(r.x << 16), __uint_as_float(r.x & 0xffff0000u), __uint_as_float(r.y << 16), __uint_as_float(r.y & 0xffff0000u)};
                    const f32x4 x1 = {__uint_as_float(r.z << 16), __uint_as_float(r.z & 0xffff0000u), __uint_as_float(r.w << 16), __uint_as_float(r.w & 0xffff0000u)};
                    const f32x4 h0 = x0 * rstd * Gv[j][0] + Sv[j][0], h1 = x1 * rstd * Gv[j][1] + Sv[j][1];
                    if (FINAL) { float* yp = Y + (size_t)row * DM + 8 * lane + 512 * j; __builtin_nontemporal_store(h0, (f32x4*)yp); __builtin_nontemporal_store(h1, (f32x4*)(yp + 4)); }
                    else { u32x4 w; w.x = pk2(h0[0], h0[1]); w.y = pk2(h0[2], h0[3]); w.z = pk2(h1[0], h1[1]); w.w = pk2(h1[2], h1[3]);
                        *(u32x4*)(H + (size_t)row * DM + 8 * lane + 512 * j) = w; }
                }
            }
        }
    }
}

constexpr int KS_LD = 72, VT_LD = 264;
constexpr int ATT_KS = 0, ATT_VT = 256 * KS_LD * 2, ATT_TB = ATT_VT + 64 * VT_LD * 2;
DI void attn_unit(LAS unsigned char* lds, const bf16_t* Z, bf16_t* MIX, const float* TB, const float* sinks_l, int b, int n, int kvh, int tid) {
    asm volatile("" : "+v"(tid));
    const int lane = tid & 63, wid = tid >> 6, r = lane & 31, hh = lane >> 5;
    LAS bf16_t* Ks = (LAS bf16_t*)(lds + ATT_KS); LAS bf16_t* Vt = (LAS bf16_t*)(lds + ATT_VT); LAS float* tb = (LAS float*)(lds + ATT_TB);
    const int base = b * SEQ + n * 128;
#pragma unroll
    for (int i = 0; i < 4; ++i) {
        const int c = tid + 512 * i, key = c >> 3, part = c & 7;
        u32x4 kv = {0u, 0u, 0u, 0u}, vv = {0u, 0u, 0u, 0u};
        if (n > 0 || key >= 128) { const bf16_t* zr = Z + (size_t)(base - 128 + key) * INW + kvh * 64 + part * 8; kv = *(const u32x4*)(zr + 512); vv = *(const u32x4*)(zr + 640); }
        *(LAS u32x4*)(Ks + key * KS_LD + part * 8) = kv;
        LAS bf16_t* vd = Vt + (part * 8) * VT_LD + key;
        vd[0 * VT_LD] = (bf16_t)(vv.x & 0xffffu); vd[1 * VT_LD] = (bf16_t)(vv.x >> 16); vd[2 * VT_LD] = (bf16_t)(vv.y & 0xffffu); vd[3 * VT_LD] = (bf16_t)(vv.y >> 16);
        vd[4 * VT_LD] = (bf16_t)(vv.z & 0xffffu); vd[5 * VT_LD] = (bf16_t)(vv.z >> 16); vd[6 * VT_LD] = (bf16_t)(vv.w & 0xffffu); vd[7 * VT_LD] = (bf16_t)(vv.w >> 16);
    }
    for (int i = tid; i < 4 * TBLD; i += 512) tb[i] = TB[kvh * 4 * TBLD + i];
    const int hl = wid >> 1, h = kvh * 4 + hl;
    const float sink2 = sinks_l[h] * LOG2E;
    LAS const float* tbh = tb + hl * TBLD;
    bf16x8 qf[4];
    {   const bf16_t* qrow = Z + (size_t)(base + (wid & 1) * 64 + r) * INW + h * 64 + 8 * hh;
#pragma unroll
        for (int c = 0; c < 4; ++c) qf[c] = *(const bf16x8*)(qrow + 16 * c); }
    __syncthreads();
#pragma unroll 1
    for (int sub = 0; sub < 2; ++sub) {
        const int qoff = (wid & 1) * 64 + sub * 32, kt0 = qoff >> 5, q = qoff + r;
        f32x16 sc[5];
#pragma unroll
        for (int t = 0; t < 5; ++t) {
#pragma unroll
            for (int i = 0; i < 16; ++i) sc[t][i] = 0.f;
#pragma unroll
            for (int c = 0; c < 4; ++c) { const bf16x8 a = *(LAS const bf16x8*)(Ks + (32 * (kt0 + t) + r) * KS_LD + 16 * c + 8 * hh); sc[t] = MFMA32(a, qf[c], sc[t]); }
        }
        if (sub == 0) {
            const bf16_t* qrow = Z + (size_t)(base + q + 32) * INW + h * 64 + 8 * hh;
#pragma unroll
            for (int c = 0; c < 4; ++c) qf[c] = *(const bf16x8*)(qrow + 16 * c);
        }
        float m = -INFINITY;
        const int rel = r - 4 * hh;
#pragma unroll
        for (int t = 0; t < 5; ++t) {
            const bool dead = (n == 0) && (kt0 + t < 4);
#pragma unroll
            for (int i = 0; i < 16; ++i) {
                const int cc = (i & 3) + 8 * (i >> 2);
                const int dist = 128 - 32 * t + rel - cc;
                bool valid = !dead;
                if (t == 0) valid = valid && (dist <= 128);
                if (t == 4) valid = valid && (dist >= 0);
                const float bias = tbh[(t == 0 || t == 4) ? (valid ? dist : 0) : dist];
                const float val = valid ? sc[t][i] * C2 + bias : -INFINITY;
                sc[t][i] = val; m = fmaxf(m, val);
            }
        }
        m = fmaxf(m, __shfl_xor(m, 32)); m = fmaxf(m, sink2);
        float sum = 0.f;
#pragma unroll
        for (int t = 0; t < 5; ++t)
#pragma unroll
            for (int i = 0; i < 16; ++i) { const float p = __builtin_amdgcn_exp2f(sc[t][i] - m); sc[t][i] = p; sum += p; }
        sum += __shfl_xor(sum, 32); sum += __builtin_amdgcn_exp2f(sink2 - m);
        const float inv = 1.0f / sum;
        f32x16 o[2];
#pragma unroll
        for (int i = 0; i < 16; ++i) { o[0][i] = 0.f; o[1][i] = 0.f; }
#pragma unroll
        for (int t = 0; t < 5; ++t)
#pragma unroll
            for (int s = 0; s < 2; ++s) {
                u32x4 pw; pw.x = pk2(sc[t][8 * s + 0], sc[t][8 * s + 1]); pw.y = pk2(sc[t][8 * s + 2], sc[t][8 * s + 3]); pw.z = pk2(sc[t][8 * s + 4], sc[t][8 * s + 5]); pw.w = pk2(sc[t][8 * s + 6], sc[t][8 * s + 7]);
                const bf16x8 pb = __builtin_bit_cast(bf16x8, pw);
#pragma unroll
                for (int dt = 0; dt < 2; ++dt) {
                    LAS const bf16_t* vr = Vt + (32 * dt + r) * VT_LD + 32 * (kt0 + t) + 16 * s + 4 * hh;
                    const s16x4 lo = *(LAS const s16x4*)vr, hi = *(LAS const s16x4*)(vr + 8);
                    const bf16x8 a = __builtin_shufflevector(lo, hi, 0, 1, 2, 3, 4, 5, 6, 7);
                    o[dt] = MFMA32(a, pb, o[dt]);
                }
            }
        bf16_t* orow = MIX + (size_t)(base + q) * DM + h * 64 + 4 * hh;
#pragma unroll
        for (int dt = 0; dt < 2; ++dt)
#pragma unroll
            for (int g4 = 0; g4 < 4; ++g4) { u32x2 w; w.x = pk2(o[dt][4 * g4 + 0] * inv, o[dt][4 * g4 + 1] * inv); w.y = pk2(o[dt][4 * g4 + 2] * inv, o[dt][4 * g4 + 3] * inv);
                *(u32x2*)(orow + 32 * dt + 8 * g4) = w; }
    }
    __syncthreads();
}

DI void sattn_task(LAS float* wl, const bf16_t* Z, const float* ck, const float* cv, bf16_t* MIX, const float* TB, const float* sinks_l, int s, int kvh, int lane) {
    asm volatile("" : "+v"(lane));
    const bf16_t* zrow = Z + (size_t)(TP + s) * INW;
#pragma unroll
    for (int hl = 0; hl < 4; ++hl) wl[hl * 64 + lane] = bf2f(zrow[(kvh * 4 + hl) * 64 + lane]) * C2;
    const float kn = bf2f(zrow[512 + kvh * 64 + lane]);
    asm volatile("s_waitcnt lgkmcnt(0)" ::: "memory");
    float sc[4][2];
#pragma unroll
    for (int kk = 0; kk < 2; ++kk) {
        const int j = lane + 64 * kk;
        const float* krow = ck + ((size_t)(s * 128 + j) * 2 + kvh) * 64;
        float a[4] = {0.f, 0.f, 0.f, 0.f};
#pragma unroll 8
        for (int d4 = 0; d4 < 16; ++d4) { const f32x4 kv = *(const f32x4*)(krow + 4 * d4);
#pragma unroll
            for (int hl = 0; hl < 4; ++hl) { const f32x4 qv = *(LAS const f32x4*)(wl + hl * 64 + 4 * d4); a[hl] += (kv.x * qv.x + kv.y * qv.y) + (kv.z * qv.z + kv.w * qv.w); } }
#pragma unroll
        for (int hl = 0; hl < 4; ++hl) sc[hl][kk] = a[hl] + TB[(kvh * 4 + hl) * TBLD + (128 - j)];
    }
    float pn[4];
#pragma unroll
    for (int hl = 0; hl < 4; ++hl) {
        const float sink2 = sinks_l[kvh * 4 + hl] * LOG2E;
        const float snew = wave_sum(kn * wl[hl * 64 + lane]) + TB[(kvh * 4 + hl) * TBLD + 0];
        float m = wave_max(fmaxf(sc[hl][0], sc[hl][1])); m = fmaxf(m, fmaxf(snew, sink2));
        const float p0 = __builtin_amdgcn_exp2f(sc[hl][0] - m), p1 = __builtin_amdgcn_exp2f(sc[hl][1] - m), pnw = __builtin_amdgcn_exp2f(snew - m);
        const float sum = wave_sum(p0 + p1) + pnw + __builtin_amdgcn_exp2f(sink2 - m);
        const float inv = 1.0f / sum;
        wl[256 + hl * TBLD + lane] = p0 * inv; wl[256 + hl * TBLD + 64 + lane] = p1 * inv; pn[hl] = pnw * inv;
    }
    asm volatile("s_waitcnt lgkmcnt(0)" ::: "memory");
    const int jg = lane >> 4, d4 = lane & 15;
    f32x4 o[4];
#pragma unroll
    for (int hl = 0; hl < 4; ++hl) o[hl] = (f32x4){0.f, 0.f, 0.f, 0.f};
    const float* vb = cv + ((size_t)(s * 128 + jg) * 2 + kvh) * 64 + 4 * d4;
#pragma unroll 8
    for (int i = 0; i < 32; ++i) { const f32x4 vv = *(const f32x4*)(vb + (size_t)i * 512);
#pragma unroll
        for (int hl = 0; hl < 4; ++hl) o[hl] += vv * wl[256 + hl * TBLD + 4 * i + jg]; }
    const f32x4 vn4 = bf4_to_f4(zrow + 640 + kvh * 64 + 4 * d4);
#pragma unroll
    for (int hl = 0; hl < 4; ++hl) {
#pragma unroll
        for (int e = 0; e < 4; ++e) { float v = o[hl][e]; v += __shfl_xor(v, 16); v += __shfl_xor(v, 32); o[hl][e] = v + pn[hl] * vn4[e]; }
        if (jg == 0) { u32x2 w; w.x = pk2(o[hl][0], o[hl][1]); w.y = pk2(o[hl][2], o[hl][3]); *(u32x2*)(MIX + (size_t)(TP + s) * DM + (kvh * 4 + hl) * 64 + 4 * d4) = w; }
    }
    asm volatile("s_waitcnt lgkmcnt(0)" ::: "memory");
}

constexpr int PU_LD = 136;
constexpr int POOL_U = 0, POOL_P = 144 * PU_LD * 2, POOL_O = POOL_P + 128 * PU_LD * 2;
DI void pool_unit(LAS unsigned char* lds, const bf16_t* Z, const bf16_t* PWT, const float* pscale_l, bf16_t* MIX, int ub, int tid) {
    asm volatile("" : "+v"(tid));
    const int lane = tid & 63, wid = tid >> 6, r = lane & 31, hh = lane >> 5;
    LAS bf16_t* Ug = (LAS bf16_t*)(lds + POOL_U); LAS bf16_t* Pg = (LAS bf16_t*)(lds + POOL_P); LAS bf16_t* Og = (LAS bf16_t*)(lds + POOL_O);
    const int b = ub >> 5, n = ub & 31;
    const bf16_t* zb = Z + (size_t)(b * SEQ + n * 128 - 15) * INW + 768;
    bf16_t* ob = MIX + (size_t)(b * SEQ + n * 128) * DM + 512;
    u32x4 ureg[5];
#define POOL_LOADU(gg) do { _Pragma("unroll") for (int i_ = 0; i_ < 5; ++i_) { const int c_ = tid + 512 * i_, row_ = c_ >> 4, part_ = c_ & 15; \
        u32x4 v_ = {0u, 0u, 0u, 0u}; if (c_ < 143 * 16 && n * 128 - 15 + row_ >= 0) v_ = *(const u32x4*)(zb + (size_t)row_ * INW + (gg) * 128 + part_ * 8); ureg[i_] = v_; } } while (0)
    POOL_LOADU(0);
    const int mt = wid >> 1, nt0 = (wid & 1) * 2;
#pragma unroll 1
    for (int g = 0; g < 4; ++g) {
        const int w = 2 << g;
        bf16x8 bfr[8][2];
#pragma unroll
        for (int ks = 0; ks < 8; ++ks)
#pragma unroll
            for (int qq = 0; qq < 2; ++qq) bfr[ks][qq] = *(const bf16x8*)(PWT + (size_t)g * 16384 + (32 * (nt0 + qq) + r) * 128 + 16 * ks + 8 * hh);
#pragma unroll
        for (int i = 0; i < 5; ++i) { const int c = tid + 512 * i; if (c < 143 * 16) *(LAS u32x4*)(Ug + (c >> 4) * PU_LD + (c & 15) * 8) = ureg[i]; }
        __syncthreads();
        if (g < 3) POOL_LOADU(g + 1);
        {   const int c2 = tid & 63, t0 = wid * 16;
            float a0 = 0.f, a1 = 0.f;
            for (int s = 0; s < w; ++s) { const unsigned uv = *(LAS const unsigned*)(Ug + (t0 + 15 - s) * PU_LD + 2 * c2); a0 += __uint_as_float(uv << 16); a1 += __uint_as_float(uv & 0xffff0000u); }
            for (int t = t0; t < t0 + 16; ++t) {
                const unsigned uv = *(LAS const unsigned*)(Ug + (t + 15) * PU_LD + 2 * c2);
                const float u0 = __uint_as_float(uv << 16), u1 = __uint_as_float(uv & 0xffff0000u);
                const int pos1 = n * 128 + t + 1; const float ic = 1.0f / (float)(pos1 < w ? pos1 : w);
                *(LAS unsigned*)(Pg + t * PU_LD + 2 * c2) = pk2(a0 * ic - u0, a1 * ic - u1);
                if (t + 1 < t0 + 16) {
                    const unsigned ua = *(LAS const unsigned*)(Ug + (t + 16) * PU_LD + 2 * c2), ud = *(LAS const unsigned*)(Ug + (t + 16 - w) * PU_LD + 2 * c2);
                    a0 += __uint_as_float(ua << 16) - __uint_as_float(ud << 16); a1 += __uint_as_float(ua & 0xffff0000u) - __uint_as_float(ud & 0xffff0000u);
                }
            }
        }
        __syncthreads();
        {   f32x16 acc[2];
#pragma unroll
            for (int i = 0; i < 16; ++i) { acc[0][i] = 0.f; acc[1][i] = 0.f; }
#pragma unroll
            for (int ks = 0; ks < 8; ++ks) {
                const bf16x8 a = *(LAS const bf16x8*)(Pg + (32 * mt + r) * PU_LD + 16 * ks + 8 * hh);
#pragma unroll
                for (int qq = 0; qq < 2; ++qq) acc[qq] = MFMA32(a, bfr[ks][qq], acc[qq]);
            }
#pragma unroll
            for (int qq = 0; qq < 2; ++qq) { const int cl = 32 * (nt0 + qq) + r; const float ps = pscale_l[g * 128 + cl];
#pragma unroll
                for (int i = 0; i < 16; ++i) Og[(32 * mt + crow(i, hh)) * PU_LD + cl] = (bf16_t)(pk2(acc[qq][i] * ps, 0.f) & 0xffffu); }
        }
        __syncthreads();
#pragma unroll
        for (int i = 0; i < 4; ++i) { const int c = tid + 512 * i, row = c >> 4, part = c & 15;
            *(u32x4*)(ob + (size_t)row * DM + g * 128 + part * 8) = *(LAS const u32x4*)(Og + row * PU_LD + part * 8); }
    }
#undef POOL_LOADU
}
DI void pool_unit_sample(LAS unsigned char* lds, const bf16_t* Z, const float* sp_l, const bf16_t* PWT, const float* pscale_l, bf16_t* MIX, int k, int tid) {
    asm volatile("" : "+v"(tid));
    const int lane = tid & 63, wid = tid >> 6, r = lane & 31, hh = lane >> 5;
    LAS bf16_t* Pg = (LAS bf16_t*)(lds + POOL_P);
    const int g = k >> 2, s0 = (k & 3) * 32, w = 2 << g;
    for (int idx = tid; idx < 32 * 64; idx += 512) { const int sl = idx >> 6, c2 = idx & 63, s = s0 + sl;
        const unsigned uv = *(const unsigned*)(Z + (size_t)(TP + s) * INW + 768 + g * 128 + 2 * c2);
        const float u0 = __uint_as_float(uv << 16), u1 = __uint_as_float(uv & 0xffff0000u);
        float a0 = u0, a1 = u1;
#pragma unroll
        for (int i = 0; i < 15; ++i) { if (i >= 16 - w) { const f32x2 sv = *(const f32x2*)(sp_l + ((size_t)s * 15 + i) * 512 + g * 128 + 2 * c2); a0 += sv.x; a1 += sv.y; } }
        const float ic = 1.0f / (float)w;
        *(LAS unsigned*)(Pg + sl * PU_LD + 2 * c2) = pk2(a0 * ic - u0, a1 * ic - u1); }
    __syncthreads();
    if (wid < 2) {
        f32x16 acc[2];
#pragma unroll
        for (int i = 0; i < 16; ++i) { acc[0][i] = 0.f; acc[1][i] = 0.f; }
#pragma unroll
        for (int ks = 0; ks < 8; ++ks) {
            const bf16x8 a = *(LAS const bf16x8*)(Pg + r * PU_LD + 16 * ks + 8 * hh);
#pragma unroll
            for (int qq = 0; qq < 2; ++qq) { const bf16x8 bb = *(const bf16x8*)(PWT + (size_t)g * 16384 + (32 * (wid * 2 + qq) + r) * 128 + 16 * ks + 8 * hh); acc[qq] = MFMA32(a, bb, acc[qq]); }
        }
#pragma unroll
        for (int qq = 0; qq < 2; ++qq) { const int col = g * 128 + 32 * (wid * 2 + qq) + r; const float ps = pscale_l[col];
#pragma unroll
            for (int i = 0; i < 16; ++i) MIX[(size_t)(TP + s0 + crow(i, hh)) * DM + 512 + col] = (bf16_t)(pk2(acc[qq][i] * ps, 0.f) & 0xffffu); }
    }
    __syncthreads();
}

DI void states_copy(KP P, const bf16_t* Z, int l, int gtid, int GT) {
    float* out = P->out;
    for (int idx = gtid; idx < 8 * 128 * 32; idx += GT) { const int c4 = idx & 31, j = (idx >> 5) & 127, b = idx >> 12;
        const bf16_t* zr = Z + (size_t)(b * SEQ + SEQ - 128 + j) * INW + c4 * 4;
        *(f32x4*)(out + O_KP + ((size_t)(l * 8 + b) * 128 + j) * 128 + c4 * 4) = bf4_to_f4(zr + 512);
        *(f32x4*)(out + O_VP + ((size_t)(l * 8 + b) * 128 + j) * 128 + c4 * 4) = bf4_to_f4(zr + 640); }
    for (int idx = gtid; idx < 8 * 15 * 128; idx += GT) { const int c4 = idx & 127, bi = idx >> 7, i = bi % 15, b = bi / 15;
        *(f32x4*)(out + O_PP + ((size_t)(l * 8 + b) * 15 + i) * 512 + c4 * 4) = bf4_to_f4(Z + (size_t)(b * SEQ + SEQ - 15 + i) * INW + 768 + c4 * 4); }
    for (int idx = gtid; idx < 128 * 32; idx += GT) { const int c4 = idx & 31, s = idx >> 5;
        const bf16_t* zr = Z + (size_t)(TP + s) * INW + c4 * 4;
        *(f32x4*)(out + O_KS + ((size_t)(l * 128 + s) * 128 + 127) * 128 + c4 * 4) = bf4_to_f4(zr + 512);
        *(f32x4*)(out + O_VS + ((size_t)(l * 128 + s) * 128 + 127) * 128 + c4 * 4) = bf4_to_f4(zr + 640); }
    for (int idx = gtid; idx < 128 * 128; idx += GT) { const int c4 = idx & 127, s = idx >> 7;
        *(f32x4*)(out + O_PS + ((size_t)(l * 128 + s) * 15 + 14) * 512 + c4 * 4) = bf4_to_f4(Z + (size_t)(TP + s) * INW + 768 + c4 * 4); }
}
DI void states_shift(KP P, int t, int NT) {
    float* out = P->out; const float* ck = P->in[4]; const float* cv = P->in[5]; const float* sp = P->in[6];
#pragma unroll 4
    for (int idx = t; idx < 256 * 127 * 32; idx += NT) { const int ls = idx / (127 * 32), r = idx - ls * (127 * 32);
        const size_t so = (size_t)ls * 16384 + 128 + (size_t)r * 4, dd = (size_t)ls * 16384 + (size_t)r * 4;
        const f32x4 a = *(const f32x4*)(ck + so), b = *(const f32x4*)(cv + so);
        *(f32x4*)(out + O_KS + dd) = a; *(f32x4*)(out + O_VS + dd) = b; }
#pragma unroll 4
    for (int idx = t; idx < 256 * 14 * 128; idx += NT) { const int ls = idx / (14 * 128), r = idx - ls * (14 * 128);
        *(f32x4*)(out + O_PS + (size_t)ls * 7680 + (size_t)r * 4) = *(const f32x4*)(sp + (size_t)ls * 7680 + 512 + (size_t)r * 4); }
}

#define XB_TMO      128
#define XB_XCNT(j)  (256  + 64 * (j))
#define XB_XSUB(j)  (1280 + 64 * (j))
#define XB_XGEN(j)  (2304 + 64 * (j))
#define XB_TOP      3328
#define XB_TOPGEN   3392
#define XCD_BAR_WORDS 3456
#define XB_SPIN_CAP (1u << 18)

__device__ __forceinline__ unsigned xb_ld(unsigned* p)              { return __hip_atomic_load(p, __ATOMIC_RELAXED, __HIP_MEMORY_SCOPE_AGENT); }
__device__ __forceinline__ unsigned xb_add(unsigned* p, unsigned v) { return __hip_atomic_fetch_add(p, v, __ATOMIC_RELAXED, __HIP_MEMORY_SCOPE_AGENT); }
__device__ __forceinline__ unsigned xb_xcc_id() { return (unsigned)__builtin_amdgcn_s_getreg((3 << 11) | 20) & 0xFu; }
#define XB_SPIN(cond, bar) do { unsigned _sp = 0; while (cond) { __builtin_amdgcn_s_sleep(1); \
    if ((++_sp & 255u) == 0u) { if (xb_ld(&(bar)[XB_TMO])) break; if (_sp > XB_SPIN_CAP) { atomicAdd(&(bar)[XB_TMO], 1u); break; } } } } while (0)

struct XcdBarrier {
    unsigned* bar; unsigned x;
    volatile LAS unsigned* st;
};

__device__ __forceinline__ XcdBarrier xcd_barrier_post(unsigned* bar, volatile LAS unsigned* st) {
    XcdBarrier b; b.bar = bar; b.x = xb_xcc_id(); b.st = st;
    if (threadIdx.x == 0) (void)xb_add(&bar[XB_XCNT(b.x)], 1u);
    return b;
}
__device__ __forceinline__ void xcd_barrier_complete(unsigned* bar, unsigned x, unsigned& nloc, unsigned& nx) {
    const unsigned G = gridDim.x * gridDim.y * gridDim.z;
    unsigned sum, cnt, mine, sp = 0u;
    for (;;) {
        sum = 0u; cnt = 0u; mine = 0u;
#pragma unroll
        for (unsigned j = 0; j < 16; ++j) { const unsigned c = xb_ld(&bar[XB_XCNT(j)]); sum += c; cnt += (c > 0u) ? 1u : 0u; mine = (j == x) ? c : mine; }
        if (sum == G) break;
        __builtin_amdgcn_s_sleep(1);
        if ((++sp & 255u) == 0u) { if (xb_ld(&bar[XB_TMO])) break; if (sp > XB_SPIN_CAP) { atomicAdd(&bar[XB_TMO], 1u); break; } }
    }
    nloc = mine > 0u ? mine : 1u; nx = cnt > 0u ? cnt : 1u;
}

__device__ __forceinline__ void xcd_barrier(const XcdBarrier& b) {
    asm volatile("s_waitcnt vmcnt(0)" ::: "memory");
    __syncthreads();
    if (threadIdx.x == 0) {
        unsigned* bar = b.bar;
        __builtin_amdgcn_s_waitcnt(0);
        unsigned nloc = b.st[0], nx = b.st[1];
        if (nloc == 0u) { xcd_barrier_complete(bar, b.x, nloc, nx); b.st[0] = nloc; b.st[1] = nx; }
        const unsigned old = xb_add(&bar[XB_XSUB(b.x)], 1u);
        const unsigned gen = old / nloc;
        if (old + 1u == (gen + 1u) * nloc) {
            __builtin_amdgcn_fence(__ATOMIC_RELEASE, "agent");
            asm volatile("s_waitcnt vmcnt(0)" ::: "memory");
            const unsigned og = xb_add(&bar[XB_TOP], 1u);
            const unsigned tg = og / nx;
            if (og + 1u == (tg + 1u) * nx) xb_add(&bar[XB_TOPGEN], 1u);
            else XB_SPIN(xb_ld(&bar[XB_TOPGEN]) == tg, bar);
            __builtin_amdgcn_fence(__ATOMIC_ACQUIRE, "agent");
            xb_add(&bar[XB_XGEN(b.x)], 1u);
            asm volatile("s_waitcnt vmcnt(0)" ::: "memory");
        } else {
            XB_SPIN(xb_ld(&bar[XB_XGEN(b.x)]) == gen, bar);
            __builtin_amdgcn_fence(__ATOMIC_ACQUIRE, "agent");
            asm volatile("s_waitcnt vmcnt(0)" ::: "memory");
        }
    }
    __syncthreads();
}
DI KP kargs() { unsigned long long v = (unsigned long long)__builtin_amdgcn_kernarg_segment_ptr(); asm volatile("" : "+s"(v)); return (KP)v; }
#define PH_VARS KP Pk = kargs(); int tid = threadIdx.x; asm volatile("" : "+v"(tid)); const int lane = tid & 63, wid = __builtin_amdgcn_readfirstlane(tid >> 6); \
    const int G = gridDim.x, bx = blockIdx.x; const int gw = bx * 8 + wid, NGW = G * 8, gtid = bx * 512 + tid, GT = G * 512; unsigned char* ws = Pk->ws; (void)lane; (void)gw; (void)NGW; (void)gtid; (void)GT; (void)ws;
__global__ void __launch_bounds__(512, 2) fwd(Params Pdummy) {
    extern __shared__ __attribute__((aligned(16))) unsigned char lds_g[];
    LAS unsigned char* lds = (LAS unsigned char*)lds_g;
    cg::grid_group grid = cg::this_grid();
    int lo, hi; unsigned* barw; { KP Pk = kargs(); lo = Pk->ph_lo; hi = Pk->ph_hi; barw = (unsigned*)(Pk->ws + WS_BAR); }
    if (hi > 1000) grid.sync();
    if (threadIdx.x < 2) ((volatile LAS unsigned*)(lds + 131072))[threadIdx.x] = 0u;
    __syncthreads();
    XcdBarrier xb; xb.bar = barw; xb.x = 0; xb.st = nullptr;
    if (hi - lo > 1) xb = xcd_barrier_post(barw, (volatile LAS unsigned*)(lds + 131072));
#ifndef PROBE_REP
#define PROBE_REP -1
#endif
#ifndef PROBE_N
#define PROBE_N 0
#endif
#ifndef PROBE_MIX
#define PROBE_MIX 0
#endif
#ifndef STAG_TICKS
#define STAG_TICKS 0
#endif
#define STAGGER() do { if (STAG_TICKS > 0) { const unsigned long long t0_ = __builtin_amdgcn_s_memrealtime(); const unsigned long long d_ = (unsigned long long)((bx >> 3) & 3) * STAG_TICKS; while (__builtin_amdgcn_s_memrealtime() - t0_ < d_) __builtin_amdgcn_s_sleep(8); } } while (0)
#ifndef PROBE_SYNC
#define PROBE_SYNC 0
#endif
#define REPS(k) for (int rep_ = 0; rep_ < ((k) == PROBE_REP ? 1 + PROBE_N : 1); ++rep_)
#define IN(k) (lo <= (k) && (k) < hi)
#define SEAM(k) do { if (IN(k) && IN((k) + 1)) xcd_barrier(xb); } while (0)
    const bool merged = IN(0) && IN(1) && (int)gridDim.x > MODLD / 256;
    if (IN(0)) { PH_VARS
        prologue(Pk, lds, gw, NGW, gtid, GT, wid, lane);
        if (merged) {
            unsigned* flag = (unsigned*)(ws + WS_BAR) + 3840;
            asm volatile("s_waitcnt vmcnt(0)" ::: "memory"); __syncthreads();
            if (tid == 0) { __builtin_amdgcn_fence(__ATOMIC_RELEASE, "agent"); asm volatile("s_waitcnt vmcnt(0)" ::: "memory"); __hip_atomic_fetch_add(flag, 1u, __ATOMIC_RELAXED, __HIP_MEMORY_SCOPE_AGENT); }
            if (bx < MODLD / 256) {
                if (wid == 0) { unsigned sp = 0;
                    while ((unsigned)__builtin_amdgcn_readfirstlane(__hip_atomic_load(flag, __ATOMIC_RELAXED, __HIP_MEMORY_SCOPE_AGENT)) < (unsigned)G) { __builtin_amdgcn_s_sleep(2); if (++sp > (1u << 22)) break; }
                    __builtin_amdgcn_fence(__ATOMIC_ACQUIRE, "agent"); asm volatile("s_waitcnt vmcnt(0)" ::: "memory"); }
                __syncthreads();
                pg8::Gemm g{(const bf16_t*)(ws + WS_CS), (const bf16_t*)(ws + WS_WADA), 256, MODLD, DM}; pg8::StaticOrder S; S.init(256, MODLD, G, bx);
                EpiMod E{(float*)(ws + WS_MOD), Pk->in[8]};
                pg8::gemm_phase<EpiMod, pg8::StaticOrder, PG8_ALIGN, PG8_SP2>(lds, g, S, E, tid);
            } else {
                prologue_rest(Pk, lds, (bx - MODLD / 256) * 8 + wid, (G - MODLD / 256) * 8, wid, lane);
            }
        } else prologue_rest(Pk, lds, gw, NGW, wid, lane);
    }
    SEAM(0);
    for (int i_ = 0; i_ < PROBE_SYNC; ++i_) xcd_barrier(xb);
    if (IN(1) && !merged) { PH_VARS
        pg8::Gemm g{(const bf16_t*)(ws + WS_CS), (const bf16_t*)(ws + WS_WADA), 256, MODLD, DM}; pg8::StaticOrder S; S.init(256, MODLD, G, bx);
        EpiMod E{(float*)(ws + WS_MOD), Pk->in[8]};
        pg8::gemm_phase<EpiMod, pg8::StaticOrder, PG8_ALIGN, PG8_SP2>(lds, g, S, E, tid);
        states_shift(Pk, gtid, GT);
    }
    if (!merged) SEAM(1);
#pragma unroll 1
    for (int l = 0; l < 2; ++l) {
        const int pb = 2 + 10 * l;
#define LAYER_VARS unsigned char* wl = ws + WS_L0 + (size_t)l * LAYER_BYTES; bf16_t* XB = (bf16_t*)(ws + WS_X); float* XS = (float*)(ws + WS_XS); float* XSv = XS - (size_t)TP * DM; float* PART = (float*)(ws + WS_WADA); bf16_t* H = (bf16_t*)(ws + WS_H); bf16_t* ACT = (bf16_t*)(ws + WS_ACT); bf16_t* Z = (bf16_t*)(ws + WS_Z); bf16_t* MIX = (bf16_t*)(ws + WS_MIX); \
        const float* modl = (const float*)(ws + WS_MOD) + (size_t)l * NMOD; const float* gain_l = Pk->in[9] + (size_t)l * 3 * DM; \
        (void)wl; (void)XB; (void)XS; (void)XSv; (void)PART; (void)H; (void)ACT; (void)Z; (void)MIX; (void)modl; (void)gain_l;
        if (IN(pb + 0)) REPS(pb + 0) { PH_VARS LAYER_VARS
            if (l == 0) { norm_phase<false>(Pk->in[0], nullptr, gain_l, modl, H, nullptr, gw, NGW, lane, nullptr, 0, TP / 16); norm_sample<false>(Pk->in[1], gain_l, modl, H, nullptr, gw, NGW, lane, XSv, nullptr, 0); }
            else { norm_phase_bf<false>(XB, gain_l, modl, H, nullptr, gw, NGW, lane); norm_sample<false>(XS, gain_l, modl, H, nullptr, gw, NGW, lane, XSv, PART, FF / 256); } }
        SEAM(pb + 0);
        if (IN(pb + 1)) REPS(pb + 1) { PH_VARS LAYER_VARS
            pg8::Gemm g{H, (const bf16_t*)(wl + LW_GU1), MPAD, 2 * FF, DM}; TailOrder S; S.init(2 * FF, G, bx);
            EpiSwiGLU E{ACT};
            pg8::gemm_phase<EpiSwiGLU, TailOrder, PG8_ALIGN, PG8_SP2>(lds, g, S, E, tid);
        }
        SEAM(pb + 1);
        if (IN(pb + 2)) REPS(pb + 2) { PH_VARS LAYER_VARS
            pg8::Gemm g{ACT, (const bf16_t*)(wl + LW_D1), MPAD, DM, FF}; SplitOrder S; S.init(DM, FF, G, bx);
            EpiResid E{l == 0 ? Pk->in[0] : nullptr, XB, PART, modl + 2 * DM, 0.5f};
            STAGGER(); pg8::gemm_phase<EpiResid, SplitOrder, PG8_ALIGN, PG8_SP2>(lds, g, S, E, tid);
        }
        SEAM(pb + 2);
        if (IN(pb + 3)) REPS(pb + 3) { PH_VARS LAYER_VARS norm_phase_bf<false>(XB, gain_l + DM, modl + 3 * DM, H, nullptr, gw, NGW, lane); norm_sample<false>(XS, gain_l + DM, modl + 3 * DM, H, nullptr, gw, NGW, lane, XSv, PART, FF / 256); }
        SEAM(pb + 3);
        if (IN(pb + 4)) REPS(pb + 4) { PH_VARS LAYER_VARS
            pg8::Gemm g{H, (const bf16_t*)(wl + LW_IN), MPAD, INW, DM}; TailOrder S; S.init(INW, G, bx);
            EpiStoreBf16 E{Z, INW};
            pg8::gemm_phase<EpiStoreBf16, TailOrder, PG8_ALIGN, PG8_SP2>(lds, g, S, E, tid);
            if (l == 0 && merged) {
                constexpr int NB3 = (TP / 256 * (INW / 256) + INW / 256) - 512;
                if (G <= NB3 + 16) states_shift(Pk, gtid, GT); else if (bx >= NB3) states_shift(Pk, (bx - NB3) * 512 + tid, (G - NB3) * 512);
            }
        }
        SEAM(pb + 4);
        if (IN(pb + 5)) REPS(pb + 5) { PH_VARS LAYER_VARS
            const float* TB = (const float*)(ws + WS_TB);
            const float* sinks_l = Pk->in[12] + l * 8;
            const float* ck = Pk->in[4] + (size_t)l * 128 * 128 * 128; const float* cv = Pk->in[5] + (size_t)l * 128 * 128 * 128; const float* sp = Pk->in[6] + (size_t)l * 128 * 15 * 512;
            for (int id = bx; id < 816; id += G) {
                if (id < 512) { for (int rp = 0; rp < (PROBE_MIX == 1 ? 2 : 1); ++rp) { const int kvh = id & 1, bn = id >> 1; attn_unit(lds, Z, MIX, TB, sinks_l, bn >> 5, bn & 31, kvh, tid); } }
                else if (id < 784) { for (int rp = 0; rp < (PROBE_MIX == 2 ? 2 : 1); ++rp) { if (id < 768) pool_unit(lds, Z, (const bf16_t*)(wl + LW_POOL), Pk->in[15] + l * 512, MIX, id - 512, tid); else pool_unit_sample(lds, Z, sp, (const bf16_t*)(wl + LW_POOL), Pk->in[15] + l * 512, MIX, id - 768, tid); } }
                else { for (int rp = 0; rp < (PROBE_MIX == 3 ? 2 : 1); ++rp) { const int task = (id - 784) * 8 + wid; sattn_task((LAS float*)(lds + wid * 4096), Z, ck, cv, MIX, TB, sinks_l, task >> 1, task & 1, lane); __syncthreads(); } }
            }
            for (int rp = 0; rp < (PROBE_MIX == 4 ? 2 : 1); ++rp) states_copy(Pk, Z, l, gtid, GT);
        }
        SEAM(pb + 5);
        if (IN(pb + 6)) REPS(pb + 6) { PH_VARS LAYER_VARS
            pg8::Gemm g{MIX, (const bf16_t*)(wl + LW_OUT), MPAD, DM, DM}; SplitOrder S; S.init(DM, DM, G, bx);
            EpiResid E{nullptr, XB, PART, modl + 5 * DM, 1.0f};
            STAGGER(); pg8::gemm_phase<EpiResid, SplitOrder, PG8_ALIGN, PG8_SP2>(lds, g, S, E, tid);
        }
        SEAM(pb + 6);
        if (IN(pb + 7)) REPS(pb + 7) { PH_VARS LAYER_VARS norm_phase_bf<false>(XB, gain_l + 2 * DM, modl + 6 * DM, H, nullptr, gw, NGW, lane); norm_sample<false>(XS, gain_l + 2 * DM, modl + 6 * DM, H, nullptr, gw, NGW, lane, XSv, PART, DM / 256); }
        SEAM(pb + 7);
        if (IN(pb + 8)) REPS(pb + 8) { PH_VARS LAYER_VARS
            pg8::Gemm g{H, (const bf16_t*)(wl + LW_GU2), MPAD, 2 * FF, DM}; TailOrder S; S.init(2 * FF, G, bx);
            EpiSwiGLU E{ACT};
            pg8::gemm_phase<EpiSwiGLU, TailOrder, PG8_ALIGN, PG8_SP2>(lds, g, S, E, tid);
        }
        SEAM(pb + 8);
        if (IN(pb + 9)) REPS(pb + 9) { PH_VARS LAYER_VARS
            pg8::Gemm g{ACT, (const bf16_t*)(wl + LW_D2), MPAD, DM, FF}; SplitOrder S; S.init(DM, FF, G, bx);
            EpiResid E{nullptr, XB, PART, modl + 8 * DM, 0.5f};
            STAGGER(); pg8::gemm_phase<EpiResid, SplitOrder, PG8_ALIGN, PG8_SP2>(lds, g, S, E, tid);
        }
        SEAM(pb + 9);
    }
    if (IN(22)) REPS(22) { PH_VARS norm_phase_bf<true>((const bf16_t*)(ws + WS_X), Pk->in[22], nullptr, nullptr, Pk->out, gw, NGW, lane); norm_sample<true>((const float*)(ws + WS_XS), Pk->in[22], nullptr, nullptr, Pk->out, gw, NGW, lane, nullptr, (const float*)(ws + WS_WADA), FF / 256); }
#undef IN
#undef SEAM
}

extern "C" void kernel_launch(void* const* d_in, const int* in_sizes, int n_in, void* d_out, int out_size, void* d_ws, size_t ws_size, hipStream_t stream) {
    static int grid = 0;
    if (grid == 0) {
        if (n_in != 23 || (size_t)out_size != O_END || ws_size < WS_END) { fprintf(stderr, "kernel_launch: unexpected sizes n_in %d out %d ws %zu\n", n_in, out_size, ws_size); grid = -1; return; }
        int dev = 0, cus = 0, per_cu = 0;
        (void)hipGetDevice(&dev); (void)hipDeviceGetAttribute(&cus, hipDeviceAttributeMultiprocessorCount, dev);
        if (hipFuncSetAttribute((const void*)fwd, hipFuncAttributeMaxDynamicSharedMemorySize, LDS_BYTES) != hipSuccess) { fprintf(stderr, "kernel_launch: hipFuncSetAttribute failed\n"); grid = -1; return; }
        if (hipOccupancyMaxActiveBlocksPerMultiprocessor(&per_cu, (const void*)fwd, 512, LDS_BYTES) != hipSuccess || per_cu < 1) { fprintf(stderr, "kernel_launch: occupancy query says %d\n", per_cu); per_cu = 1; }
        (void)hipGetLastError();
        grid = cus * per_cu;
    }
    if (grid < 0) return;
    Params p{};
    for (int i = 0; i < 23; ++i) p.in[i] = (const float*)d_in[i];
    p.out = (float*)d_out; p.ws = (unsigned char*)d_ws;
#if N_LAUNCH_PER_PHASE
    for (int ph = 0; ph < NPH; ++ph) { p.ph_lo = ph; p.ph_hi = ph + 1; hipLaunchKernelGGL(fwd, dim3(grid), dim3(512), LDS_BYTES, stream, p); }
#else
    p.ph_lo = 0; p.ph_hi = NPH;
    if (hipMemsetAsync((char*)d_ws + WS_BAR, 0, WS_BAR_BYTES, stream) != hipSuccess) { fprintf(stderr, "kernel_launch: memset failed\n"); return; }
    void* args[] = {&p};
    hipError_t e = hipLaunchCooperativeKernel((const void*)fwd, dim3(grid), dim3(512), args, LDS_BYTES, stream);
    if (e != hipSuccess) fprintf(stderr, "kernel_launch: cooperative launch failed: %s (grid %d)\n", hipGetErrorString(e), grid);
#endif
}
```
